# Optimizing an MI355X kernel written in HIP

```python
import jax, jax.numpy as jnp
from jax import lax
import numpy as np

D_MODEL = 2048
BATCH = 4
SEQ = 4096
DEPTH = 4

N_MIXERS = 2
N_HEADS = 16
HEAD_DIM = D_MODEL // N_HEADS
D_FF = 4 * D_MODEL
CONV_WIDTH = 3
Q_BLOCK = 128
N_ATTN_LAYERS = (DEPTH + 1) // 2
N_CONV_LAYERS = DEPTH // 2
N_MOD = 6
DEEPNORM_ALPHA = (2.0 * DEPTH) ** 0.25
DEEPNORM_BETA = (8.0 * DEPTH) ** -0.25
LN_EPS = 1e-5
MOD_INIT_SCALE = 0.1

kernel_name = "hybrid_stickbreak_shortconv_deepnorm_adaln"


def layer_norm(x, g, b):
    xf = x.astype(jnp.float32)
    mu = jnp.mean(xf, axis=-1, keepdims=True)
    xc = xf - mu
    var = jnp.mean(xc * xc, axis=-1, keepdims=True)
    y = xc * lax.rsqrt(var + LN_EPS)
    return (y * g.astype(jnp.float32) + b.astype(jnp.float32)).astype(x.dtype)


def stick_breaking_attention(h, w_qkv, w_o):
    bsz, seq, _ = h.shape
    qkv = h @ w_qkv
    q, k, v = jnp.split(qkv, 3, axis=-1)
    q = q.reshape(bsz, seq, N_HEADS, HEAD_DIM)
    k = k.reshape(bsz, seq, N_HEADS, HEAD_DIM)
    v = v.reshape(bsz, seq, N_HEADS, HEAD_DIM)
    scale = HEAD_DIM ** -0.5
    outs = []
    for blk in range(seq // Q_BLOCK):
        start = blk * Q_BLOCK
        end = start + Q_BLOCK
        qb = q[:, start:end].astype(jnp.float32)
        kb = k[:, :end].astype(jnp.float32)
        vb = v[:, :end].astype(jnp.float32)
        z = jnp.einsum('bqhd,bkhd->bhqk', qb, kb) * scale
        t_idx = start + jnp.arange(Q_BLOCK)[:, None]
        s_idx = jnp.arange(end)[None, :]
        causal = s_idx < t_idx
        log_beta = jax.nn.log_sigmoid(z)
        log_1m = jnp.where(causal, jax.nn.log_sigmoid(-z), 0.0)
        log_stick = lax.cumsum(log_1m, axis=3, reverse=True) - log_1m
        a = jnp.where(causal, jnp.exp(log_beta + log_stick), 0.0)
        outs.append(jnp.einsum('bhqk,bkhd->bqhd', a, vb))
    o = jnp.concatenate(outs, axis=1).reshape(bsz, seq, D_MODEL).astype(h.dtype)
    return o @ w_o


def short_conv_mixer(h, w_in, conv_w, conv_b, w_out):
    bcu = h @ w_in
    b_gate, c_gate, u = jnp.split(bcu, 3, axis=-1)
    gated = c_gate * u
    y = lax.conv_general_dilated(
        gated, conv_w[:, None, :].astype(gated.dtype),
        window_strides=(1,), padding=[(CONV_WIDTH - 1, 0)],
        dimension_numbers=('NWC', 'WIO', 'NWC'),
        feature_group_count=D_MODEL) + conv_b
    return (b_gate * y) @ w_out


def sq_relu_mlp(h, w1, b1, w2, b2):
    return jnp.square(jax.nn.relu(h @ w1 + b1)) @ w2 + b2


def setup_inputs(seed: int = 0) -> dict:
    key = jax.random.key(seed)
    ks = jax.random.split(key, 20)
    d, f = D_MODEL, D_FF
    nrm = jax.random.normal
    x = nrm(ks[0], (BATCH, SEQ, d), jnp.float32)
    c = nrm(ks[1], (BATCH, d), jnp.float32)
    mod_w = nrm(ks[2], (DEPTH, d, N_MOD * d), jnp.float32) * (d ** -0.5) * MOD_INIT_SCALE
    mod_b = nrm(ks[3], (DEPTH, N_MOD * d), jnp.float32) * 0.01
    ln_g = 1.0 + 0.02 * nrm(ks[4], (DEPTH, 2, d), jnp.float32)
    ln_b = 0.02 * nrm(ks[5], (DEPTH, 2, d), jnp.float32)
    v_col_scale = jnp.concatenate([jnp.ones((2 * d,), jnp.float32),
                                   jnp.full((d,), DEEPNORM_BETA, jnp.float32)])
    attn_w_qkv = nrm(ks[6], (N_ATTN_LAYERS, d, 3 * d), jnp.float32) * (d ** -0.5) * v_col_scale
    attn_w_o = nrm(ks[7], (N_ATTN_LAYERS, d, d), jnp.float32) * (d ** -0.5) * DEEPNORM_BETA
    conv_w_in = nrm(ks[8], (N_CONV_LAYERS, d, 3 * d), jnp.float32) * (d ** -0.5)
    conv_w = nrm(ks[9], (N_CONV_LAYERS, CONV_WIDTH, d), jnp.float32) * (CONV_WIDTH ** -0.5)
    conv_b = nrm(ks[10], (N_CONV_LAYERS, d), jnp.float32) * 0.01
    conv_w_out = nrm(ks[11], (N_CONV_LAYERS, d, d), jnp.float32) * (d ** -0.5) * DEEPNORM_BETA
    mlp_w1 = nrm(ks[12], (DEPTH, d, f), jnp.float32) * (d ** -0.5) * DEEPNORM_BETA
    mlp_b1 = nrm(ks[13], (DEPTH, f), jnp.float32) * 0.01
    mlp_w2 = nrm(ks[14], (DEPTH, f, d), jnp.float32) * (f ** -0.5) * DEEPNORM_BETA
    mlp_b2 = nrm(ks[15], (DEPTH, d), jnp.float32) * 0.01
    return {"x": x, "c": c, "mod_w": mod_w, "mod_b": mod_b, "ln_g": ln_g, "ln_b": ln_b,
            "attn_w_qkv": attn_w_qkv, "attn_w_o": attn_w_o,
            "conv_w_in": conv_w_in, "conv_w": conv_w, "conv_b": conv_b, "conv_w_out": conv_w_out,
            "mlp_w1": mlp_w1, "mlp_b1": mlp_b1, "mlp_w2": mlp_w2, "mlp_b2": mlp_b2}


def reference(x, c, mod_w, mod_b, ln_g, ln_b, attn_w_qkv, attn_w_o,
              conv_w_in, conv_w, conv_b, conv_w_out, mlp_w1, mlp_b1, mlp_w2, mlp_b2):
    cond = jax.nn.silu(c)
    for i in range(DEPTH):
        mod = (cond @ mod_w[i] + mod_b[i])[:, None, :]
        sh_m, sc_m, g_m, sh_f, sc_f, g_f = jnp.split(mod, N_MOD, axis=-1)
        h = x * (1.0 + sc_m) + sh_m
        if i % N_MIXERS == 0:
            j = i // N_MIXERS
            y = stick_breaking_attention(h, attn_w_qkv[j], attn_w_o[j])
        else:
            j = i // N_MIXERS
            y = short_conv_mixer(h, conv_w_in[j], conv_w[j], conv_b[j], conv_w_out[j])
        x = layer_norm(DEEPNORM_ALPHA * x + (1.0 + g_m) * y, ln_g[i, 0], ln_b[i, 0])
        h = x * (1.0 + sc_f) + sh_f
        y = sq_relu_mlp(h, mlp_w1[i], mlp_b1[i], mlp_w2[i], mlp_b2[i])
        x = layer_norm(DEEPNORM_ALPHA * x + (1.0 + g_f) * y, ln_g[i, 1], ln_b[i, 1])
    return x
```

```cpp
#include <hip/hip_runtime.h>
#include <hip/hip_bf16.h>
#include <cstdio>
#include <cstdint>
namespace pg8 {
#define PG8_LAS __attribute__((address_space(3)))
typedef unsigned short bf16_t;
typedef short bf16x8 __attribute__((ext_vector_type(8)));
typedef float f32x4 __attribute__((ext_vector_type(4)));
typedef unsigned u32x4 __attribute__((ext_vector_type(4)));
constexpr int BM = 256, BK = 64, HALF = 128, HTB = HALF * BK * 2  , STAGE_BYTES = 8 * HTB, NXCD = 8, WGM = 8;

__host__ __device__ __forceinline__ int lds_byte(int r, int c) { const int st = (r >> 4) * 2 + (c >> 5), rr = r & 15, cc = c & 31, ob = rr * 64 + cc * 2; return st * 1024 + (ob ^ (((ob >> 9) & 1) << 5)); }
__host__ __device__ __forceinline__ void stage_rc(int b, int& R, int& C) { const int st = b / 1024, sb = b % 1024, swz = sb ^ (((sb >> 9) & 1) << 5); R = (st >> 1) * 16 + swz / 64; C = (st & 1) * 32 + (swz % 64) / 2; }
__host__ __device__ __forceinline__ int perm32(int rho) { const int n = rho >> 4, i = rho & 15; return 8 * (i >> 2) + 4 * n + (i & 3); }

struct Unit { int pm, pn; };
struct Gemm { const bf16_t* A; const bf16_t* Bt; int M, N, K; };

struct StaticOrder {
    int nM, nN, nwg, G, c;
    __host__ __device__ void init(int M, int N, int G_, int c_) { nM = M / BM; nN = N / BM; nwg = nM * nN; G = G_; c = c_; }
    __host__ __device__ bool next(int i, Unit& u) const {
        const long L = (long)i * G + c; if (L >= nwg) return false;
        int wgid = (int)L; { const int q = nwg / NXCD, r = nwg % NXCD, xcd = wgid % NXCD, off = wgid / NXCD; wgid = (xcd < r ? xcd * (q + 1) : r * (q + 1) + (xcd - r) * q) + off; }
        const int nig = WGM * nN, gid = wgid / nig, fm = gid * WGM, gsz = (nM - fm) < WGM ? (nM - fm) : WGM;
        u.pm = fm + ((wgid % nig) % gsz); u.pn = (wgid % nig) / gsz; return true;
    }
    __device__ __forceinline__ void a_ready(const Unit&) const {}
    __device__ __forceinline__ void done(const Unit&) const {}
};

__device__ __forceinline__ unsigned cvt_pk_bf16(float lo, float hi) { unsigned r; asm volatile("v_cvt_pk_bf16_f32 %0, %1, %2" : "=v"(r) : "v"(lo), "v"(hi)); return r; }
typedef float f32x2 __attribute__((ext_vector_type(2)));

template <int ACT> struct EpiBf16 {
    static constexpr bool PERM = true, AFTER_DRAIN = false; static_assert(ACT == 0 || ACT == 3, "EpiBf16: ACT is 0 (none) or 3 (squared relu)");
    bf16_t* O; int ldc; const float* bias; int split_cols; size_t split_stride; float scale0;
    __device__ __forceinline__ void operator()(const f32x4 (&acc)[2][2][4][2], const Unit& u, int wr, int wc, int fr, int fq) const {
        const int row0 = u.pm * BM + wr * 64 + fr; int colt = u.pn * BM; bf16_t* base = O;
        float sc = 1.f; if (split_cols) { const int t = colt / split_cols; base += (size_t)t * split_stride; colt -= t * split_cols; if (t == 0) sc = scale0; }
        const int col0 = colt + wc * 32 + 8 * fq, bcol0 = u.pn * BM + wc * 32 + 8 * fq;
        f32x4 bv[2][2];
#pragma unroll
        for (int bj = 0; bj < 2; ++bj)
#pragma unroll
            for (int n = 0; n < 2; ++n) bv[bj][n] = bias ? *(const f32x4*)(bias + bcol0 + bj * HALF + 4 * n) : (f32x4){0.f, 0.f, 0.f, 0.f};
#pragma unroll
        for (int ai = 0; ai < 2; ++ai)
#pragma unroll
            for (int m = 0; m < 4; ++m) { bf16_t* rowp = base + (size_t)(row0 + ai * HALF + m * 16) * ldc + col0;
#pragma unroll
                for (int bj = 0; bj < 2; ++bj) { f32x4 v0 = acc[ai][bj][m][0] + bv[bj][0], v1 = acc[ai][bj][m][1] + bv[bj][1];
                    if (ACT == 3) {
#pragma unroll
                        for (int j = 0; j < 4; ++j) { const float a = fmaxf(v0[j], 0.f), b = fmaxf(v1[j], 0.f); v0[j] = a * a; v1[j] = b * b; } }
                    v0 = v0 * sc; v1 = v1 * sc; u32x4 w; w.x = cvt_pk_bf16(v0[0], v0[1]); w.y = cvt_pk_bf16(v0[2], v0[3]); w.z = cvt_pk_bf16(v1[0], v1[1]); w.w = cvt_pk_bf16(v1[2], v1[3]);
                    *(u32x4*)(rowp + bj * HALF) = w; } }
    }
};
struct EpiResid {
    static constexpr bool PERM = false, AFTER_DRAIN = false;
    float* X; int ldc; const float* bias; const float* gate; int gate_bstride; int rows_per_batch; float alpha;
    __device__ __forceinline__ void operator()(const f32x4 (&acc)[2][2][4][2], const Unit& u, int wr, int wc, int fr, int fq) const {
        const int row0 = u.pm * BM + wr * 64 + fr, col0 = u.pn * BM + wc * 32 + 4 * fq;
        const float* gp = gate + (size_t)((u.pm * BM) / rows_per_batch) * gate_bstride;
        f32x4 bv[2][2], gv[2][2];
#pragma unroll
        for (int bj = 0; bj < 2; ++bj)
#pragma unroll
            for (int n = 0; n < 2; ++n) { bv[bj][n] = bias ? *(const f32x4*)(bias + col0 + bj * HALF + n * 16) : (f32x4){0.f, 0.f, 0.f, 0.f}; gv[bj][n] = *(const f32x4*)(gp + col0 + bj * HALF + n * 16); }
#pragma unroll
        for (int ai = 0; ai < 2; ++ai)
#pragma unroll
            for (int m = 0; m < 4; ++m) { float* rowp = X + (size_t)(row0 + ai * HALF + m * 16) * ldc + col0;
#pragma unroll
                for (int bj = 0; bj < 2; ++bj)
#pragma unroll
                    for (int n = 0; n < 2; ++n) { const f32x4 xo = *(const f32x4*)(rowp + bj * HALF + n * 16); *(f32x4*)(rowp + bj * HALF + n * 16) = xo * alpha + gv[bj][n] * (acc[ai][bj][m][n] + bv[bj][n]); }
                if (m & 1) asm volatile("" ::: "memory"); }
    }
};

template <class Epi, class Sched, bool ALIGN_EPI = false, bool SP2 = false>
__device__ __forceinline__ void gemm_phase(PG8_LAS unsigned char* lds, const Gemm g, const Sched& S, const Epi& E) {
    int tid_ = threadIdx.x; asm volatile("" : "+v"(tid_));
    const int tid = tid_, wid = __builtin_amdgcn_readfirstlane(tid >> 6), lane = tid & 63, wr = wid >> 2, wc = wid & 3, fr = lane & 15, fq = lane >> 4;
    const int K = g.K, nt = K / BK;
    unsigned voffA[2], voffB[2];
#pragma unroll
    for (int i = 0; i < 2; ++i) { int R, C; stage_rc(tid * 16 + i * 8192, R, C); const int Rb = Epi::PERM ? ((R & ~31) + perm32(R & 31)) : R;
        voffA[i] = (unsigned)(R * K + C) * 2u; voffB[i] = (unsigned)(Rb * K + C) * 2u; }
    const size_t kstep = (size_t)(BK * 2);
    const size_t hstep = (size_t)HALF * K * 2;
    const size_t tstep = 2 * hstep;
    const unsigned ldsw = (unsigned)wid * 1024u;
    const int aoff = lds_byte(wr * 64 + fr, fq * 8), boff = lds_byte(wc * 32 + fr, fq * 8);
#define PG8_SA(b, h) (((b) * 2 + (h)) * HTB)
#define PG8_SB(b, h) ((4 + (b) * 2 + (h)) * HTB)
#define PG8_STAGE(bufoff, gbase, voff) do { _Pragma("unroll") for (int _i = 0; _i < 2; ++_i) \
        __builtin_amdgcn_global_load_lds((const unsigned*)((const char*)(gbase) + (voff)[_i]), (PG8_LAS unsigned*)(lds + (bufoff) + ldsw + _i * 8192), 16, 0, 0); } while (0)
#define PG8_LDA(dst, b, h) do { _Pragma("unroll") for (int m = 0; m < 4; ++m) _Pragma("unroll") for (int k = 0; k < 2; ++k) dst[m][k] = *(const PG8_LAS bf16x8*)(lds + PG8_SA(b, h) + aoff + m * 2048 + k * 1024); } while (0)
#define PG8_LDB(dst, b, h) do { _Pragma("unroll") for (int n = 0; n < 2; ++n) _Pragma("unroll") for (int k = 0; k < 2; ++k) dst[n][k] = *(const PG8_LAS bf16x8*)(lds + PG8_SB(b, h) + boff + n * 2048 + k * 1024); } while (0)
#define PG8_MMA(ai, bj, At, Bt) do { __builtin_amdgcn_s_setprio(1); _Pragma("unroll") for (int m = 0; m < 4; ++m) _Pragma("unroll") for (int n = 0; n < 2; ++n) _Pragma("unroll") for (int k = 0; k < 2; ++k) \
        acc[ai][bj][m][n] = __builtin_amdgcn_mfma_f32_16x16x32_bf16(Bt[n][k], At[m][k], acc[ai][bj][m][n], 0, 0, 0); __builtin_amdgcn_s_setprio(0); } while (0)
#define PG8_WAIT_V(n) asm volatile("s_waitcnt vmcnt(" #n ")" ::: "memory")
#define PG8_WAIT_L(n) asm volatile("s_waitcnt lgkmcnt(" #n ")" ::: "memory")
#define PG8_BAR __builtin_amdgcn_s_barrier()
#define PG8_SCHED __builtin_amdgcn_sched_barrier(0)
    Unit cur, nxt; int ui = 0;
    if (!S.next(0, cur)) return;
    f32x4 acc[2][2][4][2];
#pragma unroll
    for (int a = 0; a < 2; ++a)
#pragma unroll
        for (int b = 0; b < 2; ++b)
#pragma unroll
            for (int m = 0; m < 4; ++m)
#pragma unroll
                for (int n = 0; n < 2; ++n) acc[a][b][m][n] = (f32x4){0.f, 0.f, 0.f, 0.f};
    bf16x8 At[4][2], B0[2][2], B1[2][2];
    const char* cA = (const char*)g.A + (size_t)cur.pm * tstep; const char* cB = (const char*)g.Bt + (size_t)cur.pn * tstep;
    S.a_ready(cur);
    if constexpr (SP2) {
        PG8_STAGE(PG8_SB(0, 0), cB, voffB); PG8_STAGE(PG8_SB(0, 1), cB + hstep, voffB); PG8_STAGE(PG8_SA(0, 0), cA, voffA); PG8_STAGE(PG8_SA(0, 1), cA + hstep, voffA);
        if (wr == 1) PG8_BAR;
        PG8_WAIT_V(2); PG8_BAR;
        PG8_STAGE(PG8_SB(1, 0), cB + kstep, voffB); PG8_STAGE(PG8_SA(1, 0), cA + kstep, voffA); PG8_STAGE(PG8_SB(1, 1), cB + hstep + kstep, voffB);
        PG8_WAIT_V(6); PG8_BAR;
    } else {
        PG8_STAGE(PG8_SB(0, 0), cB, voffB); PG8_STAGE(PG8_SA(0, 0), cA, voffA); PG8_STAGE(PG8_SB(0, 1), cB + hstep, voffB); PG8_STAGE(PG8_SA(0, 1), cA + hstep, voffA);
        if (wr == 1) PG8_BAR;
        PG8_WAIT_V(4); PG8_BAR;
        PG8_STAGE(PG8_SB(1, 0), cB + kstep, voffB); PG8_STAGE(PG8_SA(1, 0), cA + kstep, voffA); PG8_STAGE(PG8_SB(1, 1), cB + hstep + kstep, voffB);
        PG8_WAIT_V(6); PG8_BAR;
    }
    for (;;) {
        const bool has_next = S.next(ui + 1, nxt);
        const char* nA = has_next ? (const char*)g.A + (size_t)nxt.pm * tstep : cA; const char* nB = has_next ? (const char*)g.Bt + (size_t)nxt.pn * tstep : cB;
        for (int t = 0; t < nt; t += 2) {
            const bool last = (t == nt - 2);
            const char* a1 = cA + (size_t)(t + 1) * kstep;
            const char* a2 = last ? nA : cA + (size_t)(t + 2) * kstep; const char* b2 = last ? nB : cB + (size_t)(t + 2) * kstep;
            const char* a3 = a2 + kstep; const char* b3 = b2 + kstep;
            if (last && has_next) S.a_ready(nxt);
            if constexpr (SP2) {
            PG8_LDB(B0, 0, 0); PG8_LDB(B1, 0, 1); PG8_SCHED; PG8_LDA(At, 0, 0); PG8_STAGE(PG8_SA(1, 1), a1 + hstep, voffA);
            PG8_WAIT_V(8); PG8_WAIT_L(0); PG8_BAR; PG8_MMA(0, 0, At, B0); PG8_MMA(0, 1, At, B1); PG8_BAR; PG8_SCHED;
            PG8_LDA(At, 0, 1); PG8_STAGE(PG8_SB(0, 0), b2, voffB); PG8_STAGE(PG8_SB(0, 1), b2 + hstep, voffB); PG8_STAGE(PG8_SA(0, 0), a2, voffA);
            PG8_WAIT_V(8); PG8_WAIT_L(0); PG8_BAR; PG8_MMA(1, 0, At, B0); PG8_MMA(1, 1, At, B1); PG8_BAR; PG8_SCHED;
            PG8_LDB(B0, 1, 0); PG8_LDB(B1, 1, 1); PG8_SCHED; PG8_LDA(At, 1, 0); PG8_STAGE(PG8_SA(0, 1), a2 + hstep, voffA);
            PG8_WAIT_V(8); PG8_WAIT_L(0); PG8_BAR; PG8_MMA(0, 0, At, B0); PG8_MMA(0, 1, At, B1); PG8_BAR; PG8_SCHED;
            PG8_LDA(At, 1, 1); PG8_STAGE(PG8_SB(1, 0), b3, voffB); PG8_STAGE(PG8_SB(1, 1), b3 + hstep, voffB); PG8_STAGE(PG8_SA(1, 0), a3, voffA);
            PG8_WAIT_V(8); PG8_WAIT_L(0); PG8_BAR; PG8_MMA(1, 0, At, B0); PG8_MMA(1, 1, At, B1); PG8_BAR; PG8_SCHED;
            } else {
            PG8_LDB(B0, 0, 0); PG8_SCHED; PG8_LDA(At, 0, 0); PG8_STAGE(PG8_SA(1, 1), a1 + hstep, voffA);
            PG8_WAIT_L(8); PG8_BAR; PG8_WAIT_L(0); PG8_MMA(0, 0, At, B0); PG8_BAR; PG8_SCHED;
            PG8_LDB(B1, 0, 1); PG8_STAGE(PG8_SB(0, 0), b2, voffB);
            PG8_BAR; PG8_WAIT_L(0); PG8_MMA(0, 1, At, B1); PG8_BAR;
            PG8_LDA(At, 0, 1); PG8_STAGE(PG8_SA(0, 0), a2, voffA);
            PG8_BAR; PG8_WAIT_L(0); PG8_MMA(1, 0, At, B0); PG8_BAR; PG8_SCHED;
            PG8_STAGE(PG8_SB(0, 1), b2 + hstep, voffB);
            PG8_WAIT_V(6); PG8_BAR; PG8_MMA(1, 1, At, B1); PG8_BAR;
            PG8_LDB(B0, 1, 0); PG8_SCHED; PG8_LDA(At, 1, 0); PG8_STAGE(PG8_SA(0, 1), a2 + hstep, voffA);
            PG8_WAIT_L(8); PG8_BAR; PG8_WAIT_L(0); PG8_MMA(0, 0, At, B0); PG8_BAR; PG8_SCHED;
            PG8_LDB(B1, 1, 1); PG8_STAGE(PG8_SB(1, 0), b3, voffB);
            PG8_BAR; PG8_WAIT_L(0); PG8_MMA(0, 1, At, B1); PG8_BAR;
            PG8_LDA(At, 1, 1); PG8_STAGE(PG8_SA(1, 0), a3, voffA);
            PG8_BAR; PG8_WAIT_L(0); PG8_MMA(1, 0, At, B0); PG8_BAR; PG8_SCHED;
            PG8_STAGE(PG8_SB(1, 1), b3 + hstep, voffB);
            PG8_WAIT_V(6); PG8_BAR; PG8_MMA(1, 1, At, B1); PG8_BAR;
            }
        }
        if constexpr (ALIGN_EPI) { if (wr == 0) PG8_BAR; }
        if constexpr (!Epi::AFTER_DRAIN) { E(acc, cur, wr, wc, fr, fq); S.done(cur); }
        if (!has_next) break;
#pragma unroll
        for (int a = 0; a < 2; ++a)
#pragma unroll
            for (int b = 0; b < 2; ++b)
#pragma unroll
                for (int m = 0; m < 4; ++m)
#pragma unroll
                    for (int n = 0; n < 2; ++n) acc[a][b][m][n] = (f32x4){0.f, 0.f, 0.f, 0.f};
        cur = nxt; cA = nA; cB = nB; ++ui;
        if constexpr (ALIGN_EPI) { if (wr == 1) PG8_BAR; }
    }
    PG8_WAIT_V(0);
    if constexpr (!ALIGN_EPI) { if (wr == 0) PG8_BAR; }
    PG8_BAR;
    if constexpr (Epi::AFTER_DRAIN) { E.fused(acc, cur, wr, wc, fr, fq, lds, wid, lane); S.done(cur); }
#undef PG8_SA
#undef PG8_SB
#undef PG8_STAGE
#undef PG8_LDA
#undef PG8_LDB
#undef PG8_MMA
#undef PG8_WAIT_V
#undef PG8_WAIT_L
#undef PG8_BAR
#undef PG8_SCHED
}
}

namespace sba {
using bf16x8 = __attribute__((ext_vector_type(8))) short;
using s16x4  = __attribute__((ext_vector_type(4))) short;
using f32x16 = __attribute__((ext_vector_type(16))) float;
using u32x4  = __attribute__((ext_vector_type(4))) unsigned;
typedef _Float16 f16x8 __attribute__((ext_vector_type(8)));
#define SBA_LAS __attribute__((address_space(3)))
constexpr int D = 128, NW = 8, QBLK = 32, KVBLK = 64, LDR = 2048, SEQ = 4096, NHEAD = 16, UNIT_ROWS = QBLK * NW;
constexpr int SHM_V = KVBLK * D * 2, SHM_K = KVBLK * D * 2;
constexpr int OFF_V = 0, OFF_K = 2 * SHM_V, OFF_FLAG = 2 * SHM_V + 2 * SHM_K, LDS_BYTES = OFF_FLAG + 128;
constexpr float DEAD = -152.f;
constexpr float NEG = -30000.f;
#define SBA_KSWZ(row, colB) ((row) * 256 + ((colB) ^ (((row) & 7) << 4)))
#define SBA_SBAR() __builtin_amdgcn_sched_barrier(0)
__device__ __forceinline__ int crow(int r, int hi) { return (r & 3) + 8 * (r >> 2) + 4 * hi; }
__device__ __forceinline__ unsigned cvtpk(float lo, float hi) { unsigned r; asm volatile("v_cvt_pk_bf16_f32 %0, %1, %2" : "=v"(r) : "v"(lo), "v"(hi)); return r; }
__device__ __forceinline__ unsigned pkh(float lo, float hi) { return __builtin_bit_cast(unsigned, __builtin_amdgcn_cvt_pkrtz(lo, hi)); }
__device__ __forceinline__ int v_st(int k, int c) { const int kk = (k & ~0xC) | ((k & 4) << 1) | ((k & 8) >> 1); return ((kk >> 3) * 4 + (c >> 5)) * 512 + ((kk & 7) * 32 + (c & 31)) * 2; }
__device__ __forceinline__ int v_rd_base(int lane) { return ((lane & 3) << 3) | (((lane >> 2) & 3) << 6) | (((lane >> 4) & 1) << 5) | (((lane >> 5) & 1) << 8); }
constexpr int v_rd_off(int d0, int ks, int half) { return d0 * 512 + ks * 4096 + half * 2048; }
template <int OFF> __device__ __forceinline__ s16x4 tr_read(int vb) { s16x4 r; asm volatile("ds_read_b64_tr_b16 %0, %1 offset:%2" : "=&v"(r) : "v"(vb), "i"(OFF) : "memory"); return r; }
template <int D0> __device__ __forceinline__ void pv_one(f32x16& od, int vb, bf16x8 pa0, bf16x8 pa1, bf16x8 pa2, bf16x8 pa3) {
  const s16x4 l0 = tr_read<v_rd_off(D0, 0, 0)>(vb), h0 = tr_read<v_rd_off(D0, 0, 1)>(vb), l1 = tr_read<v_rd_off(D0, 1, 0)>(vb), h1 = tr_read<v_rd_off(D0, 1, 1)>(vb);
  const s16x4 l2 = tr_read<v_rd_off(D0, 2, 0)>(vb), h2 = tr_read<v_rd_off(D0, 2, 1)>(vb), l3 = tr_read<v_rd_off(D0, 3, 0)>(vb), h3 = tr_read<v_rd_off(D0, 3, 1)>(vb);
  asm volatile("s_waitcnt lgkmcnt(0)" ::: "memory"); SBA_SBAR();
#define SBA_PK(L, H) (bf16x8){L[0], L[1], L[2], L[3], H[0], H[1], H[2], H[3]}
  od = __builtin_amdgcn_mfma_f32_32x32x16_bf16(pa0, SBA_PK(l0, h0), od, 0, 0, 0);
  od = __builtin_amdgcn_mfma_f32_32x32x16_bf16(pa1, SBA_PK(l1, h1), od, 0, 0, 0);
  od = __builtin_amdgcn_mfma_f32_32x32x16_bf16(pa2, SBA_PK(l2, h2), od, 0, 0, 0);
  od = __builtin_amdgcn_mfma_f32_32x32x16_bf16(pa3, SBA_PK(l3, h3), od, 0, 0, 0);
#undef SBA_PK
}
__device__ __forceinline__ void qkt(f32x16& p0, f32x16& p1, const SBA_LAS char* Ks, const bf16x8* qr, int r32, int hi) {
  p0 = f32x16{}; p1 = f32x16{};
#pragma unroll
  for (int d0 = 0; d0 < 8; ++d0) { const int cb = (d0 * 16 + hi * 8) * 2;
    const bf16x8 b0 = *(const SBA_LAS bf16x8*)(Ks + SBA_KSWZ(r32, cb));
    const bf16x8 b1 = *(const SBA_LAS bf16x8*)(Ks + SBA_KSWZ(32 + r32, cb));
    p0 = __builtin_amdgcn_mfma_f32_32x32x16_bf16(b0, qr[d0], p0, 0, 0, 0);
    p1 = __builtin_amdgcn_mfma_f32_32x32x16_bf16(b1, qr[d0], p1, 0, 0, 0); }
}
__device__ __forceinline__ void sb_elem(float z, float& lb, float& l1) {
  const float e = __builtin_amdgcn_exp2f(-__builtin_fabsf(z));
  const float L = __builtin_amdgcn_logf(1.0f + e);
  lb = __builtin_fminf(z, 0.f) - L; l1 = lb - z;
}

__device__ __forceinline__ void attn_unit(int b, int h, int qb, const unsigned short* __restrict__ Q, const unsigned short* __restrict__ K, const unsigned short* __restrict__ V,
                                          unsigned short* __restrict__ O, SBA_LAS char* lds) {
  int tid_ = threadIdx.x; asm volatile("" : "+v"(tid_));
  const int tid = tid_, wid = __builtin_amdgcn_readfirstlane(tid >> 6), lane = tid & 63, r32 = lane & 31, hi = lane >> 5;
  SBA_LAS char* V_lds = lds + OFF_V; SBA_LAS char* K_lds = lds + OFF_K; volatile SBA_LAS unsigned* flags = (volatile SBA_LAS unsigned*)(lds + OFF_FLAG);
  const long rowbase = (long)b * SEQ; const int q0 = qb * UNIT_ROWS;
  bf16x8 qr[8];
  { const unsigned short* Qw = Q + (rowbase + q0 + wid * QBLK + r32) * LDR + h * D + hi * 8;
#pragma unroll
    for (int d0 = 0; d0 < 8; ++d0) qr[d0] = *(const bf16x8*)(Qw + d0 * 16); }
  const unsigned short* Kh = K + rowbase * LDR + h * D; const unsigned short* Vh = V + rowbase * LDR + h * D;
  const int sr = tid >> 4, sc = (tid & 15) * 8, vst0 = v_st(sr, sc), vst1 = v_st(32 + sr, sc);
  const int vb0 = (int)(uintptr_t)V_lds + v_rd_base(lane);
  bf16x8 vs0, vs1, ks0, ks1;
#define SBA_SLOAD(k0) do { vs0 = *(const bf16x8*)(Vh + (long)((k0) + sr) * LDR + sc); vs1 = *(const bf16x8*)(Vh + (long)((k0) + 32 + sr) * LDR + sc); \
    ks0 = *(const bf16x8*)(Kh + (long)((k0) + sr) * LDR + sc); ks1 = *(const bf16x8*)(Kh + (long)((k0) + 32 + sr) * LDR + sc); } while (0)
#define SBA_SWRITE(bf) do { *(SBA_LAS bf16x8*)(V_lds + (bf) * SHM_V + vst0) = vs0; *(SBA_LAS bf16x8*)(V_lds + (bf) * SHM_V + vst1) = vs1; const int kc = sc * 2; \
    *(SBA_LAS bf16x8*)(K_lds + (bf) * SHM_K + SBA_KSWZ(sr, kc)) = ks0; *(SBA_LAS bf16x8*)(K_lds + (bf) * SHM_K + SBA_KSWZ(32 + sr, kc)) = ks1; } while (0)
  f16x8 U0, U1, ONES;
  { u32x4 w0, w1;
#pragma unroll
    for (int p = 0; p < 4; ++p) { const int ka = crow(2 * p, hi), kb = crow(2 * p + 1, hi), kc2 = crow(8 + 2 * p, hi), kd = crow(8 + 2 * p + 1, hi);
      w0[p] = (ka > r32 ? 0x3C00u : 0u) | (kb > r32 ? 0x3C000000u : 0u); w1[p] = (kc2 > r32 ? 0x3C00u : 0u) | (kd > r32 ? 0x3C000000u : 0u); }
    U0 = __builtin_bit_cast(f16x8, w0); U1 = __builtin_bit_cast(f16x8, w1);
    const u32x4 wo = {0x3C003C00u, 0x3C003C00u, 0x3C003C00u, 0x3C003C00u}; ONES = __builtin_bit_cast(f16x8, wo); }
  const int kt_top = 4 * qb + 3, my_kt = 4 * qb + (wid >> 1);
  const int ql = r32 + 32 * (wid & 1);
  float carry = 0.f; bool dead = false; f32x16 o[4] = {};
  SBA_SLOAD(kt_top * KVBLK); asm volatile("s_waitcnt vmcnt(0)" ::: "memory"); SBA_SWRITE(0); __syncthreads();
  for (int i = 0;; ++i) {
    const int kt = kt_top - i, cur = i & 1;
    if (kt > 0) SBA_SLOAD((kt - 1) * KVBLK);
    if (kt <= my_kt && !dead) {
      f32x16 p0, p1;
      qkt(p0, p1, K_lds + cur * SHM_K, qr, r32, hi);
      f32x16 lb0, lb1; float l10[16], l11[16];
#pragma unroll
      for (int r = 0; r < 16; ++r) { float a, c; sb_elem(p0[r], a, c); lb0[r] = a; l10[r] = c; sb_elem(p1[r], a, c); lb1[r] = a; l11[r] = c; }
      if (kt == my_kt) {
#pragma unroll
        for (int r = 0; r < 16; ++r) { const int k0 = crow(r, hi); const bool v0 = k0 < ql, v1 = (k0 + 32) < ql;
          l10[r] = v0 ? l10[r] : 0.f; lb0[r] = v0 ? lb0[r] : NEG; l11[r] = v1 ? l11[r] : 0.f; lb1[r] = v1 ? lb1[r] : NEG; }
      }
      const float lbk0 = lb0[0], l1k0 = l10[0];
      f16x8 h00, h01, h10, h11;
      { u32x4 a, c, e, g;
#pragma unroll
        for (int p = 0; p < 4; ++p) { a[p] = pkh(l10[2 * p], l10[2 * p + 1]); c[p] = pkh(l10[8 + 2 * p], l10[8 + 2 * p + 1]); e[p] = pkh(l11[2 * p], l11[2 * p + 1]); g[p] = pkh(l11[8 + 2 * p], l11[8 + 2 * p + 1]); }
        h00 = __builtin_bit_cast(f16x8, a); h01 = __builtin_bit_cast(f16x8, c); h10 = __builtin_bit_cast(f16x8, e); h11 = __builtin_bit_cast(f16x8, g); }
      lb1 = __builtin_amdgcn_mfma_f32_32x32x16_f16(U0, h10, lb1, 0, 0, 0); lb1 = __builtin_amdgcn_mfma_f32_32x32x16_f16(U1, h11, lb1, 0, 0, 0);
      lb0 = __builtin_amdgcn_mfma_f32_32x32x16_f16(U0, h00, lb0, 0, 0, 0); lb0 = __builtin_amdgcn_mfma_f32_32x32x16_f16(U1, h01, lb0, 0, 0, 0);
      lb0 = __builtin_amdgcn_mfma_f32_32x32x16_f16(ONES, h10, lb0, 0, 0, 0); lb0 = __builtin_amdgcn_mfma_f32_32x32x16_f16(ONES, h11, lb0, 0, 0, 0);
      float tot = (hi == 0) ? (lb0[0] - lbk0) + l1k0 : 0.f;
      { auto rr = __builtin_amdgcn_permlane32_swap(__float_as_uint(tot), __float_as_uint(tot), false, false); tot = __uint_as_float(rr[0]) + __uint_as_float(rr[1]); }
#pragma unroll
      for (int r = 0; r < 16; ++r) { lb0[r] = __builtin_amdgcn_exp2f(lb0[r] + carry); lb1[r] = __builtin_amdgcn_exp2f(lb1[r] + carry); }
      carry += tot;
      bf16x8 pa0, pa1, pa2, pa3;
#define SBA_PK4(P, BASE, OUT) do { unsigned a0 = cvtpk(P[BASE + 0], P[BASE + 1]), a1 = cvtpk(P[BASE + 2], P[BASE + 3]);   \
    unsigned b0 = cvtpk(P[BASE + 4], P[BASE + 5]), b1 = cvtpk(P[BASE + 6], P[BASE + 7]);                              \
    auto r0 = __builtin_amdgcn_permlane32_swap(a0, b0, false, false); auto r1 = __builtin_amdgcn_permlane32_swap(a1, b1, false, false); \
    u32x4 w = {r0[0], r1[0], r0[1], r1[1]}; OUT = __builtin_bit_cast(bf16x8, w); } while (0)
      SBA_PK4(lb0, 0, pa0); SBA_PK4(lb0, 8, pa1); SBA_PK4(lb1, 0, pa2); SBA_PK4(lb1, 8, pa3);
#undef SBA_PK4
      SBA_SBAR();
      const int vb = vb0 + cur * SHM_V;
      pv_one<0>(o[0], vb, pa0, pa1, pa2, pa3); pv_one<1>(o[1], vb, pa0, pa1, pa2, pa3); pv_one<2>(o[2], vb, pa0, pa1, pa2, pa3); pv_one<3>(o[3], vb, pa0, pa1, pa2, pa3);
      dead = !__any(carry > DEAD);
    }
    if (lane == 0) flags[cur * 8 + wid] = (kt > my_kt || !dead) ? 1u : 0u;
    if (kt > 0) { asm volatile("s_waitcnt vmcnt(0)" ::: "memory"); SBA_SWRITE(cur ^ 1); }
    __syncthreads();
    if (kt == 0) break;
    unsigned any = 0u;
#pragma unroll
    for (int w = 0; w < 8; ++w) any |= flags[cur * 8 + w];
    if (__builtin_amdgcn_readfirstlane(any) == 0u) break;
  }
  unsigned short* Ow = O + (rowbase + q0 + wid * QBLK) * LDR + h * D;
#pragma unroll
  for (int r = 0; r < 16; ++r) { const int orow = crow(r, hi);
#pragma unroll
    for (int d0 = 0; d0 < 4; ++d0) Ow[(long)orow * LDR + d0 * 32 + r32] = (unsigned short)(cvtpk(o[d0][r], 0.f) & 0xffffu); }
#undef SBA_SLOAD
#undef SBA_SWRITE
}
}
#define GAS __attribute__((address_space(1)))
#define LAS __attribute__((address_space(3)))
typedef unsigned short bf16;
typedef unsigned v4u __attribute__((ext_vector_type(4)));
typedef float f32x4 __attribute__((ext_vector_type(4)));
typedef short bf16x8 __attribute__((ext_vector_type(8)));
typedef GAS unsigned gu32;
typedef GAS unsigned long long gu64;
#define RLX_AGENT __ATOMIC_RELAXED, __HIP_MEMORY_SCOPE_AGENT
#define LDS_WAIT() asm volatile("s_waitcnt lgkmcnt(0)" ::: "memory")
#define VM_WAIT() asm volatile("s_waitcnt vmcnt(0)" ::: "memory")
__device__ __forceinline__ unsigned long long rt() { return __builtin_amdgcn_s_memrealtime(); }
__device__ __forceinline__ unsigned f2bf(float f) { unsigned u = __builtin_bit_cast(unsigned, f); return (u + 0x7fffu + ((u >> 16) & 1u)) >> 16; }
__device__ __forceinline__ unsigned pk2(float lo, float hi) { return f2bf(lo) | (f2bf(hi) << 16); }

#define XB_TMO      128
#define XB_XCNT(j)  (256  + 64 * (j))
#define XB_XSUB(j)  (1280 + 64 * (j))
#define XB_XGEN(j)  (2304 + 64 * (j))
#define XB_TOP      3328
#define XB_TOPGEN   3392
#define XCD_BAR_WORDS 3456
#define XB_SPIN_CAP (1u << 18)

__device__ __forceinline__ unsigned xb_ld(unsigned* p)              { return __hip_atomic_load(p, __ATOMIC_RELAXED, __HIP_MEMORY_SCOPE_AGENT); }
__device__ __forceinline__ unsigned xb_add(unsigned* p, unsigned v) { return __hip_atomic_fetch_add(p, v, __ATOMIC_RELAXED, __HIP_MEMORY_SCOPE_AGENT); }
__device__ __forceinline__ unsigned xb_xcc_id() { return (unsigned)__builtin_amdgcn_s_getreg((3 << 11) | 20) & 0xFu; }
#define XB_SPIN(cond, bar) do { unsigned _sp = 0; while (cond) { __builtin_amdgcn_s_sleep(1); \
    if ((++_sp & 255u) == 0u) { if (xb_ld(&(bar)[XB_TMO])) break; if (_sp > XB_SPIN_CAP) { atomicAdd(&(bar)[XB_TMO], 1u); break; } } } } while (0)

struct XcdBarrier {
    unsigned* bar; unsigned x;
    volatile LAS unsigned* st;
};

__device__ __forceinline__ XcdBarrier xcd_barrier_post(unsigned* bar, volatile LAS unsigned* st) {
    XcdBarrier b; b.bar = bar; b.x = xb_xcc_id(); b.st = st;
    if (threadIdx.x == 0) (void)xb_add(&bar[XB_XCNT(b.x)], 1u);
    return b;
}
__device__ __forceinline__ void xcd_barrier_complete(unsigned* bar, unsigned x, unsigned& nloc, unsigned& nx) {
    const unsigned G = gridDim.x * gridDim.y * gridDim.z;
    unsigned sum, cnt, mine, sp = 0u;
    for (;;) {
        sum = 0u; cnt = 0u; mine = 0u;
#pragma unroll
        for (unsigned j = 0; j < 16; ++j) { const unsigned c = xb_ld(&bar[XB_XCNT(j)]); sum += c; cnt += (c > 0u) ? 1u : 0u; mine = (j == x) ? c : mine; }
        if (sum == G) break;
        __builtin_amdgcn_s_sleep(1);
        if ((++sp & 255u) == 0u) { if (xb_ld(&bar[XB_TMO])) break; if (sp > XB_SPIN_CAP) { atomicAdd(&bar[XB_TMO], 1u); break; } }
    }
    nloc = mine > 0u ? mine : 1u; nx = cnt > 0u ? cnt : 1u;
}

__device__ __forceinline__ void xcd_barrier(const XcdBarrier& b) {
    asm volatile("s_waitcnt vmcnt(0)" ::: "memory");
    __syncthreads();
    if (threadIdx.x == 0) {
        unsigned* bar = b.bar;
        __builtin_amdgcn_s_waitcnt(0);
        unsigned nloc = b.st[0], nx = b.st[1];
        if (nloc == 0u) { xcd_barrier_complete(bar, b.x, nloc, nx); b.st[0] = nloc; b.st[1] = nx; }
        const unsigned old = xb_add(&bar[XB_XSUB(b.x)], 1u);
        const unsigned gen = old / nloc;
        if (old + 1u == (gen + 1u) * nloc) {
            __builtin_amdgcn_fence(__ATOMIC_RELEASE, "agent");
            asm volatile("s_waitcnt vmcnt(0)" ::: "memory");
            const unsigned og = xb_add(&bar[XB_TOP], 1u);
            const unsigned tg = og / nx;
            if (og + 1u == (tg + 1u) * nx) xb_add(&bar[XB_TOPGEN], 1u);
            else XB_SPIN(xb_ld(&bar[XB_TOPGEN]) == tg, bar);
            __builtin_amdgcn_fence(__ATOMIC_ACQUIRE, "agent");
            xb_add(&bar[XB_XGEN(b.x)], 1u);
            asm volatile("s_waitcnt vmcnt(0)" ::: "memory");
        } else {
            XB_SPIN(xb_ld(&bar[XB_XGEN(b.x)]) == gen, bar);
            __builtin_amdgcn_fence(__ATOMIC_ACQUIRE, "agent");
            asm volatile("s_waitcnt vmcnt(0)" ::: "memory");
        }
    }
    __syncthreads();
}

constexpr int NWAVES = 8;
constexpr int BATCH = 4, SEQ = 4096, DM = 2048, NH = 16, HD = 128, FF = 8192, DEPTH = 4, NMOD = 6;
constexpr int M = BATCH * SEQ;
constexpr int NMIX = 3 * DM;
constexpr float LN_EPS = 1e-5f;
constexpr float DN_ALPHA = 1.6817928305074290f;
constexpr float QSCALE = 0.088388347648318440f * 1.4426950408889634f;
constexpr int MODN = NMOD * DM;
constexpr int KSPLIT = 8;
constexpr size_t MiB = 1u << 20;
constexpr size_t WS_CTL = 0, CTL_ZERO_BYTES = 1 * MiB;
constexpr size_t WS_MODTAB = 1 * MiB;
constexpr size_t WS_PART = 2 * MiB;
constexpr size_t WS_W = 16 * MiB, W_LAYER = 96 * MiB, W_MIXIN = 0, W_MIXOUT = 24 * MiB, W_W1 = 32 * MiB, W_W2 = 64 * MiB;
constexpr size_t WS_H = 400 * MiB, WS_Q = 464 * MiB, WS_K = 528 * MiB, WS_V = 592 * MiB, WS_O = 656 * MiB;
constexpr size_t WS_HID = 720 * MiB, WS_END = 976 * MiB;
static_assert(WS_PART + (size_t)KSPLIT * DEPTH * BATCH * MODN * 4 <= WS_W && WS_W + DEPTH * W_LAYER <= WS_H && WS_HID + (size_t)M * FF * 2 <= WS_END, "d_ws map");
constexpr int CW_BAR = 4096;
constexpr int RING_OFF = 0, RING_BYTES = 131072;
constexpr int LDSCTL_OFF = RING_BYTES, MISC_OFF = LDSCTL_OFF + 320;
constexpr int LDS_BYTES = 147456;
static_assert(MISC_OFF + 128 <= LDS_BYTES && sba::LDS_BYTES <= RING_BYTES, "LDS map");

struct Frame {
    LAS unsigned char* lds;
    int tid, lane, wave, vcu, G;
};
__device__ __forceinline__ float wave_sum(float v) {
#pragma unroll
    for (int o = 1; o < 64; o <<= 1) v += __shfl_xor(v, o);
    return v;
}
__device__ __forceinline__ unsigned cvtpk_bf16(float lo, float hi) { unsigned r; asm volatile("v_cvt_pk_bf16_f32 %0, %1, %2" : "=v"(r) : "v"(lo), "v"(hi)); return r; }
__device__ __forceinline__ void p0_transpose_item(const float* W, int K, int N, bf16* WT, LAS float* scr, int item, int lane) {
    const int nblk = N / 32, kb = item / nblk, nb = item % nblk, k0 = 64 * kb, n0 = 32 * nb;
#pragma unroll 8
    for (int i = 0; i < 32; ++i) { const int kk = 2 * i + (lane >> 5); scr[kk * 33 + (lane & 31)] = W[(size_t)(k0 + kk) * N + n0 + (lane & 31)]; }
    LDS_WAIT(); asm volatile("" ::: "memory");
    const int c = lane & 7;
#pragma unroll
    for (int j = 0; j < 4; ++j) { const int n = (lane >> 3) + 8 * j; const LAS float* s = scr + (8 * c) * 33 + n;
        v4u o; o.x = cvtpk_bf16(s[0 * 33], s[1 * 33]); o.y = cvtpk_bf16(s[2 * 33], s[3 * 33]); o.z = cvtpk_bf16(s[4 * 33], s[5 * 33]); o.w = cvtpk_bf16(s[6 * 33], s[7 * 33]);
        *(v4u*)(WT + (size_t)(n0 + n) * K + k0 + 8 * c) = o; }
    LDS_WAIT(); asm volatile("" ::: "memory");
}

struct Args { const float* in[16]; float* out; unsigned char* ws; int ph_lo, ph_hi; };
constexpr int NPHASE = 2 + 7 * DEPTH;

__device__ __forceinline__ void phase_prologue_a(Frame& F, const Args& a) {
    const int gw = F.vcu * NWAVES + F.wave, NGW = F.G * NWAVES;
    LAS float* sil = (LAS float*)(F.lds + 69632);
    for (int e = F.tid; e < BATCH * DM; e += NWAVES * 64) { const int b = e / DM, k = e % DM; const float cv = a.in[1][e]; sil[k * 4 + b] = cv / (1.0f + __expf(-cv)); }
    __syncthreads();
    for (int task = gw; task < DEPTH * (MODN / 256) * KSPLIT; task += NGW) {
        const int l = task / ((MODN / 256) * KSPLIT), rem = task % ((MODN / 256) * KSPLIT), cb = rem / KSPLIT, kc = rem % KSPLIT;
        const float* W = a.in[2] + (size_t)l * DM * MODN + (size_t)(kc * 256) * MODN + cb * 256 + 4 * F.lane;
        f32x4 acc0 = {0.f, 0.f, 0.f, 0.f}, acc1 = acc0, acc2 = acc0, acc3 = acc0;
        for (int k0 = 0; k0 < 256; k0 += 8) {
            f32x4 w[8];
#pragma unroll
            for (int j = 0; j < 8; ++j) w[j] = *(const f32x4*)(W + (size_t)(k0 + j) * MODN);
#pragma unroll
            for (int j = 0; j < 8; ++j) { const f32x4 s = *(const LAS f32x4*)(sil + (kc * 256 + k0 + j) * 4); acc0 += w[j] * s[0]; acc1 += w[j] * s[1]; acc2 += w[j] * s[2]; acc3 += w[j] * s[3]; }
        }
        float* P = (float*)(a.ws + WS_PART) + ((size_t)(kc * DEPTH + l) * BATCH) * MODN + cb * 256 + 4 * F.lane;
        *(f32x4*)(P) = acc0; *(f32x4*)(P + MODN) = acc1; *(f32x4*)(P + 2 * MODN) = acc2; *(f32x4*)(P + 3 * MODN) = acc3;
    }
    LAS float* scr = (LAS float*)(F.lds + F.wave * 8704);
    constexpr int I_IN = (DM / 64) * (NMIX / 32), I_OUT = (DM / 64) * (DM / 32), I_1 = (DM / 64) * (FF / 32), I_2 = (FF / 64) * (DM / 32), I_LAYER = I_IN + I_OUT + I_1 + I_2;
    for (int it = gw; it < DEPTH * I_LAYER; it += NGW) {
        const int l = it / I_LAYER; int r = it % I_LAYER; const int j = l >> 1;
        bf16* wl = (bf16*)(a.ws + WS_W + (size_t)l * W_LAYER);
        if (r < I_IN) { const float* src = (l & 1) ? a.in[8] + (size_t)j * DM * NMIX : a.in[6] + (size_t)j * DM * NMIX; p0_transpose_item(src, DM, NMIX, (bf16*)((unsigned char*)wl + W_MIXIN), scr, r, F.lane); continue; } r -= I_IN;
        if (r < I_OUT) { const float* src = (l & 1) ? a.in[11] + (size_t)j * DM * DM : a.in[7] + (size_t)j * DM * DM; p0_transpose_item(src, DM, DM, (bf16*)((unsigned char*)wl + W_MIXOUT), scr, r, F.lane); continue; } r -= I_OUT;
        if (r < I_1) { p0_transpose_item(a.in[12] + (size_t)l * DM * FF, DM, FF, (bf16*)((unsigned char*)wl + W_W1), scr, r, F.lane); continue; } r -= I_1;
        p0_transpose_item(a.in[14] + (size_t)l * FF * DM, FF, DM, (bf16*)((unsigned char*)wl + W_W2), scr, r, F.lane);
    }
}
__device__ __forceinline__ void phase_prologue_b(Frame& F, const Args& a) {
    const float* part = (const float*)(a.ws + WS_PART); float* modtab = (float*)(a.ws + WS_MODTAB); const float* mod_b = a.in[3];
    for (int e = F.vcu * NWAVES * 64 + F.tid; e < DEPTH * BATCH * MODN; e += F.G * NWAVES * 64) {
        const int l = e / (BATCH * MODN), rem = e % (BATCH * MODN), b = rem / MODN, n = rem % MODN;
        float s = mod_b[l * MODN + n];
#pragma unroll
        for (int kc = 0; kc < KSPLIT; ++kc) s += part[((size_t)(kc * DEPTH + l) * BATCH + b) * MODN + n];
        if ((n / DM) % 3 != 0) s += 1.0f;
        modtab[e] = s;
    }
    const int rows_wg = M / F.G, row0 = F.vcu * rows_wg, b = row0 / SEQ;
    LAS float* ST = (LAS float*)(F.lds);
    for (int c = F.tid; c < 2 * DM; c += NWAVES * 64) {
        float s = mod_b[c];
#pragma unroll
        for (int kc = 0; kc < KSPLIT; ++kc) s += part[((size_t)(kc * DEPTH + 0) * BATCH + b) * MODN + c];
        ST[c] = (c >= DM) ? s + 1.0f : s;
    }
    __syncthreads();
    const int rows_wave = rows_wg / NWAVES;
    for (int r = 0; r < rows_wave; ++r) {
        const size_t row = (size_t)row0 + F.wave * rows_wave + r;
        const float* xr = a.in[0] + row * DM; float* orow = a.out + row * DM; bf16* hr = (bf16*)(a.ws + WS_H) + row * DM;
#pragma unroll
        for (int j = 0; j < 8; ++j) { const int col = 4 * F.lane + 256 * j; const f32x4 v = *(const f32x4*)(xr + col);
            const f32x4 T = *(const LAS f32x4*)(ST + col), S = *(const LAS f32x4*)(ST + DM + col); const f32x4 hv = v * S + T;
            *(f32x4*)(orow + col) = v; uint2 w; w.x = cvtpk_bf16(hv[0], hv[1]); w.y = cvtpk_bf16(hv[2], hv[3]); *(uint2*)(hr + col) = w; }
    }
}
__device__ __forceinline__ void phase_ln(Frame& F, const Args& a, const float* lg, const float* lb, const float* Tn, const float* Sn, bool write_h) {
    const int rows_wg = M / F.G, row0 = F.vcu * rows_wg, b = row0 / SEQ, rows_wave = rows_wg / NWAVES;
    f32x4 g4[8], b4[8], A4[8], B4[8];
#pragma unroll
    for (int j = 0; j < 8; ++j) { const int col = 4 * F.lane + 256 * j; g4[j] = *(const f32x4*)(lg + col); b4[j] = *(const f32x4*)(lb + col);
        const f32x4 S = *(const f32x4*)(Sn + (size_t)b * MODN + col), T = *(const f32x4*)(Tn + (size_t)b * MODN + col); A4[j] = g4[j] * S; B4[j] = b4[j] * S + T; }
    for (int r = 0; r < rows_wave; ++r) {
        const size_t row = (size_t)row0 + F.wave * rows_wave + r;
        float* xr = a.out + row * DM; bf16* hr = (bf16*)(a.ws + WS_H) + row * DM;
        f32x4 v[8]; float s = 0.f;
#pragma unroll
        for (int j = 0; j < 8; ++j) { v[j] = *(const f32x4*)(xr + 4 * F.lane + 256 * j); s += (v[j][0] + v[j][1]) + (v[j][2] + v[j][3]); }
        const float mean = wave_sum(s) * (1.0f / DM); float s2 = 0.f;
#pragma unroll
        for (int j = 0; j < 8; ++j) { v[j] = v[j] - mean; s2 += (v[j][0] * v[j][0] + v[j][1] * v[j][1]) + (v[j][2] * v[j][2] + v[j][3] * v[j][3]); }
        const float rstd = 1.0f / sqrtf(wave_sum(s2) * (1.0f / DM) + LN_EPS);
#pragma unroll
        for (int j = 0; j < 8; ++j) { const int col = 4 * F.lane + 256 * j; const f32x4 xn = v[j] * rstd;
            *(f32x4*)(xr + col) = xn * g4[j] + b4[j];
            if (write_h) { const f32x4 hv = xn * A4[j] + B4[j]; uint2 w; w.x = cvtpk_bf16(hv[0], hv[1]); w.y = cvtpk_bf16(hv[2], hv[3]); *(uint2*)(hr + col) = w; } }
    }
}
__device__ __forceinline__ void bf8_to_f32(const bf16x8 v, float (&f)[8]) {
#pragma unroll
    for (int i = 0; i < 8; ++i) f[i] = __uint_as_float(((unsigned)(unsigned short)v[i]) << 16);
}
__device__ __forceinline__ void phase_conv(Frame& F, const Args& a, const float* cw, const float* cb) {
    const bf16* Bg = (const bf16*)(a.ws + WS_Q); const bf16* Cg = (const bf16*)(a.ws + WS_K); const bf16* Ug = (const bf16*)(a.ws + WS_V); bf16* Out = (bf16*)(a.ws + WS_O);
    constexpr int TT = 8, NTASK = (M / TT) * (DM / 8);
    for (int task = F.vcu * NWAVES * 64 + F.tid; task < NTASK; task += F.G * NWAVES * 64) {
        const int chunk = task & (DM / 8 - 1), run = task / (DM / 8), ch0 = chunk * 8, m0 = run * TT; const bool first = (m0 % SEQ) == 0;
        float w0[8], w1[8], w2[8], bb[8];
#pragma unroll
        for (int i = 0; i < 8; ++i) { w0[i] = cw[ch0 + i]; w1[i] = cw[DM + ch0 + i]; w2[i] = cw[2 * DM + ch0 + i]; bb[i] = cb[ch0 + i]; }
        float g2[8], g1[8];
        { float c[8], u[8];
          if (first) {
#pragma unroll
              for (int i = 0; i < 8; ++i) { g2[i] = 0.f; g1[i] = 0.f; }
          } else {
              bf8_to_f32(*(const bf16x8*)(Cg + (size_t)(m0 - 2) * DM + ch0), c); bf8_to_f32(*(const bf16x8*)(Ug + (size_t)(m0 - 2) * DM + ch0), u);
#pragma unroll
              for (int i = 0; i < 8; ++i) g2[i] = c[i] * u[i];
              bf8_to_f32(*(const bf16x8*)(Cg + (size_t)(m0 - 1) * DM + ch0), c); bf8_to_f32(*(const bf16x8*)(Ug + (size_t)(m0 - 1) * DM + ch0), u);
#pragma unroll
              for (int i = 0; i < 8; ++i) g1[i] = c[i] * u[i];
          } }
#pragma unroll
        for (int t = 0; t < TT; ++t) {
            float c[8], u[8], bg[8], g0[8], y[8];
            bf8_to_f32(*(const bf16x8*)(Cg + (size_t)(m0 + t) * DM + ch0), c); bf8_to_f32(*(const bf16x8*)(Ug + (size_t)(m0 + t) * DM + ch0), u); bf8_to_f32(*(const bf16x8*)(Bg + (size_t)(m0 + t) * DM + ch0), bg);
#pragma unroll
            for (int i = 0; i < 8; ++i) { g0[i] = c[i] * u[i]; y[i] = bg[i] * (w0[i] * g2[i] + w1[i] * g1[i] + w2[i] * g0[i] + bb[i]); g2[i] = g1[i]; g1[i] = g0[i]; }
            v4u o; o.x = cvtpk_bf16(y[0], y[1]); o.y = cvtpk_bf16(y[2], y[3]); o.z = cvtpk_bf16(y[4], y[5]); o.w = cvtpk_bf16(y[6], y[7]);
            *(v4u*)(Out + (size_t)(m0 + t) * DM + ch0) = o;
        }
    }
}

#ifndef MK_DIS
#define MK_DIS 0
#endif
__global__ void __launch_bounds__(NWAVES * 64, 2) mk_fwd(Args args) {
    extern __shared__ __attribute__((aligned(16))) unsigned char lds[];
    Frame F;
    F.lds = (LAS unsigned char*)lds;
    volatile LAS unsigned* MISC = (volatile LAS unsigned*)(F.lds + MISC_OFF);
    F.tid = threadIdx.x; F.lane = F.tid & 63; F.wave = __builtin_amdgcn_readfirstlane(F.tid >> 6);
    F.G = gridDim.x; { const int bx = blockIdx.x; F.vcu = (F.G % 8 == 0) ? (bx % 8) * (F.G / 8) + bx / 8 : bx; }
    unsigned char* ws = args.ws;
    for (int u = F.tid; u < (LDS_BYTES - LDSCTL_OFF) / 4; u += NWAVES * 64) ((LAS unsigned*)(F.lds + LDSCTL_OFF))[u] = 0u;
    __syncthreads();
    XcdBarrier bar = xcd_barrier_post((unsigned*)(ws + WS_CTL) + CW_BAR, MISC + 8);
    const int lo = args.ph_lo, hi = args.ph_hi;
#define FRESH() do { int t_ = threadIdx.x; asm volatile("" : "+v"(t_)); F.tid = t_; F.lane = t_ & 63; F.wave = __builtin_amdgcn_readfirstlane(t_ >> 6); } while (0)
#define IN(k) (lo <= (k) && (k) < hi)
#define SEAM(k) do { if ((k) + 1 < hi) xcd_barrier(bar); } while (0)
    float* modtab = (float*)(ws + WS_MODTAB);
    bf16* Hb = (bf16*)(ws + WS_H); bf16* Qb = (bf16*)(ws + WS_Q); bf16* Kb = (bf16*)(ws + WS_K); bf16* Vb = (bf16*)(ws + WS_V); bf16* Ob = (bf16*)(ws + WS_O); bf16* HIDb = (bf16*)(ws + WS_HID);

    if (IN(0)) {
#if !(MK_DIS & 1)
        FRESH(); phase_prologue_a(F, args);
#endif
        SEAM(0); }
    if (IN(1)) {
#if !(MK_DIS & 2)
        FRESH(); phase_prologue_b(F, args);
#endif
        SEAM(1); }
    for (int l = 0; l < DEPTH; ++l) {
        const int pb = 2 + 7 * l, j = l >> 1; const bool is_conv = (l & 1) != 0;
        const unsigned char* wl = ws + WS_W + (size_t)l * W_LAYER;
        const float* mt = modtab + (size_t)l * BATCH * MODN;
        if (IN(pb + 0)) {
            pg8::Gemm g{Hb, (const bf16*)(wl + W_MIXIN), M, NMIX, DM}; pg8::StaticOrder S; S.init(M, NMIX, F.G, (int)blockIdx.x);
            pg8::EpiBf16<0> E{Qb, DM, nullptr, DM, (size_t)(WS_K - WS_Q) / 2, is_conv ? 1.0f : QSCALE};

#if !(MK_DIS & 4)
            pg8::gemm_phase<pg8::EpiBf16<0>, pg8::StaticOrder, true, true>(F.lds + RING_OFF, g, S, E);
#endif

            SEAM(pb + 0);
        }
        if (IN(pb + 1)) {
            if (is_conv) {

#if !(MK_DIS & 16)
                FRESH(); phase_conv(F, args, args.in[9] + (size_t)j * 3 * DM, args.in[10] + (size_t)j * DM);
#endif

            } else {

#if !(MK_DIS & 8)
                const int nunits = BATCH * NH * (SEQ / sba::UNIT_ROWS);
                for (int u = F.vcu; u < nunits; u += F.G) { const int bh = u / (SEQ / sba::UNIT_ROWS), qb = u % (SEQ / sba::UNIT_ROWS);
                    sba::attn_unit(bh / NH, bh % NH, qb, Qb, Kb, Vb, Ob, (LAS char*)(F.lds + RING_OFF)); }
#endif

            }
            SEAM(pb + 1);
        }
        if (IN(pb + 2)) {
            pg8::Gemm g{Ob, (const bf16*)(wl + W_MIXOUT), M, DM, DM}; pg8::StaticOrder S; S.init(M, DM, F.G, (int)blockIdx.x);
            pg8::EpiResid E{args.out, DM, nullptr, mt + 2 * DM, MODN, SEQ, DN_ALPHA};

#if !(MK_DIS & 32)
            pg8::gemm_phase<pg8::EpiResid, pg8::StaticOrder, true, true>(F.lds + RING_OFF, g, S, E);
            SEAM(pb + 2);
#endif

        }
        if (IN(pb + 3)) {
#if !(MK_DIS & 64)
            FRESH(); phase_ln(F, args, args.in[4] + (size_t)(l * 2 + 0) * DM, args.in[5] + (size_t)(l * 2 + 0) * DM, mt + 3 * DM, mt + 4 * DM, true);
#endif
            SEAM(pb + 3); }
        if (IN(pb + 4)) {
            pg8::Gemm g{Hb, (const bf16*)(wl + W_W1), M, FF, DM}; pg8::StaticOrder S; S.init(M, FF, F.G, (int)blockIdx.x);
            pg8::EpiBf16<3> E{HIDb, FF, args.in[13] + (size_t)l * FF, 0, 0, 1.f};

#if !(MK_DIS & 128)
            pg8::gemm_phase<pg8::EpiBf16<3>, pg8::StaticOrder, true, true>(F.lds + RING_OFF, g, S, E);
#endif

            SEAM(pb + 4);
        }
        if (IN(pb + 5)) {
            pg8::Gemm g{HIDb, (const bf16*)(wl + W_W2), M, DM, FF}; pg8::StaticOrder S; S.init(M, DM, F.G, (int)blockIdx.x);
            pg8::EpiResid E{args.out, DM, args.in[15] + (size_t)l * DM, mt + 5 * DM, MODN, SEQ, DN_ALPHA};

#if !(MK_DIS & 256)
            pg8::gemm_phase<pg8::EpiResid, pg8::StaticOrder, true, true>(F.lds + RING_OFF, g, S, E);
            SEAM(pb + 5);
#endif

        }
        if (IN(pb + 6)) { const int nl = (l + 1 < DEPTH) ? l + 1 : l; const float* mtn = modtab + (size_t)nl * BATCH * MODN;

#if !(MK_DIS & 512)
            FRESH(); phase_ln(F, args, args.in[4] + (size_t)(l * 2 + 1) * DM, args.in[5] + (size_t)(l * 2 + 1) * DM, mtn + 0 * DM, mtn + 1 * DM, l + 1 < DEPTH);
#endif
            SEAM(pb + 6); }
    }
#undef IN
#undef SEAM
}

#ifndef MK_PER_PHASE
#define MK_PER_PHASE 0
#endif
extern "C" void kernel_launch(void* const* d_in, const int* in_sizes, int n_in, void* d_out, int out_size, void* d_ws, size_t ws_size, hipStream_t stream) {
    static int grid = 0;
    if (grid == 0) {
        if (n_in != 16 || in_sizes[0] != M * DM || out_size != M * DM || ws_size < WS_END) { fprintf(stderr, "kernel_launch: unexpected shapes (n_in %d, in0 %d, out %d, ws %zu); nothing launched\n", n_in, n_in > 0 ? in_sizes[0] : -1, out_size, ws_size); grid = -1; return; }
        int dev = 0, cus = 0, per_cu = 0;
        if (hipGetDevice(&dev) != hipSuccess || hipDeviceGetAttribute(&cus, hipDeviceAttributeMultiprocessorCount, dev) != hipSuccess) { fprintf(stderr, "kernel_launch: device query failed\n"); grid = -1; return; }
        if (hipFuncSetAttribute((const void*)mk_fwd, hipFuncAttributeMaxDynamicSharedMemorySize, LDS_BYTES) != hipSuccess) { fprintf(stderr, "kernel_launch: hipFuncSetAttribute failed\n"); grid = -1; return; }
        if (hipOccupancyMaxActiveBlocksPerMultiprocessor(&per_cu, (const void*)mk_fwd, NWAVES * 64, LDS_BYTES) != hipSuccess || per_cu < 1) { fprintf(stderr, "kernel_launch: occupancy query reports %d workgroups per CU\n", per_cu); }
        (void)hipGetLastError();
        grid = cus;
        if (grid > 256) grid = 256;
        if (grid != 256 && grid != 128 && grid != 64) { fprintf(stderr, "kernel_launch: %d CUs: this kernel deals rows in M/grid blocks and needs 64, 128 or 256 workgroups; nothing launched\n", grid); grid = -1; return; }
    }
    if (grid < 0) return;
    if (hipMemsetAsync((char*)d_ws + WS_CTL, 0, CTL_ZERO_BYTES, stream) != hipSuccess) { fprintf(stderr, "kernel_launch: memset failed\n"); return; }
    Args a{};
    for (int i = 0; i < 16; ++i) a.in[i] = (const float*)d_in[i];
    a.out = (float*)d_out; a.ws = (unsigned char*)d_ws;
#if MK_PER_PHASE
    for (int p = 0; p < NPHASE; ++p) { a.ph_lo = p; a.ph_hi = p + 1; hipLaunchKernelGGL(mk_fwd, dim3(grid), dim3(NWAVES * 64), LDS_BYTES, stream, a); }
#else
    a.ph_lo = 0; a.ph_hi = NPHASE;
    hipLaunchKernelGGL(mk_fwd, dim3(grid), dim3(NWAVES * 64), LDS_BYTES, stream, a);
#endif
    const hipError_t le = hipPeekAtLastError();
    if (le != hipSuccess) fprintf(stderr, "kernel_launch: launch failed: %s\n", hipGetErrorName(le));
}
```

```cpp
#include <hip/hip_runtime.h>
#include <hip/hip_bf16.h>
#include <cstdio>
#include <cstdint>
namespace pg8 {
#define PG8_LAS __attribute__((address_space(3)))
typedef unsigned short bf16_t;
typedef short bf16x8 __attribute__((ext_vector_type(8)));
typedef float f32x4 __attribute__((ext_vector_type(4)));
typedef unsigned u32x4 __attribute__((ext_vector_type(4)));
constexpr int BM = 256, BK = 64, HALF = 128, HTB = HALF * BK * 2  , STAGE_BYTES = 8 * HTB, NXCD = 8, WGM = 8;

__host__ __device__ __forceinline__ int lds_byte(int r, int c) { const int st = (r >> 4) * 2 + (c >> 5), rr = r & 15, cc = c & 31, ob = rr * 64 + cc * 2; return st * 1024 + (ob ^ (((ob >> 9) & 1) << 5)); }
__host__ __device__ __forceinline__ void stage_rc(int b, int& R, int& C) { const int st = b / 1024, sb = b % 1024, swz = sb ^ (((sb >> 9) & 1) << 5); R = (st >> 1) * 16 + swz / 64; C = (st & 1) * 32 + (swz % 64) / 2; }
__host__ __device__ __forceinline__ int perm32(int rho) { const int n = rho >> 4, i = rho & 15; return 8 * (i >> 2) + 4 * n + (i & 3); }

typedef float f32x16 __attribute__((ext_vector_type(16)));
__host__ __device__ __forceinline__ int lds_byte2(int r, int c) { const int rb = r >> 4, rr = r & 15, h = c >> 5, ch = (c & 31) >> 3; return (rb * 2 + h) * 1024 + rr * 64 + ((ch ^ ((rr >> 2) & 3)) << 4) + (c & 7) * 2; }
__host__ __device__ __forceinline__ void stage_rc2(int b, int& R, int& C) { const int p = b / 1024, l = (b % 1024) / 16, rr = l >> 2, cs = l & 3, ch = cs ^ ((rr >> 2) & 3); R = (p >> 1) * 16 + rr; C = (p & 1) * 32 + ch * 8; }
__host__ __device__ __forceinline__ int perm32b(int rho) { return (rho & 3) | (((rho >> 3) & 1) << 2) | (((rho >> 2) & 1) << 3) | (rho & 16); }

__host__ __device__ __forceinline__ int adj16_row(int bj, int R) { return 64 * (R >> 5) + 16 * ((R & 15) >> 2) + 8 * bj + 4 * ((R >> 4) & 1) + (R & 3); }
typedef int i32x8 __attribute__((ext_vector_type(8)));
typedef int i32x4 __attribute__((ext_vector_type(4)));
__device__ __forceinline__ i32x8 frag32(bf16x8 lo, bf16x8 hi) { const i32x4 a = __builtin_bit_cast(i32x4, lo), b = __builtin_bit_cast(i32x4, hi); return __builtin_shufflevector(a, b, 0, 1, 2, 3, 4, 5, 6, 7); }
__device__ __forceinline__ void mfma_fp8_tied(f32x4& acc, const i32x8 a, const i32x8 b, const int scl) {
    asm volatile("v_mfma_scale_f32_16x16x128_f8f6f4 %0, %1, %2, %0, %3, %3 op_sel_hi:[0,0,0]" : "+v"(acc) : "v"(a), "v"(b), "v"(scl));
}
struct Unit { int pm, pn; };
struct Gemm { const bf16_t* A; const bf16_t* Bt; int M, N, K; };

struct StaticOrder {
    int nM, nN, nwg, G, c;
    __host__ __device__ void init(int M, int N, int G_, int c_) { nM = M / BM; nN = N / BM; nwg = nM * nN; G = G_; c = c_; }
    __host__ __device__ bool next(int i, Unit& u) const {
        const long L = (long)i * G + c; if (L >= nwg) return false;
        int wgid = (int)L; { const int q = nwg / NXCD, r = nwg % NXCD, xcd = wgid % NXCD, off = wgid / NXCD; wgid = (xcd < r ? xcd * (q + 1) : r * (q + 1) + (xcd - r) * q) + off; }
        const int nig = WGM * nN, gid = wgid / nig, fm = gid * WGM, gsz = (nM - fm) < WGM ? (nM - fm) : WGM;
        u.pm = fm + ((wgid % nig) % gsz); u.pn = (wgid % nig) / gsz; return true;
    }
    __device__ __forceinline__ void a_ready(const Unit&) const {}
    __device__ __forceinline__ void done(const Unit&) const {}
};

__device__ __forceinline__ unsigned cvt_pk_bf16(float lo, float hi) { unsigned r; asm volatile("v_cvt_pk_bf16_f32 %0, %1, %2" : "=v"(r) : "v"(lo), "v"(hi)); return r; }
typedef float f32x2 __attribute__((ext_vector_type(2)));
#ifndef MK_WT
#define MK_WT 0
#endif
__device__ __forceinline__ void store16_wt(void* p, u32x4 v) {
#if MK_WT
    asm volatile("global_store_dwordx4 %0, %1, off sc1" :: "v"(p), "v"(v) : "memory");
#else
    *(u32x4*)p = v;
#endif
}

template <int ACT, bool HAS_BIAS> struct EpiBf16 {
    static constexpr bool PERM = true, AFTER_DRAIN = false; static constexpr int BPERM = 1; static_assert(ACT == 0 || ACT == 3, "EpiBf16: ACT is 0 (none) or 3 (squared relu)");
    int row_mask;
    bf16_t* O; int ldc; const float* bias; int split_cols; size_t split_stride;
    __device__ __forceinline__ void operator()(const f32x4 (&acc)[2][2][4][2], const Unit& u, int wr, int wc, int fr, int fq) const {
        const int row0 = (u.pm * BM + wr * 64 + fr) & row_mask; int colt = u.pn * BM; bf16_t* base = O;
        if (split_cols) { const int t = colt / split_cols; base += (size_t)t * split_stride; colt -= t * split_cols; }
        const int col0 = colt + wc * 32 + 8 * fq, bcol0 = u.pn * BM + wc * 32 + 8 * fq;
        f32x4 bv[2][2];
        if constexpr (HAS_BIAS) { int bcolv = bcol0; asm volatile("" : "+v"(bcolv));
#pragma unroll
            for (int bj = 0; bj < 2; ++bj)
#pragma unroll
                for (int n = 0; n < 2; ++n) bv[bj][n] = *(const f32x4*)(bias + bcolv + bj * HALF + 4 * n);
        }
#pragma unroll
        for (int ai = 0; ai < 2; ++ai)
#pragma unroll
            for (int m = 0; m < 4; ++m) { bf16_t* rowp = base + (size_t)(row0 + ai * HALF + m * 16) * ldc + col0;
#pragma unroll
                for (int bj = 0; bj < 2; ++bj) { f32x4 v0 = acc[ai][bj][m][0], v1 = acc[ai][bj][m][1];
                    if constexpr (HAS_BIAS) { v0 = v0 + bv[bj][0]; v1 = v1 + bv[bj][1]; }
                    if (ACT == 3) {
#pragma unroll
                        for (int j = 0; j < 4; ++j) { const float a = fmaxf(v0[j], 0.f), b = fmaxf(v1[j], 0.f); v0[j] = a * a; v1[j] = b * b; } }
                    u32x4 w; w.x = cvt_pk_bf16(v0[0], v0[1]); w.y = cvt_pk_bf16(v0[2], v0[3]); w.z = cvt_pk_bf16(v1[0], v1[1]); w.w = cvt_pk_bf16(v1[2], v1[3]);
                    store16_wt(rowp + bj * HALF, w); } }
    }
};
struct EpiResid {
    static constexpr bool PERM = false, AFTER_DRAIN = false; static constexpr int BPERM = 0;
    float* X; int ldc; const float* bias; const float* gate; int gate_bstride; int rows_per_batch; float alpha; long out_off;
    __device__ __forceinline__ void operator()(const f32x4 (&acc)[2][2][4][2], const Unit& u, int wr, int wc, int fr, int fq) const {
        const int row0 = u.pm * BM + wr * 64 + fr, col0 = u.pn * BM + wc * 32 + 4 * fq;
        const float* gp = gate + (size_t)((u.pm * BM) / rows_per_batch) * gate_bstride;
        f32x4 bv[2][2], gv[2][2];
#pragma unroll
        for (int bj = 0; bj < 2; ++bj)
#pragma unroll
            for (int n = 0; n < 2; ++n) { bv[bj][n] = bias ? *(const f32x4*)(bias + col0 + bj * HALF + n * 16) : (f32x4){0.f, 0.f, 0.f, 0.f}; gv[bj][n] = *(const f32x4*)(gp + col0 + bj * HALF + n * 16); }
#pragma unroll
        for (int ai = 0; ai < 2; ++ai)
#pragma unroll
            for (int m = 0; m < 4; ++m) { float* rowp = X + (size_t)(row0 + ai * HALF + m * 16) * ldc + col0;
#pragma unroll
                for (int bj = 0; bj < 2; ++bj)
#pragma unroll
                    for (int n = 0; n < 2; ++n) { const f32x4 xo = *(const f32x4*)(rowp + bj * HALF + n * 16); *(f32x4*)(rowp + out_off + bj * HALF + n * 16) = xo * alpha + gv[bj][n] * (acc[ai][bj][m][n] + bv[bj][n]); }
                if (m & 1) asm volatile("" ::: "memory"); }
    }
};


template <bool HAS_BIAS, bool SCALED = false> struct EpiGateBf16 {
    static constexpr bool PERM = true, AFTER_DRAIN = false; static constexpr int BPERM = 1;
    bf16_t* O; int ldc; const float* bias; const float* gate; int gate_bstride; int rows_per_batch; float ascale;
    __device__ __forceinline__ void operator()(const f32x4 (&acc)[2][2][4][2], const Unit& u, int wr, int wc, int fr, int fq) const {
        const int row0 = u.pm * BM + wr * 64 + fr, col0 = u.pn * BM + wc * 32 + 8 * fq;
        const float* gp = gate + (size_t)((u.pm * BM) / rows_per_batch) * gate_bstride;
        int colv = col0; asm volatile("" : "+v"(colv));
        f32x4 bv[2][2], gv[2][2];
#pragma unroll
        for (int bj = 0; bj < 2; ++bj)
#pragma unroll
            for (int n = 0; n < 2; ++n) { if constexpr (HAS_BIAS) bv[bj][n] = *(const f32x4*)(bias + colv + bj * HALF + 4 * n); gv[bj][n] = *(const f32x4*)(gp + colv + bj * HALF + 4 * n); }
#pragma unroll
        for (int ai = 0; ai < 2; ++ai)
#pragma unroll
            for (int m = 0; m < 4; ++m) { bf16_t* rowp = O + (size_t)(row0 + ai * HALF + m * 16) * ldc + col0;
#pragma unroll
                for (int bj = 0; bj < 2; ++bj) { f32x4 v0 = acc[ai][bj][m][0], v1 = acc[ai][bj][m][1]; if constexpr (SCALED) { v0 = v0 * ascale; v1 = v1 * ascale; } if constexpr (HAS_BIAS) { v0 = v0 + bv[bj][0]; v1 = v1 + bv[bj][1]; } v0 = v0 * gv[bj][0]; v1 = v1 * gv[bj][1];
                    u32x4 w; w.x = cvt_pk_bf16(v0[0], v0[1]); w.y = cvt_pk_bf16(v0[2], v0[3]); w.z = cvt_pk_bf16(v1[0], v1[1]); w.w = cvt_pk_bf16(v1[2], v1[3]);
                    store16_wt(rowp + bj * HALF, w); } }
    }
};

struct EpiConvIn {
    static constexpr bool PERM = true, AFTER_DRAIN = false; static constexpr int BPERM = 1;
    bf16_t* Gt; bf16_t* Bg; int ldc; int CT;
    __device__ __forceinline__ void operator()(const f32x4 (&acc)[2][2][4][2], const Unit& u, int wr, int wc, int fr, int fq) const {
        const int row0 = u.pm * BM + wr * 64 + fr;
        if (u.pn < CT) {
            const int col0 = u.pn * HALF + wc * 32 + 8 * fq;
#pragma unroll
            for (int ai = 0; ai < 2; ++ai)
#pragma unroll
                for (int m = 0; m < 4; ++m) { const f32x4 v0 = acc[ai][0][m][0] * acc[ai][1][m][0], v1 = acc[ai][0][m][1] * acc[ai][1][m][1];
                    u32x4 w; w.x = cvt_pk_bf16(v0[0], v0[1]); w.y = cvt_pk_bf16(v0[2], v0[3]); w.z = cvt_pk_bf16(v1[0], v1[1]); w.w = cvt_pk_bf16(v1[2], v1[3]);
                    store16_wt(Gt + (size_t)(row0 + ai * HALF + m * 16) * ldc + col0, w); }
        } else {
            const int col0 = (u.pn - CT) * BM + wc * 32 + 8 * fq;
#pragma unroll
            for (int ai = 0; ai < 2; ++ai)
#pragma unroll
                for (int m = 0; m < 4; ++m) { bf16_t* rowp = Bg + (size_t)(row0 + ai * HALF + m * 16) * ldc + col0;
#pragma unroll
                    for (int bj = 0; bj < 2; ++bj) { const f32x4 v0 = acc[ai][bj][m][0], v1 = acc[ai][bj][m][1];
                        u32x4 w; w.x = cvt_pk_bf16(v0[0], v0[1]); w.y = cvt_pk_bf16(v0[2], v0[3]); w.z = cvt_pk_bf16(v1[0], v1[1]); w.w = cvt_pk_bf16(v1[2], v1[3]);
                        store16_wt(rowp + bj * HALF, w); } }
        }
    }
};

struct EpiFp8Relu2 {
    static constexpr bool PERM = true, AFTER_DRAIN = false; static constexpr int BPERM = 2;
    unsigned char* O8; int ldc; const float* bias; float oscale;
    __device__ __forceinline__ void operator()(const f32x4 (&acc)[2][2][4][2], const Unit& u, int wr, int wc, int fr, int fq) const {
        const int row0 = u.pm * BM + wr * 64 + fr, col0 = u.pn * BM + wc * 64 + 16 * fq;
        int colv = col0; asm volatile("" : "+v"(colv));
        f32x4 bv[2][2];
#pragma unroll
        for (int bj = 0; bj < 2; ++bj)
#pragma unroll
            for (int n = 0; n < 2; ++n) bv[bj][n] = *(const f32x4*)(bias + colv + 8 * bj + 4 * n);
#pragma unroll
        for (int ai = 0; ai < 2; ++ai)
#pragma unroll
            for (int m = 0; m < 4; ++m) { u32x4 w;
#pragma unroll
                for (int bj = 0; bj < 2; ++bj)
#pragma unroll
                    for (int n = 0; n < 2; ++n) { f32x4 v = acc[ai][bj][m][n] + bv[bj][n];
#pragma unroll
                        for (int j = 0; j < 4; ++j) { const float a = fmaxf(v[j], 0.f); v[j] = fminf(a * a * oscale, 448.0f); }
                        int p = 0; p = __builtin_amdgcn_cvt_pk_fp8_f32(v[0], v[1], p, false); p = __builtin_amdgcn_cvt_pk_fp8_f32(v[2], v[3], p, true); w[2 * bj + n] = (unsigned)p; }
                *(u32x4*)(O8 + (size_t)(row0 + ai * HALF + m * 16) * ldc + col0) = w; }
    }
};

struct EpiI8Fp8Relu2 {
    static constexpr bool PERM = true, AFTER_DRAIN = false; static constexpr int BPERM = 2;
    unsigned char* O8; int ldc; const float* bias; const float* rowscale; const float* colscale; float oscale;
    __device__ __forceinline__ void operator()(const f32x4 (&acc)[2][2][4][2], const Unit& u, int wr, int wc, int fr, int fq) const {
        const int row0 = u.pm * BM + wr * 64 + fr, col0 = u.pn * BM + wc * 64 + 16 * fq;
        int colv = col0; asm volatile("" : "+v"(colv));
        const float sq = sqrtf(oscale);
        f32x4 bv[2][2], cv[2][2];
#pragma unroll
        for (int bj = 0; bj < 2; ++bj)
#pragma unroll
            for (int n = 0; n < 2; ++n) { bv[bj][n] = *(const f32x4*)(bias + colv + 8 * bj + 4 * n); cv[bj][n] = *(const f32x4*)(colscale + colv + 8 * bj + 4 * n); }
        float rsv[2][4];
#pragma unroll
        for (int ai = 0; ai < 2; ++ai)
#pragma unroll
            for (int m = 0; m < 4; ++m) rsv[ai][m] = rowscale[row0 + ai * HALF + m * 16];
        __builtin_amdgcn_sched_barrier(0);
#pragma unroll
        for (int bj = 0; bj < 2; ++bj)
#pragma unroll
            for (int n = 0; n < 2; ++n) { bv[bj][n] = bv[bj][n] * sq; cv[bj][n] = cv[bj][n] * sq; }
#pragma unroll
        for (int ai = 0; ai < 2; ++ai)
#pragma unroll
            for (int m = 0; m < 4; ++m) { const int row = row0 + ai * HALF + m * 16; const float rs = rsv[ai][m]; u32x4 w;
#pragma unroll
                for (int bj = 0; bj < 2; ++bj)
#pragma unroll
                    for (int n = 0; n < 2; ++n) { const i32x4 ia = __builtin_bit_cast(i32x4, acc[ai][bj][m][n]); const f32x4 rc = cv[bj][n] * rs;
                        f32x4 a = __builtin_elementwise_fma(__builtin_convertvector(ia, f32x4), rc, bv[bj][n]);
#pragma unroll
                        for (int j = 0; j < 4; ++j) a[j] = __builtin_amdgcn_fmed3f(a[j], 0.f, 21.166010f);
                        const f32x4 v = a * a;
                        int p = 0; p = __builtin_amdgcn_cvt_pk_fp8_f32(v[0], v[1], p, false); p = __builtin_amdgcn_cvt_pk_fp8_f32(v[2], v[3], p, true); w[2 * bj + n] = (unsigned)p; }
                *(u32x4*)(O8 + (size_t)row * ldc + col0) = w; }
    }
};

struct EpiI8Bf16Split {
    static constexpr bool PERM = true, AFTER_DRAIN = false; static constexpr int BPERM = 1;
    bf16_t* O; int ldc; const float* rowscale; const float* colscale; int split_cols; bf16_t* O1; bf16_t* O2; unsigned* vmax;
    __device__ __forceinline__ void operator()(const f32x4 (&acc)[2][2][4][2], const Unit& u, int wr, int wc, int fr, int fq) const {
        const int row0 = u.pm * BM + wr * 64 + fr; int colt = u.pn * BM; bf16_t* base = O;
        const int t = colt / split_cols; base = (t == 0) ? O : (t == 1) ? O1 : O2; colt -= t * split_cols; f32x4 vm4 = {0.f, 0.f, 0.f, 0.f};
        const int col0 = colt + wc * 32 + 8 * fq; int ccol = u.pn * BM + wc * 32 + 8 * fq; asm volatile("" : "+v"(ccol));
        f32x4 cv[2][2];
#pragma unroll
        for (int bj = 0; bj < 2; ++bj)
#pragma unroll
            for (int n = 0; n < 2; ++n) cv[bj][n] = *(const f32x4*)(colscale + ccol + bj * HALF + 4 * n);
        float rsv[2][4];
#pragma unroll
        for (int ai = 0; ai < 2; ++ai)
#pragma unroll
            for (int m = 0; m < 4; ++m) rsv[ai][m] = rowscale[row0 + ai * HALF + m * 16];
        __builtin_amdgcn_sched_barrier(0);
#pragma unroll
        for (int ai = 0; ai < 2; ++ai)
#pragma unroll
            for (int m = 0; m < 4; ++m) { const int row = row0 + ai * HALF + m * 16; const float rs = rsv[ai][m]; const size_t rowo = (size_t)row * ldc + col0;
#pragma unroll
                for (int bj = 0; bj < 2; ++bj) { const i32x4 i0 = __builtin_bit_cast(i32x4, acc[ai][bj][m][0]), i1 = __builtin_bit_cast(i32x4, acc[ai][bj][m][1]);
                    const f32x4 v0 = __builtin_convertvector(i0, f32x4) * (cv[bj][0] * rs), v1 = __builtin_convertvector(i1, f32x4) * (cv[bj][1] * rs);
                    if (t == 2) {
#pragma unroll
                        for (int j = 0; j < 4; ++j) vm4[j] = fmaxf(vm4[j], fmaxf(fabsf(v0[j]), fabsf(v1[j]))); }
                    u32x4 w; w.x = cvt_pk_bf16(v0[0], v0[1]); w.y = cvt_pk_bf16(v0[2], v0[3]); w.z = cvt_pk_bf16(v1[0], v1[1]); w.w = cvt_pk_bf16(v1[2], v1[3]);
                    *(u32x4*)(base + rowo + bj * HALF) = w; } }
        if (t == 2) { float vm = fmaxf(fmaxf(vm4[0], vm4[1]), fmaxf(vm4[2], vm4[3]));
#pragma unroll
            for (int o = 1; o < 64; o <<= 1) vm = fmaxf(vm, __shfl_xor(vm, o));
            if ((fr | fq) == 0) __hip_atomic_fetch_max(vmax + u.pm, __float_as_uint(vm), __ATOMIC_RELAXED, __HIP_MEMORY_SCOPE_AGENT); }
    }
};

__device__ __forceinline__ float o_scale_panels(unsigned* w, int first, int pm) {
    float t[16];
#pragma unroll
    for (int i = 0; i < 16; ++i) t[i] = __uint_as_float(__hip_atomic_load(w + first + i, __ATOMIC_RELAXED, __HIP_MEMORY_SCOPE_AGENT));
    float vm = 0.f;
#pragma unroll
    for (int i = 0; i < 16; ++i) vm = fmaxf(vm, (first + i <= pm) ? t[i] : 0.f);
    return vm > 0.f ? vm * (1.01f / 127.0f) : 1.0f;
}
struct EpiI8GateBf16 {
    static constexpr bool PERM = true, AFTER_DRAIN = false; static constexpr int BPERM = 1;
    bf16_t* O; int ldc; const float* gate; int gate_bstride; int rows_per_batch; const float* colscale; unsigned* vmax;
    __device__ __forceinline__ void operator()(const f32x4 (&acc)[2][2][4][2], const Unit& u, int wr, int wc, int fr, int fq) const {
        const int row0 = u.pm * BM + wr * 64 + fr, col0 = u.pn * BM + wc * 32 + 8 * fq;
        const float* gp = gate + (size_t)((u.pm * BM) / rows_per_batch) * gate_bstride;
        const float rs = o_scale_panels(vmax, u.pm - u.pm % (rows_per_batch / BM), u.pm);
        int colv = col0; asm volatile("" : "+v"(colv));
        f32x4 gv[2][2];
#pragma unroll
        for (int bj = 0; bj < 2; ++bj)
#pragma unroll
            for (int n = 0; n < 2; ++n) gv[bj][n] = *(const f32x4*)(gp + colv + bj * HALF + 4 * n) * *(const f32x4*)(colscale + colv + bj * HALF + 4 * n) * rs;
#pragma unroll
        for (int ai = 0; ai < 2; ++ai)
#pragma unroll
            for (int m = 0; m < 4; ++m) { bf16_t* rowp = O + (size_t)(row0 + ai * HALF + m * 16) * ldc + col0;
#pragma unroll
                for (int bj = 0; bj < 2; ++bj) { const i32x4 i0 = __builtin_bit_cast(i32x4, acc[ai][bj][m][0]), i1 = __builtin_bit_cast(i32x4, acc[ai][bj][m][1]);
                    const f32x4 v0 = __builtin_convertvector(i0, f32x4) * gv[bj][0], v1 = __builtin_convertvector(i1, f32x4) * gv[bj][1];
                    u32x4 w; w.x = cvt_pk_bf16(v0[0], v0[1]); w.y = cvt_pk_bf16(v0[2], v0[3]); w.z = cvt_pk_bf16(v1[0], v1[1]); w.w = cvt_pk_bf16(v1[2], v1[3]);
                    *(u32x4*)(rowp + bj * HALF) = w; } }
    }
};

struct EpiNull { static constexpr bool PERM = false, AFTER_DRAIN = false; static constexpr int BPERM = 0;
    __device__ __forceinline__ void operator()(const f32x4 (&acc)[2][2][4][2], const Unit& u, int wr, int wc, int fr, int fq) const {
#pragma unroll
        for (int ai = 0; ai < 2; ++ai)
#pragma unroll
            for (int m = 0; m < 4; ++m) asm volatile("" :: "v"(acc[ai][0][m][0]), "v"(acc[ai][0][m][1]), "v"(acc[ai][1][m][0]), "v"(acc[ai][1][m][1])); }
};

struct FixedOrder { int n;
    __device__ __forceinline__ bool next(int i, Unit& u) const { if (i >= n) return false; u.pm = 0; u.pn = 0; return true; }
    __device__ __forceinline__ void a_ready(const Unit&) const {}
    __device__ __forceinline__ void done(const Unit&) const {}
};
template <class Epi, class Sched, bool ALIGN_EPI = false, bool SP2 = false, int SKEL = 0, int ES = 2  , bool I8 = false    >
__device__ __forceinline__ void gemm_phase(PG8_LAS unsigned char* lds, const Gemm g, const Sched& S, const Epi& E) {
    typedef double f64x2v __attribute__((ext_vector_type(2)));
    int tid_ = threadIdx.x; asm volatile("" : "+v"(tid_));
    const int tid = tid_, wid = __builtin_amdgcn_readfirstlane(tid >> 6), lane = tid & 63, wr = wid >> 2, wc = wid & 3, fr = lane & 15, fq = lane >> 4;
    const int K = g.K, KB = K * ES  , nt = KB / (BK * 2);
    unsigned voffA[2], voffB[2], voffB1[2];
#pragma unroll
    for (int i = 0; i < 2; ++i) { int R, C; stage_rc(tid * 16 + i * 8192, R, C);
        voffA[i] = (unsigned)(R * KB + C * 2);
        if constexpr (Epi::BPERM == 2) { voffB[i] = (unsigned)(adj16_row(0, R) * KB + C * 2); voffB1[i] = (unsigned)(adj16_row(1, R) * KB + C * 2); }
        else { const int Rb = Epi::PERM ? ((R & ~31) + perm32(R & 31)) : R; voffB[i] = (unsigned)(Rb * KB + C * 2); voffB1[i] = voffB[i]; } }
    const unsigned bh1 = (Epi::BPERM == 2) ? 0u : (unsigned)HALF * (unsigned)KB;
    const unsigned kstep = (unsigned)(BK * 2);
    const unsigned hstep = (unsigned)HALF * (unsigned)KB;
    const unsigned tstep = 2u * hstep;
    const unsigned ldsw = (unsigned)wid * 1024u;
    const int aoff = lds_byte(wr * 64 + fr, fq * 8), boff = lds_byte(wc * 32 + fr, fq * 8);
#define PG8_SA(b, h) (((b) * 2 + (h)) * HTB)
#define PG8_SB(b, h) ((4 + (b) * 2 + (h)) * HTB)
#define PG8_STAGE_R(rsrc, bufoff, soff, voff) do { if constexpr (SKEL != 2 && SKEL != 3) { _Pragma("unroll") for (int _i = 0; _i < 2; ++_i) \
        __builtin_amdgcn_raw_ptr_buffer_load_lds(rsrc, (PG8_LAS void*)(lds + (bufoff) + ldsw + _i * 8192), 16, (int)(voff)[_i], (int)(soff), 0, 0); } } while (0)
#define PG8_LDA(dst, b, h) do { if constexpr (SKEL != 2 && SKEL != 4) { _Pragma("unroll") for (int m = 0; m < 4; ++m) _Pragma("unroll") for (int k = 0; k < 2; ++k) dst[m][k] = *(const PG8_LAS bf16x8*)(lds + PG8_SA(b, h) + aoff + m * 2048 + k * 1024); } } while (0)
#define PG8_LDB(dst, b, h) do { if constexpr (SKEL != 2 && SKEL != 4) { _Pragma("unroll") for (int n = 0; n < 2; ++n) _Pragma("unroll") for (int k = 0; k < 2; ++k) dst[n][k] = *(const PG8_LAS bf16x8*)(lds + PG8_SB(b, h) + boff + n * 2048 + k * 1024); } } while (0)
#define PG8_MMA(ai, bj, At, Bt) do { __builtin_amdgcn_s_setprio(1); if constexpr (ES == 2) { _Pragma("unroll") for (int m = 0; m < 4; ++m) _Pragma("unroll") for (int n = 0; n < 2; ++n) _Pragma("unroll") for (int k = 0; k < 2; ++k) \
        { if constexpr (SKEL != 1) acc[ai][bj][m][n] = __builtin_amdgcn_mfma_f32_16x16x32_bf16(Bt[n][k], At[m][k], acc[ai][bj][m][n], 0, 0, 0); else asm volatile("" :: "v"(Bt[n][k]), "v"(At[m][k])); } } \
      else if constexpr (I8) { _Pragma("unroll") for (int m = 0; m < 4; ++m) _Pragma("unroll") for (int n = 0; n < 2; ++n) _Pragma("unroll") for (int k = 0; k < 2; ++k) \
        acc[ai][bj][m][n] = __builtin_bit_cast(f32x4, __builtin_amdgcn_mfma_i32_16x16x64_i8(__builtin_bit_cast(i32x4, Bt[n][k]), __builtin_bit_cast(i32x4, At[m][k]), __builtin_bit_cast(i32x4, acc[ai][bj][m][n]), 0, 0, 0)); } \
      else { _Pragma("unroll") for (int m = 0; m < 4; ++m) _Pragma("unroll") for (int n = 0; n < 2; ++n) \
        mfma_fp8_tied(acc[ai][bj][m][n], frag32(Bt[n][0], Bt[n][1]), frag32(At[m][0], At[m][1]), scl1); } \
      __builtin_amdgcn_s_setprio(0); } while (0)
#define PG8_WAIT_V(n) asm volatile("s_waitcnt vmcnt(" #n ")" ::: "memory")
#define PG8_WAIT_L(n) asm volatile("s_waitcnt lgkmcnt(" #n ")" ::: "memory")
#define PG8_BAR __builtin_amdgcn_s_barrier()
#define PG8_SCHED __builtin_amdgcn_sched_barrier(0)
    int scl1 = 0x7F7F7F7F; if constexpr (ES == 1 && !I8) asm volatile("" : "+v"(scl1));
    Unit cur, nxt; int ui = 0;
    if (!S.next(0, cur)) return;
    f32x4 acc[2][2][4][2];
#pragma unroll
    for (int a = 0; a < 2; ++a)
#pragma unroll
        for (int b = 0; b < 2; ++b)
#pragma unroll
            for (int m = 0; m < 4; ++m)
#pragma unroll
                for (int n = 0; n < 2; ++n) acc[a][b][m][n] = (f32x4){0.f, 0.f, 0.f, 0.f};
    bf16x8 At[4][2], B0[2][2], B1[2][2];
    if constexpr (SKEL == 2 || SKEL == 4) {
#pragma unroll
        for (int m = 0; m < 4; ++m)
#pragma unroll
            for (int k = 0; k < 2; ++k) asm volatile("" : "=v"(At[m][k]));
#pragma unroll
        for (int n = 0; n < 2; ++n)
#pragma unroll
            for (int k = 0; k < 2; ++k) { asm volatile("" : "=v"(B0[n][k])); asm volatile("" : "=v"(B1[n][k])); } }
    unsigned cA = (unsigned)cur.pm * tstep, cB = (unsigned)cur.pn * tstep;
    const __amdgpu_buffer_rsrc_t rsA = __builtin_amdgcn_make_buffer_rsrc((void*)g.A, 0, (int)((unsigned)g.M * (unsigned)KB), 0x00020000), rsB = __builtin_amdgcn_make_buffer_rsrc((void*)g.Bt, 0, (int)((unsigned)g.N * (unsigned)KB), 0x00020000);
    __builtin_amdgcn_s_waitcnt(0x0F70);
    S.a_ready(cur);
    if constexpr (SP2) {
        PG8_STAGE_R(rsB, PG8_SB(0, 0), cB, voffB); PG8_STAGE_R(rsB, PG8_SB(0, 1), cB + bh1, voffB1); PG8_STAGE_R(rsA, PG8_SA(0, 0), cA, voffA); PG8_STAGE_R(rsA, PG8_SA(0, 1), cA + hstep, voffA);
        if (wr == 1) PG8_BAR;
        PG8_WAIT_V(2); PG8_BAR;
        PG8_STAGE_R(rsB, PG8_SB(1, 0), cB + kstep, voffB); PG8_STAGE_R(rsA, PG8_SA(1, 0), cA + kstep, voffA); PG8_STAGE_R(rsB, PG8_SB(1, 1), cB + bh1 + kstep, voffB1);
        PG8_WAIT_V(6); PG8_BAR;
    } else {
        PG8_STAGE_R(rsB, PG8_SB(0, 0), cB, voffB); PG8_STAGE_R(rsA, PG8_SA(0, 0), cA, voffA); PG8_STAGE_R(rsB, PG8_SB(0, 1), cB + bh1, voffB1); PG8_STAGE_R(rsA, PG8_SA(0, 1), cA + hstep, voffA);
        if (wr == 1) PG8_BAR;
        PG8_WAIT_V(4); PG8_BAR;
        PG8_STAGE_R(rsB, PG8_SB(1, 0), cB + kstep, voffB); PG8_STAGE_R(rsA, PG8_SA(1, 0), cA + kstep, voffA); PG8_STAGE_R(rsB, PG8_SB(1, 1), cB + bh1 + kstep, voffB1);
        PG8_WAIT_V(6); PG8_BAR;
    }
    for (;;) {
        const bool has_next = S.next(ui + 1, nxt);
        const unsigned nA = has_next ? (unsigned)nxt.pm * tstep : cA, nB = has_next ? (unsigned)nxt.pn * tstep : cB;
        for (int t = 0; t < nt; t += 2) {
            const bool last = (t == nt - 2);
            const unsigned a1 = cA + (unsigned)(t + 1) * kstep;
            const unsigned a2 = last ? nA : cA + (unsigned)(t + 2) * kstep, b2 = last ? nB : cB + (unsigned)(t + 2) * kstep;
            const unsigned a3 = a2 + kstep, b3 = b2 + kstep;
            if (last && has_next) S.a_ready(nxt);
            if constexpr (SP2) {
            PG8_LDB(B0, 0, 0); PG8_LDB(B1, 0, 1); PG8_SCHED; PG8_LDA(At, 0, 0); PG8_STAGE_R(rsA, PG8_SA(1, 1), a1 + hstep, voffA);
            PG8_WAIT_V(8); PG8_WAIT_L(0); PG8_BAR; PG8_MMA(0, 0, At, B0); PG8_MMA(0, 1, At, B1); PG8_BAR; PG8_SCHED;
            PG8_LDA(At, 0, 1); PG8_STAGE_R(rsB, PG8_SB(0, 0), b2, voffB); PG8_STAGE_R(rsB, PG8_SB(0, 1), b2 + bh1, voffB1); PG8_STAGE_R(rsA, PG8_SA(0, 0), a2, voffA);
            PG8_WAIT_V(8); PG8_WAIT_L(0); PG8_BAR; PG8_MMA(1, 0, At, B0); PG8_MMA(1, 1, At, B1); PG8_BAR; PG8_SCHED;
            PG8_LDB(B0, 1, 0); PG8_LDB(B1, 1, 1); PG8_SCHED; PG8_LDA(At, 1, 0); PG8_STAGE_R(rsA, PG8_SA(0, 1), a2 + hstep, voffA);
            PG8_WAIT_V(8); PG8_WAIT_L(0); PG8_BAR; PG8_MMA(0, 0, At, B0); PG8_MMA(0, 1, At, B1); PG8_BAR; PG8_SCHED;
            PG8_LDA(At, 1, 1); PG8_STAGE_R(rsB, PG8_SB(1, 0), b3, voffB); PG8_STAGE_R(rsB, PG8_SB(1, 1), b3 + bh1, voffB1); PG8_STAGE_R(rsA, PG8_SA(1, 0), a3, voffA);
            PG8_WAIT_V(8); PG8_WAIT_L(0); PG8_BAR; PG8_MMA(1, 0, At, B0); PG8_MMA(1, 1, At, B1); PG8_BAR; PG8_SCHED;
            } else {
            PG8_LDB(B0, 0, 0); PG8_SCHED; PG8_LDA(At, 0, 0); PG8_STAGE_R(rsA, PG8_SA(1, 1), a1 + hstep, voffA);
            PG8_WAIT_L(8); PG8_BAR; PG8_WAIT_L(0); PG8_MMA(0, 0, At, B0); PG8_BAR; PG8_SCHED;
            PG8_LDB(B1, 0, 1); PG8_STAGE_R(rsB, PG8_SB(0, 0), b2, voffB);
            PG8_BAR; PG8_WAIT_L(0); PG8_MMA(0, 1, At, B1); PG8_BAR;
            PG8_LDA(At, 0, 1); PG8_STAGE_R(rsA, PG8_SA(0, 0), a2, voffA);
            PG8_BAR; PG8_WAIT_L(0); PG8_MMA(1, 0, At, B0); PG8_BAR; PG8_SCHED;
            PG8_STAGE_R(rsB, PG8_SB(0, 1), b2 + bh1, voffB1);
            PG8_WAIT_V(6); PG8_BAR; PG8_MMA(1, 1, At, B1); PG8_BAR;
            PG8_LDB(B0, 1, 0); PG8_SCHED; PG8_LDA(At, 1, 0); PG8_STAGE_R(rsA, PG8_SA(0, 1), a2 + hstep, voffA);
            PG8_WAIT_L(8); PG8_BAR; PG8_WAIT_L(0); PG8_MMA(0, 0, At, B0); PG8_BAR; PG8_SCHED;
            PG8_LDB(B1, 1, 1); PG8_STAGE_R(rsB, PG8_SB(1, 0), b3, voffB);
            PG8_BAR; PG8_WAIT_L(0); PG8_MMA(0, 1, At, B1); PG8_BAR;
            PG8_LDA(At, 1, 1); PG8_STAGE_R(rsA, PG8_SA(1, 0), a3, voffA);
            PG8_BAR; PG8_WAIT_L(0); PG8_MMA(1, 0, At, B0); PG8_BAR; PG8_SCHED;
            PG8_STAGE_R(rsB, PG8_SB(1, 1), b3 + bh1, voffB1);
            PG8_WAIT_V(6); PG8_BAR; PG8_MMA(1, 1, At, B1); PG8_BAR;
            }
        }
        if constexpr (ALIGN_EPI) { if (wr == 0) PG8_BAR; }
        if constexpr (ES == 1 && !I8) asm volatile("s_nop 15\n\ts_nop 15" ::: "memory");
        if constexpr (!Epi::AFTER_DRAIN) { E(acc, cur, wr, wc, fr, fq); S.done(cur); }
        if (!has_next) break;
#pragma unroll
        for (int a = 0; a < 2; ++a)
#pragma unroll
            for (int b = 0; b < 2; ++b)
#pragma unroll
                for (int m = 0; m < 4; ++m)
#pragma unroll
                    for (int n = 0; n < 2; ++n) { double z0, z1; asm volatile("v_mov_b64 %0, 0\n\tv_mov_b64 %1, 0" : "=v"(z0), "=v"(z1)); const f64x2v zz = {z0, z1}; acc[a][b][m][n] = __builtin_bit_cast(f32x4, zz); }
        cur = nxt; cA = nA; cB = nB; ++ui;
        if constexpr (ALIGN_EPI) { if (wr == 1) PG8_BAR; }
    }
    PG8_WAIT_V(0);
    if constexpr (!ALIGN_EPI) { if (wr == 0) PG8_BAR; }
    PG8_BAR;
    if constexpr (Epi::AFTER_DRAIN) { E.fused(acc, cur, wr, wc, fr, fq, lds, wid, lane); S.done(cur); }
#undef PG8_SA
#undef PG8_SB
#undef PG8_STAGE_R
#undef PG8_LDA
#undef PG8_LDB
#undef PG8_MMA
#undef PG8_WAIT_V
#undef PG8_WAIT_L
#undef PG8_BAR
#undef PG8_SCHED
}


template <int ACT, bool HAS_BIAS> struct Epi32Bf16 {
    static constexpr bool PERM = true, AFTER_DRAIN = false; static_assert(ACT == 0 || ACT == 3, "Epi32Bf16: ACT is 0 (none) or 3 (squared relu)");
    bf16_t* O; int ldc; const float* bias; int split_cols; size_t split_stride;
    __device__ __forceinline__ void operator()(const f32x16 (&acc)[2][2][2], const Unit& u, int wr, int wc, int r32, int hi) const {
        const int row0 = u.pm * BM + wr * 64 + r32; int colt = u.pn * BM; bf16_t* base = O;
        if (split_cols) { const int t = colt / split_cols; base += (size_t)t * split_stride; colt -= t * split_cols; }
        const int col0 = colt + wc * 32 + 8 * hi, bcol0 = u.pn * BM + wc * 32 + 8 * hi;
        f32x4 bv[2][4];
        if constexpr (HAS_BIAS) {
#pragma unroll
            for (int bj = 0; bj < 2; ++bj)
#pragma unroll
                for (int q = 0; q < 4; ++q) bv[bj][q] = *(const f32x4*)(bias + bcol0 + bj * HALF + (q >> 1) * 16 + (q & 1) * 4);
        }
#pragma unroll
        for (int ai = 0; ai < 2; ++ai)
#pragma unroll
            for (int mb = 0; mb < 2; ++mb) { bf16_t* rowp = base + (size_t)(row0 + ai * HALF + mb * 32) * ldc + col0;
#pragma unroll
                for (int bj = 0; bj < 2; ++bj)
#pragma unroll
                    for (int t = 0; t < 2; ++t) { float v[8];
#pragma unroll
                        for (int j = 0; j < 8; ++j) { v[j] = acc[ai][bj][mb][8 * t + j]; if constexpr (HAS_BIAS) v[j] += bv[bj][2 * t + (j >> 2)][j & 3]; if (ACT == 3) { const float a = fmaxf(v[j], 0.f); v[j] = a * a; } }
                        u32x4 w; w.x = cvt_pk_bf16(v[0], v[1]); w.y = cvt_pk_bf16(v[2], v[3]); w.z = cvt_pk_bf16(v[4], v[5]); w.w = cvt_pk_bf16(v[6], v[7]);
                        store16_wt(rowp + bj * HALF + 16 * t, w); } }
    }
};
template <bool HAS_BIAS> struct Epi32GateBf16 {
    static constexpr bool PERM = true, AFTER_DRAIN = false;
    bf16_t* O; int ldc; const float* bias; const float* gate; int gate_bstride; int rows_per_batch;
    __device__ __forceinline__ void operator()(const f32x16 (&acc)[2][2][2], const Unit& u, int wr, int wc, int r32, int hi) const {
        const int row0 = u.pm * BM + wr * 64 + r32, col0 = u.pn * BM + wc * 32 + 8 * hi;
        const float* gp = gate + (size_t)((u.pm * BM) / rows_per_batch) * gate_bstride;
        f32x4 bv[2][4], gv[2][4];
#pragma unroll
        for (int bj = 0; bj < 2; ++bj)
#pragma unroll
            for (int q = 0; q < 4; ++q) { const int c = col0 + bj * HALF + (q >> 1) * 16 + (q & 1) * 4; if constexpr (HAS_BIAS) bv[bj][q] = *(const f32x4*)(bias + c); gv[bj][q] = *(const f32x4*)(gp + c); }
#pragma unroll
        for (int ai = 0; ai < 2; ++ai)
#pragma unroll
            for (int mb = 0; mb < 2; ++mb) { bf16_t* rowp = O + (size_t)(row0 + ai * HALF + mb * 32) * ldc + col0;
#pragma unroll
                for (int bj = 0; bj < 2; ++bj)
#pragma unroll
                    for (int t = 0; t < 2; ++t) { float v[8];
#pragma unroll
                        for (int j = 0; j < 8; ++j) { v[j] = acc[ai][bj][mb][8 * t + j]; if constexpr (HAS_BIAS) v[j] += bv[bj][2 * t + (j >> 2)][j & 3]; v[j] *= gv[bj][2 * t + (j >> 2)][j & 3]; }
                        u32x4 w; w.x = cvt_pk_bf16(v[0], v[1]); w.y = cvt_pk_bf16(v[2], v[3]); w.z = cvt_pk_bf16(v[4], v[5]); w.w = cvt_pk_bf16(v[6], v[7]);
                        store16_wt(rowp + bj * HALF + 16 * t, w); } }
    }
};
struct Epi32Null { static constexpr bool PERM = true, AFTER_DRAIN = false;
    __device__ __forceinline__ void operator()(const f32x16 (&acc)[2][2][2], const Unit& u, int wr, int wc, int r32, int hi) const {
#pragma unroll
        for (int ai = 0; ai < 2; ++ai)
#pragma unroll
            for (int bj = 0; bj < 2; ++bj) asm volatile("" :: "v"(acc[ai][bj][0]), "v"(acc[ai][bj][1])); }
};
template <class Epi, class Sched, bool ALIGN_EPI = false, bool SP2 = false, int SKEL = 0  >
__device__ __forceinline__ void gemm_phase32(PG8_LAS unsigned char* lds, const Gemm g, const Sched& S, const Epi& E) {
    int tid_ = threadIdx.x; asm volatile("" : "+v"(tid_));
    const int tid = tid_, wid = __builtin_amdgcn_readfirstlane(tid >> 6), lane = tid & 63, wr = wid >> 2, wc = wid & 3, r32 = lane & 31, hi = lane >> 5;
    const int K = g.K, nt = K / BK;
    unsigned voffA[2], voffB[2];
#pragma unroll
    for (int i = 0; i < 2; ++i) { int R, C; stage_rc2(tid * 16 + i * 8192, R, C); const int Rb = (R & ~31) + perm32b(R & 31);
        voffA[i] = (unsigned)(R * K + C) * 2u; voffB[i] = (unsigned)(Rb * K + C) * 2u; }
    const unsigned kstep = (unsigned)(BK * 2);
    const unsigned hstep = (unsigned)HALF * (unsigned)K * 2u;
    const unsigned tstep = 2u * hstep;
    const unsigned ldsw = (unsigned)wid * 1024u;
    const int aoff0 = lds_byte2(wr * 64 + r32, hi * 8), boff0 = lds_byte2(wc * 32 + r32, hi * 8); const int aoffs[2] = {aoff0, aoff0 ^ 32}, boffs[2] = {boff0, boff0 ^ 32};
#define PG8_SA(b, h) (((b) * 2 + (h)) * HTB)
#define PG8_SB(b, h) ((4 + (b) * 2 + (h)) * HTB)
#define PG8_STAGE_R(rsrc, bufoff, soff, voff) do { if constexpr (SKEL != 2) { _Pragma("unroll") for (int _i = 0; _i < 2; ++_i) \
        __builtin_amdgcn_raw_ptr_buffer_load_lds(rsrc, (PG8_LAS void*)(lds + (bufoff) + ldsw + _i * 8192), 16, (int)(voff)[_i], (int)(soff), 0, 0); } } while (0)
#define PG8_LDA(dst, b, h) do { if constexpr (SKEL != 2) { _Pragma("unroll") for (int m = 0; m < 2; ++m) _Pragma("unroll") for (int k = 0; k < 4; ++k) dst[m][k] = *(const PG8_LAS bf16x8*)(lds + PG8_SA(b, h) + aoffs[k & 1] + m * 4096 + (k >> 1) * 1024); } } while (0)
#define PG8_LDB(dst, b, h) do { if constexpr (SKEL != 2) { _Pragma("unroll") for (int k = 0; k < 4; ++k) dst[k] = *(const PG8_LAS bf16x8*)(lds + PG8_SB(b, h) + boffs[k & 1] + (k >> 1) * 1024); } } while (0)
#define PG8_MMA(ai, bj, At, Bt) do { __builtin_amdgcn_s_setprio(1); _Pragma("unroll") for (int k = 0; k < 4; ++k) _Pragma("unroll") for (int m = 0; m < 2; ++m) \
        { if constexpr (SKEL != 1) acc[ai][bj][m] = __builtin_amdgcn_mfma_f32_32x32x16_bf16(Bt[k], At[m][k], acc[ai][bj][m], 0, 0, 0); else asm volatile("" :: "v"(Bt[k]), "v"(At[m][k])); } __builtin_amdgcn_s_setprio(0); } while (0)
#define PG8_WAIT_V(n) asm volatile("s_waitcnt vmcnt(" #n ")" ::: "memory")
#define PG8_WAIT_L(n) asm volatile("s_waitcnt lgkmcnt(" #n ")" ::: "memory")
#define PG8_BAR __builtin_amdgcn_s_barrier()
#define PG8_SCHED __builtin_amdgcn_sched_barrier(0)
    Unit cur, nxt; int ui = 0;
    if (!S.next(0, cur)) return;
    f32x16 acc[2][2][2];
#pragma unroll
    for (int a = 0; a < 2; ++a)
#pragma unroll
        for (int b = 0; b < 2; ++b)
#pragma unroll
            for (int m = 0; m < 2; ++m) acc[a][b][m] = f32x16{};
    bf16x8 At[2][4], B0[4], B1[4];
    if constexpr (SKEL == 2) {
#pragma unroll
        for (int m = 0; m < 2; ++m)
#pragma unroll
            for (int k = 0; k < 4; ++k) asm volatile("" : "=v"(At[m][k]));
#pragma unroll
        for (int k = 0; k < 4; ++k) { asm volatile("" : "=v"(B0[k])); asm volatile("" : "=v"(B1[k])); } }
    unsigned cA = (unsigned)cur.pm * tstep, cB = (unsigned)cur.pn * tstep;
    const __amdgpu_buffer_rsrc_t rsA = __builtin_amdgcn_make_buffer_rsrc((void*)g.A, 0, (int)((unsigned)g.M * (unsigned)K * 2u), 0x00020000), rsB = __builtin_amdgcn_make_buffer_rsrc((void*)g.Bt, 0, (int)((unsigned)g.N * (unsigned)K * 2u), 0x00020000);
    S.a_ready(cur);
    if constexpr (SP2) {
        PG8_STAGE_R(rsB, PG8_SB(0, 0), cB, voffB); PG8_STAGE_R(rsB, PG8_SB(0, 1), cB + hstep, voffB); PG8_STAGE_R(rsA, PG8_SA(0, 0), cA, voffA); PG8_STAGE_R(rsA, PG8_SA(0, 1), cA + hstep, voffA);
        if (wr == 1) PG8_BAR;
        PG8_WAIT_V(2); PG8_BAR;
        PG8_STAGE_R(rsB, PG8_SB(1, 0), cB + kstep, voffB); PG8_STAGE_R(rsA, PG8_SA(1, 0), cA + kstep, voffA); PG8_STAGE_R(rsB, PG8_SB(1, 1), cB + hstep + kstep, voffB);
        PG8_WAIT_V(6); PG8_BAR;
    } else {
        PG8_STAGE_R(rsB, PG8_SB(0, 0), cB, voffB); PG8_STAGE_R(rsA, PG8_SA(0, 0), cA, voffA); PG8_STAGE_R(rsB, PG8_SB(0, 1), cB + hstep, voffB); PG8_STAGE_R(rsA, PG8_SA(0, 1), cA + hstep, voffA);
        if (wr == 1) PG8_BAR;
        PG8_WAIT_V(4); PG8_BAR;
        PG8_STAGE_R(rsB, PG8_SB(1, 0), cB + kstep, voffB); PG8_STAGE_R(rsA, PG8_SA(1, 0), cA + kstep, voffA); PG8_STAGE_R(rsB, PG8_SB(1, 1), cB + hstep + kstep, voffB);
        PG8_WAIT_V(6); PG8_BAR;
    }
    for (;;) {
        const bool has_next = S.next(ui + 1, nxt);
        const unsigned nA = has_next ? (unsigned)nxt.pm * tstep : cA, nB = has_next ? (unsigned)nxt.pn * tstep : cB;
        for (int t = 0; t < nt; t += 2) {
            const bool last = (t == nt - 2);
            const unsigned a1 = cA + (unsigned)(t + 1) * kstep;
            const unsigned a2 = last ? nA : cA + (unsigned)(t + 2) * kstep, b2 = last ? nB : cB + (unsigned)(t + 2) * kstep;
            const unsigned a3 = a2 + kstep, b3 = b2 + kstep;
            if (last && has_next) S.a_ready(nxt);
            if constexpr (SP2) {
            PG8_LDB(B0, 0, 0); PG8_LDB(B1, 0, 1); PG8_SCHED; PG8_LDA(At, 0, 0); PG8_STAGE_R(rsA, PG8_SA(1, 1), a1 + hstep, voffA);
            PG8_WAIT_V(8); PG8_WAIT_L(0); PG8_BAR; PG8_MMA(0, 0, At, B0); PG8_MMA(0, 1, At, B1); PG8_BAR; PG8_SCHED;
            PG8_LDA(At, 0, 1); PG8_STAGE_R(rsB, PG8_SB(0, 0), b2, voffB); PG8_STAGE_R(rsB, PG8_SB(0, 1), b2 + hstep, voffB); PG8_STAGE_R(rsA, PG8_SA(0, 0), a2, voffA);
            PG8_WAIT_V(8); PG8_WAIT_L(0); PG8_BAR; PG8_MMA(1, 0, At, B0); PG8_MMA(1, 1, At, B1); PG8_BAR; PG8_SCHED;
            PG8_LDB(B0, 1, 0); PG8_LDB(B1, 1, 1); PG8_SCHED; PG8_LDA(At, 1, 0); PG8_STAGE_R(rsA, PG8_SA(0, 1), a2 + hstep, voffA);
            PG8_WAIT_V(8); PG8_WAIT_L(0); PG8_BAR; PG8_MMA(0, 0, At, B0); PG8_MMA(0, 1, At, B1); PG8_BAR; PG8_SCHED;
            PG8_LDA(At, 1, 1); PG8_STAGE_R(rsB, PG8_SB(1, 0), b3, voffB); PG8_STAGE_R(rsB, PG8_SB(1, 1), b3 + hstep, voffB); PG8_STAGE_R(rsA, PG8_SA(1, 0), a3, voffA);
            PG8_WAIT_V(8); PG8_WAIT_L(0); PG8_BAR; PG8_MMA(1, 0, At, B0); PG8_MMA(1, 1, At, B1); PG8_BAR; PG8_SCHED;
            } else {
            PG8_LDB(B0, 0, 0); PG8_SCHED; PG8_LDA(At, 0, 0); PG8_STAGE_R(rsA, PG8_SA(1, 1), a1 + hstep, voffA);
            PG8_WAIT_L(8); PG8_BAR; PG8_WAIT_L(0); PG8_MMA(0, 0, At, B0); PG8_BAR; PG8_SCHED;
            PG8_LDB(B1, 0, 1); PG8_STAGE_R(rsB, PG8_SB(0, 0), b2, voffB);
            PG8_BAR; PG8_WAIT_L(0); PG8_MMA(0, 1, At, B1); PG8_BAR;
            PG8_LDA(At, 0, 1); PG8_STAGE_R(rsA, PG8_SA(0, 0), a2, voffA);
            PG8_BAR; PG8_WAIT_L(0); PG8_MMA(1, 0, At, B0); PG8_BAR; PG8_SCHED;
            PG8_STAGE_R(rsB, PG8_SB(0, 1), b2 + hstep, voffB);
            PG8_WAIT_V(6); PG8_BAR; PG8_MMA(1, 1, At, B1); PG8_BAR;
            PG8_LDB(B0, 1, 0); PG8_SCHED; PG8_LDA(At, 1, 0); PG8_STAGE_R(rsA, PG8_SA(0, 1), a2 + hstep, voffA);
            PG8_WAIT_L(8); PG8_BAR; PG8_WAIT_L(0); PG8_MMA(0, 0, At, B0); PG8_BAR; PG8_SCHED;
            PG8_LDB(B1, 1, 1); PG8_STAGE_R(rsB, PG8_SB(1, 0), b3, voffB);
            PG8_BAR; PG8_WAIT_L(0); PG8_MMA(0, 1, At, B1); PG8_BAR;
            PG8_LDA(At, 1, 1); PG8_STAGE_R(rsA, PG8_SA(1, 0), a3, voffA);
            PG8_BAR; PG8_WAIT_L(0); PG8_MMA(1, 0, At, B0); PG8_BAR; PG8_SCHED;
            PG8_STAGE_R(rsB, PG8_SB(1, 1), b3 + hstep, voffB);
            PG8_WAIT_V(6); PG8_BAR; PG8_MMA(1, 1, At, B1); PG8_BAR;
            }
        }
        if constexpr (ALIGN_EPI) { if (wr == 0) PG8_BAR; }
        if constexpr (!Epi::AFTER_DRAIN) { E(acc, cur, wr, wc, r32, hi); S.done(cur); }
        if (!has_next) break;
#pragma unroll
        for (int a = 0; a < 2; ++a)
#pragma unroll
            for (int b = 0; b < 2; ++b)
#pragma unroll
                for (int m = 0; m < 2; ++m) acc[a][b][m] = f32x16{};
        cur = nxt; cA = nA; cB = nB; ++ui;
        if constexpr (ALIGN_EPI) { if (wr == 1) PG8_BAR; }
    }
    PG8_WAIT_V(0);
    if constexpr (!ALIGN_EPI) { if (wr == 0) PG8_BAR; }
    PG8_BAR;
    static_assert(!Epi::AFTER_DRAIN, "gemm_phase32: no drained epilogues");
#undef PG8_SA
#undef PG8_SB
#undef PG8_STAGE_R
#undef PG8_LDA
#undef PG8_LDB
#undef PG8_MMA
#undef PG8_WAIT_V
#undef PG8_WAIT_L
#undef PG8_BAR
#undef PG8_SCHED
}
}

namespace sba {
using bf16x8 = __attribute__((ext_vector_type(8))) short;
using s16x4  = __attribute__((ext_vector_type(4))) short;
using f32x16 = __attribute__((ext_vector_type(16))) float;
using u32x4  = __attribute__((ext_vector_type(4))) unsigned;
typedef _Float16 f16x8 __attribute__((ext_vector_type(8)));
#define SBA_LAS __attribute__((address_space(3)))
constexpr int D = 128, NW = 8, QBLK = 32, KVBLK = 64, LDR = 2048, SEQ = 4096, NHEAD = 16, UNIT_ROWS = QBLK * NW;
constexpr int SHM_V = KVBLK * D * 2, SHM_K = KVBLK * D * 2;
constexpr int OFF_V = 0, OFF_K = 2 * SHM_V, OFF_FLAG = 2 * SHM_V + 2 * SHM_K, OFF_OST = OFF_FLAG + 128, LDS_BYTES = OFF_OST + NW * 4096;
constexpr float DEAD = -152.f;
constexpr float NEG = -30000.f;
#define SBA_KSWZ(row, colB) ((row) * 256 + ((colB) ^ (((row) & 7) << 4)))
#define SBA_SBAR() __builtin_amdgcn_sched_barrier(0)
__device__ __forceinline__ int crow(int r, int hi) { return (r & 3) + 8 * (r >> 2) + 4 * hi; }
__device__ __forceinline__ unsigned cvtpk(float lo, float hi) { unsigned r; asm volatile("v_cvt_pk_bf16_f32 %0, %1, %2" : "=v"(r) : "v"(lo), "v"(hi)); return r; }
__device__ __forceinline__ unsigned pkh(float lo, float hi) { return __builtin_bit_cast(unsigned, __builtin_amdgcn_cvt_pkrtz(lo, hi)); }
__device__ __forceinline__ int v_st(int k, int c) { const int kk = (k & ~0xC) | ((k & 4) << 1) | ((k & 8) >> 1); return ((kk >> 3) * 4 + (c >> 5)) * 512 + ((kk & 7) * 32 + (c & 31)) * 2; }
__device__ __forceinline__ int v_rd_base(int lane) { return ((lane & 3) << 3) | (((lane >> 2) & 3) << 6) | (((lane >> 4) & 1) << 5) | (((lane >> 5) & 1) << 8); }
constexpr int v_rd_off(int d0, int ks, int half) { return d0 * 512 + ks * 4096 + half * 2048; }
template <int OFF> __device__ __forceinline__ s16x4 tr_read(int vb) { s16x4 r; asm volatile("ds_read_b64_tr_b16 %0, %1 offset:%2" : "=&v"(r) : "v"(vb), "i"(OFF) : "memory"); return r; }
template <int D0> __device__ __forceinline__ void pv_one(f32x16& od, int vb, bf16x8 pa0, bf16x8 pa1, bf16x8 pa2, bf16x8 pa3) {
  const s16x4 l0 = tr_read<v_rd_off(D0, 0, 0)>(vb), h0 = tr_read<v_rd_off(D0, 0, 1)>(vb), l1 = tr_read<v_rd_off(D0, 1, 0)>(vb), h1 = tr_read<v_rd_off(D0, 1, 1)>(vb);
  const s16x4 l2 = tr_read<v_rd_off(D0, 2, 0)>(vb), h2 = tr_read<v_rd_off(D0, 2, 1)>(vb), l3 = tr_read<v_rd_off(D0, 3, 0)>(vb), h3 = tr_read<v_rd_off(D0, 3, 1)>(vb);
  asm volatile("s_waitcnt lgkmcnt(0)" ::: "memory"); SBA_SBAR();
#define SBA_PK(L, H) (bf16x8){L[0], L[1], L[2], L[3], H[0], H[1], H[2], H[3]}
  od = __builtin_amdgcn_mfma_f32_32x32x16_bf16(pa0, SBA_PK(l0, h0), od, 0, 0, 0);
  od = __builtin_amdgcn_mfma_f32_32x32x16_bf16(pa1, SBA_PK(l1, h1), od, 0, 0, 0);
  od = __builtin_amdgcn_mfma_f32_32x32x16_bf16(pa2, SBA_PK(l2, h2), od, 0, 0, 0);
  od = __builtin_amdgcn_mfma_f32_32x32x16_bf16(pa3, SBA_PK(l3, h3), od, 0, 0, 0);
#undef SBA_PK
}
__device__ __forceinline__ void qkt(f32x16& p0, f32x16& p1, const SBA_LAS char* Ks, const bf16x8* qr, int r32, int hi) {
  p0 = f32x16{}; p1 = f32x16{};
#pragma unroll
  for (int d0 = 0; d0 < 8; ++d0) { const int cb = (d0 * 16 + hi * 8) * 2;
    const bf16x8 b0 = *(const SBA_LAS bf16x8*)(Ks + SBA_KSWZ(r32, cb));
    const bf16x8 b1 = *(const SBA_LAS bf16x8*)(Ks + SBA_KSWZ(32 + r32, cb));
    p0 = __builtin_amdgcn_mfma_f32_32x32x16_bf16(b0, qr[d0], p0, 0, 0, 0);
    p1 = __builtin_amdgcn_mfma_f32_32x32x16_bf16(b1, qr[d0], p1, 0, 0, 0); }
}
__device__ __forceinline__ void sb_elem(float z, float& lb, float& l1) {
  const float e = __builtin_amdgcn_exp2f(-__builtin_fabsf(z));
  const float L = __builtin_amdgcn_logf(1.0f + e);
  lb = __builtin_amdgcn_fmed3f(z, 0.f, -3.0e38f) - L; l1 = lb - z;
}

__device__ __forceinline__ void attn_unit(int b, int h, int qb, const unsigned short* __restrict__ Q, const unsigned short* __restrict__ K, const unsigned short* __restrict__ V,
                                          signed char* __restrict__ O, float oinv, SBA_LAS char* lds) {
  int tid_ = threadIdx.x; asm volatile("" : "+v"(tid_));
  const int tid = tid_, wid = __builtin_amdgcn_readfirstlane(tid >> 6), lane = tid & 63, r32 = lane & 31, hi = lane >> 5;
  SBA_LAS char* V_lds = lds + OFF_V; SBA_LAS char* K_lds = lds + OFF_K; volatile SBA_LAS unsigned* flags = (volatile SBA_LAS unsigned*)(lds + OFF_FLAG);
  const long rowbase = (long)b * SEQ; const int q0 = qb * UNIT_ROWS;
  bf16x8 qr[8];
  { const unsigned short* Qw = Q + (rowbase + q0 + wid * QBLK + r32) * LDR + h * D + hi * 8;
#pragma unroll
    for (int d0 = 0; d0 < 8; ++d0) qr[d0] = *(const bf16x8*)(Qw + d0 * 16); }
  const unsigned short* Kh = K + rowbase * LDR + h * D; const unsigned short* Vh = V + rowbase * LDR + h * D;
  const int sr = tid >> 4, sc = (tid & 15) * 8, vst0 = v_st(sr, sc), vst1 = v_st(32 + sr, sc);
  const int vb0 = (int)(uintptr_t)V_lds + v_rd_base(lane);
  bf16x8 vs0, vs1, ks0, ks1;
#define SBA_SLOAD(k0) do { vs0 = *(const bf16x8*)(Vh + (long)((k0) + sr) * LDR + sc); vs1 = *(const bf16x8*)(Vh + (long)((k0) + 32 + sr) * LDR + sc); \
    ks0 = *(const bf16x8*)(Kh + (long)((k0) + sr) * LDR + sc); ks1 = *(const bf16x8*)(Kh + (long)((k0) + 32 + sr) * LDR + sc); } while (0)
#define SBA_SWRITE(bf) do { *(SBA_LAS bf16x8*)(V_lds + (bf) * SHM_V + vst0) = vs0; *(SBA_LAS bf16x8*)(V_lds + (bf) * SHM_V + vst1) = vs1; const int kc = sc * 2; \
    *(SBA_LAS bf16x8*)(K_lds + (bf) * SHM_K + SBA_KSWZ(sr, kc)) = ks0; *(SBA_LAS bf16x8*)(K_lds + (bf) * SHM_K + SBA_KSWZ(32 + sr, kc)) = ks1; } while (0)
  f16x8 U0, U1, ONES;
  { u32x4 w0, w1;
#pragma unroll
    for (int p = 0; p < 4; ++p) { const int ka = crow(2 * p, hi), kb = crow(2 * p + 1, hi), kc2 = crow(8 + 2 * p, hi), kd = crow(8 + 2 * p + 1, hi);
      w0[p] = (ka > r32 ? 0x3C00u : 0u) | (kb > r32 ? 0x3C000000u : 0u); w1[p] = (kc2 > r32 ? 0x3C00u : 0u) | (kd > r32 ? 0x3C000000u : 0u); }
    U0 = __builtin_bit_cast(f16x8, w0); U1 = __builtin_bit_cast(f16x8, w1);
    const u32x4 wo = {0x3C003C00u, 0x3C003C00u, 0x3C003C00u, 0x3C003C00u}; ONES = __builtin_bit_cast(f16x8, wo); }
  const int kt_top = 4 * qb + 3, my_kt = 4 * qb + (wid >> 1);
  const int ql = r32 + 32 * (wid & 1);
  float carry = 0.f; bool dead = false; f32x16 o[4] = {};
  SBA_SLOAD(kt_top * KVBLK); asm volatile("s_waitcnt vmcnt(0)" ::: "memory"); SBA_SWRITE(0); __syncthreads();
  for (int i = 0;; ++i) {
    const int kt = kt_top - i, cur = i & 1;
    if (kt > 0) SBA_SLOAD((kt - 1) * KVBLK);
    if (kt <= my_kt && !dead) {
      f32x16 p0, p1;
      qkt(p0, p1, K_lds + cur * SHM_K, qr, r32, hi);
      f32x16 lb0, lb1; float l10[16], l11[16];
#pragma unroll
      for (int r = 0; r < 16; ++r) { float a, c; sb_elem(p0[r], a, c); lb0[r] = a; l10[r] = c; sb_elem(p1[r], a, c); lb1[r] = a; l11[r] = c; }
      if (kt == my_kt) {
#pragma unroll
        for (int r = 0; r < 16; ++r) { const int k0 = crow(r, hi); const bool v0 = k0 < ql, v1 = (k0 + 32) < ql;
          l10[r] = v0 ? l10[r] : 0.f; lb0[r] = v0 ? lb0[r] : NEG; l11[r] = v1 ? l11[r] : 0.f; lb1[r] = v1 ? lb1[r] : NEG; }
      }
      const float lbk0 = lb0[0], l1k0 = l10[0];
      f16x8 h00, h01, h10, h11;
      { u32x4 a, c, e, g;
#pragma unroll
        for (int p = 0; p < 4; ++p) { a[p] = pkh(l10[2 * p], l10[2 * p + 1]); c[p] = pkh(l10[8 + 2 * p], l10[8 + 2 * p + 1]); e[p] = pkh(l11[2 * p], l11[2 * p + 1]); g[p] = pkh(l11[8 + 2 * p], l11[8 + 2 * p + 1]); }
        h00 = __builtin_bit_cast(f16x8, a); h01 = __builtin_bit_cast(f16x8, c); h10 = __builtin_bit_cast(f16x8, e); h11 = __builtin_bit_cast(f16x8, g); }
      lb1 = __builtin_amdgcn_mfma_f32_32x32x16_f16(U0, h10, lb1, 0, 0, 0); lb1 = __builtin_amdgcn_mfma_f32_32x32x16_f16(U1, h11, lb1, 0, 0, 0);
      lb0 = __builtin_amdgcn_mfma_f32_32x32x16_f16(U0, h00, lb0, 0, 0, 0); lb0 = __builtin_amdgcn_mfma_f32_32x32x16_f16(U1, h01, lb0, 0, 0, 0);
      lb0 = __builtin_amdgcn_mfma_f32_32x32x16_f16(ONES, h10, lb0, 0, 0, 0); lb0 = __builtin_amdgcn_mfma_f32_32x32x16_f16(ONES, h11, lb0, 0, 0, 0);
      float tot = (hi == 0) ? (lb0[0] - lbk0) + l1k0 : 0.f;
      { auto rr = __builtin_amdgcn_permlane32_swap(__float_as_uint(tot), __float_as_uint(tot), false, false); tot = __uint_as_float(rr[0]) + __uint_as_float(rr[1]); }
#pragma unroll
      for (int r = 0; r < 16; ++r) { lb0[r] = __builtin_amdgcn_exp2f(lb0[r] + carry); lb1[r] = __builtin_amdgcn_exp2f(lb1[r] + carry); }
      carry += tot;
      bf16x8 pa0, pa1, pa2, pa3;
#define SBA_PK4(P, BASE, OUT) do { unsigned a0 = cvtpk(P[BASE + 0], P[BASE + 1]), a1 = cvtpk(P[BASE + 2], P[BASE + 3]);   \
    unsigned b0 = cvtpk(P[BASE + 4], P[BASE + 5]), b1 = cvtpk(P[BASE + 6], P[BASE + 7]);                              \
    auto r0 = __builtin_amdgcn_permlane32_swap(a0, b0, false, false); auto r1 = __builtin_amdgcn_permlane32_swap(a1, b1, false, false); \
    u32x4 w = {r0[0], r1[0], r0[1], r1[1]}; OUT = __builtin_bit_cast(bf16x8, w); } while (0)
      SBA_PK4(lb0, 0, pa0); SBA_PK4(lb0, 8, pa1); SBA_PK4(lb1, 0, pa2); SBA_PK4(lb1, 8, pa3);
#undef SBA_PK4
      SBA_SBAR();
      const int vb = vb0 + cur * SHM_V;
      pv_one<0>(o[0], vb, pa0, pa1, pa2, pa3); pv_one<1>(o[1], vb, pa0, pa1, pa2, pa3); pv_one<2>(o[2], vb, pa0, pa1, pa2, pa3); pv_one<3>(o[3], vb, pa0, pa1, pa2, pa3);
      dead = !__any(carry > DEAD);
    }
    if (lane == 0) flags[cur * 8 + wid] = (kt > my_kt || !dead) ? 1u : 0u;
    if (kt > 0) { asm volatile("s_waitcnt vmcnt(0)" ::: "memory"); SBA_SWRITE(cur ^ 1); }
    __syncthreads();
    if (kt == 0) break;
    unsigned any = 0u;
#pragma unroll
    for (int w = 0; w < 8; ++w) any |= flags[cur * 8 + w];
    if (__builtin_amdgcn_readfirstlane(any) == 0u) break;
  }
  { signed char* Ow = O + (rowbase + q0 + wid * QBLK) * LDR + h * D; SBA_LAS signed char* stg = (SBA_LAS signed char*)(lds + OFF_OST) + wid * 4096;
#pragma unroll
    for (int r = 0; r < 16; ++r) { const int orow = crow(r, hi);
#pragma unroll
      for (int d0 = 0; d0 < 4; ++d0) { int q = __float2int_rn(o[d0][r] * oinv); q = q > 127 ? 127 : (q < -127 ? -127 : q); stg[orow * 128 + d0 * 32 + r32] = (signed char)q; } }
    asm volatile("s_waitcnt lgkmcnt(0)" ::: "memory");
#pragma unroll
    for (int i = 0; i < 4; ++i) { const int row = i * 8 + (lane >> 3), ch = lane & 7; const u32x4 v = *(const SBA_LAS u32x4*)(stg + row * 128 + ch * 16);
      *(u32x4*)(Ow + (long)row * LDR + ch * 16) = v; }
    asm volatile("s_waitcnt lgkmcnt(0)" ::: "memory");
  }
#undef SBA_SLOAD
#undef SBA_SWRITE
}
}
#define GAS __attribute__((address_space(1)))
#define LAS __attribute__((address_space(3)))
typedef unsigned short bf16;
typedef unsigned v4u __attribute__((ext_vector_type(4)));
typedef float f32x4 __attribute__((ext_vector_type(4)));
typedef short bf16x8 __attribute__((ext_vector_type(8)));
typedef GAS unsigned gu32;
typedef GAS unsigned long long gu64;
#define RLX_AGENT __ATOMIC_RELAXED, __HIP_MEMORY_SCOPE_AGENT
#define LDS_WAIT() asm volatile("s_waitcnt lgkmcnt(0)" ::: "memory")
#define VM_WAIT() asm volatile("s_waitcnt vmcnt(0)" ::: "memory")
__device__ __forceinline__ unsigned long long rt() { return __builtin_amdgcn_s_memrealtime(); }
__device__ __forceinline__ unsigned f2bf(float f) { unsigned u = __builtin_bit_cast(unsigned, f); return (u + 0x7fffu + ((u >> 16) & 1u)) >> 16; }
__device__ __forceinline__ unsigned pk2(float lo, float hi) { return f2bf(lo) | (f2bf(hi) << 16); }

#define XB_TMO      128
#define XB_XCNT(j)  (256  + 64 * (j))
#define XB_XSUB(j)  (1280 + 64 * (j))
#define XB_XGEN(j)  (2304 + 64 * (j))
#define XB_TOP      3328
#define XB_TOPGEN   3392
#define XCD_BAR_WORDS 3456
#define XB_SPIN_CAP (1u << 18)

__device__ __forceinline__ unsigned xb_ld(unsigned* p)              { return __hip_atomic_load(p, __ATOMIC_RELAXED, __HIP_MEMORY_SCOPE_AGENT); }
__device__ __forceinline__ unsigned xb_add(unsigned* p, unsigned v) { return __hip_atomic_fetch_add(p, v, __ATOMIC_RELAXED, __HIP_MEMORY_SCOPE_AGENT); }
__device__ __forceinline__ unsigned xb_xcc_id() { return (unsigned)__builtin_amdgcn_s_getreg((3 << 11) | 20) & 0xFu; }
#define XB_SPIN(cond, bar) do { unsigned _sp = 0; while (cond) { __builtin_amdgcn_s_sleep(1); \
    if ((++_sp & 255u) == 0u) { if (xb_ld(&(bar)[XB_TMO])) break; if (_sp > XB_SPIN_CAP) { atomicAdd(&(bar)[XB_TMO], 1u); break; } } } } while (0)

struct XcdBarrier {
    unsigned* bar; unsigned x;
    volatile LAS unsigned* st;
};

__device__ __forceinline__ XcdBarrier xcd_barrier_post(unsigned* bar, volatile LAS unsigned* st) {
    XcdBarrier b; b.bar = bar; b.x = xb_xcc_id(); b.st = st;
    if (threadIdx.x == 0) (void)xb_add(&bar[XB_XCNT(b.x)], 1u);
    return b;
}
__device__ __forceinline__ void xcd_barrier_complete(unsigned* bar, unsigned x, unsigned& nloc, unsigned& nx) {
    const unsigned G = gridDim.x * gridDim.y * gridDim.z;
    unsigned sum, cnt, mine, sp = 0u;
    for (;;) {
        sum = 0u; cnt = 0u; mine = 0u;
#pragma unroll
        for (unsigned j = 0; j < 16; ++j) { const unsigned c = xb_ld(&bar[XB_XCNT(j)]); sum += c; cnt += (c > 0u) ? 1u : 0u; mine = (j == x) ? c : mine; }
        if (sum == G) break;
        __builtin_amdgcn_s_sleep(1);
        if ((++sp & 255u) == 0u) { if (xb_ld(&bar[XB_TMO])) break; if (sp > XB_SPIN_CAP) { atomicAdd(&bar[XB_TMO], 1u); break; } }
    }
    nloc = mine > 0u ? mine : 1u; nx = cnt > 0u ? cnt : 1u;
}

__device__ __forceinline__ void xcd_barrier(const XcdBarrier& b) {
    asm volatile("s_waitcnt vmcnt(0)" ::: "memory");
    __syncthreads();
    if (threadIdx.x == 0) {
        unsigned* bar = b.bar;
        __builtin_amdgcn_s_waitcnt(0);
        unsigned nloc = b.st[0], nx = b.st[1];
        if (nloc == 0u) { xcd_barrier_complete(bar, b.x, nloc, nx); b.st[0] = nloc; b.st[1] = nx; }
        const unsigned old = xb_add(&bar[XB_XSUB(b.x)], 1u);
        const unsigned gen = old / nloc;
        if (old + 1u == (gen + 1u) * nloc) {
            __builtin_amdgcn_fence(__ATOMIC_RELEASE, "agent");
            asm volatile("s_waitcnt vmcnt(0)" ::: "memory");
            const unsigned og = xb_add(&bar[XB_TOP], 1u);
            const unsigned tg = og / nx;
            if (og + 1u == (tg + 1u) * nx) xb_add(&bar[XB_TOPGEN], 1u);
            else XB_SPIN(xb_ld(&bar[XB_TOPGEN]) == tg, bar);
            __builtin_amdgcn_fence(__ATOMIC_ACQUIRE, "agent");
            xb_add(&bar[XB_XGEN(b.x)], 1u);
            asm volatile("s_waitcnt vmcnt(0)" ::: "memory");
        } else {
            XB_SPIN(xb_ld(&bar[XB_XGEN(b.x)]) == gen, bar);
            __builtin_amdgcn_fence(__ATOMIC_ACQUIRE, "agent");
            asm volatile("s_waitcnt vmcnt(0)" ::: "memory");
        }
    }
    __syncthreads();
}

template <unsigned NG = 4u>
__device__ __forceinline__ void grp_barrier(unsigned* cnt, unsigned* mask, volatile LAS unsigned* ep, unsigned* bar, unsigned* nb_cnt = nullptr, unsigned* nb_mask = nullptr) {
    asm volatile("s_waitcnt vmcnt(0)" ::: "memory");
    __syncthreads();
    if (threadIdx.x == 0) {
        __builtin_amdgcn_s_waitcnt(0);
        const unsigned e = ep[0] + 1u; ep[0] = e;
        unsigned st = ep[1];
        if (st == 0u) { const unsigned m = xb_ld(mask); st = (m != 0u && (m & (m - 1u)) == 0u) ? 1u : 2u; ep[1] = st; }
        bool fast = (st == 1u);
        if (fast && nb_mask) fast = (xb_ld(nb_mask) == xb_ld(mask));
        if (!fast) { __builtin_amdgcn_fence(__ATOMIC_RELEASE, "agent"); asm volatile("s_waitcnt vmcnt(0)" ::: "memory"); }
        (void)xb_add(cnt, 1u);
        const unsigned target = NG * e;
        XB_SPIN(xb_ld(cnt) < target, bar);
        if (nb_cnt) XB_SPIN(xb_ld(nb_cnt) < target, bar);
        __builtin_amdgcn_fence(__ATOMIC_ACQUIRE, "agent");
        asm volatile("s_waitcnt vmcnt(0)" ::: "memory");
    }
    __syncthreads();
}

template <unsigned NG = 4u>
__device__ __forceinline__ void prefix_barrier(unsigned* cnt0, unsigned* mask0, int pm, int first, int last, volatile LAS unsigned* ep, unsigned* bar) {
    asm volatile("s_waitcnt vmcnt(0)" ::: "memory");
    __syncthreads();
    if (threadIdx.x < 64) {
        int lane_ = threadIdx.x; asm volatile("" : "+v"(lane_)); const int lane = lane_;
        __builtin_amdgcn_s_waitcnt(0);
        unsigned e = 0u;
        if (lane == 0) { e = ep[0] + 1u; ep[0] = e; }
        e = __builtin_amdgcn_readfirstlane(e);
        const unsigned own = xb_ld(mask0 + 64 * pm);
        const int g = first + lane;
        const unsigned mg = (g > pm && g <= last) ? xb_ld(mask0 + 64 * g) : own;
        const bool fast = (own != 0u) && ((own & (own - 1u)) == 0u) && __all(mg == own);
        if (!fast && lane == 0) { __builtin_amdgcn_fence(__ATOMIC_RELEASE, "agent"); asm volatile("s_waitcnt vmcnt(0)" ::: "memory"); }
        if (lane == 0) (void)xb_add(cnt0 + 64 * pm, 1u);
        const unsigned target = NG * e;
        unsigned sp = 0u;
        for (;;) {
            const unsigned v = (g <= pm) ? xb_ld(cnt0 + 64 * g) : target;
            if (__all(v >= target)) break;
            __builtin_amdgcn_s_sleep(1);
            if ((++sp & 255u) == 0u) { if (xb_ld(&bar[XB_TMO])) break; if (sp > XB_SPIN_CAP) { if (lane == 0) atomicAdd(&bar[XB_TMO], 1u); break; } }
        }
        __builtin_amdgcn_fence(__ATOMIC_ACQUIRE, "agent");
        asm volatile("s_waitcnt vmcnt(0)" ::: "memory");
    }
    __syncthreads();
}

constexpr int NWAVES = 8, NWAVES_ = 8;
constexpr int BATCH = 4, SEQ = 4096, DM = 2048, NH = 16, HD = 128, FF = 8192, DEPTH = 4, NMOD = 6;
constexpr int M = BATCH * SEQ;
constexpr int NMIX = 3 * DM;
constexpr float LN_EPS = 1e-5f;
constexpr float DN_ALPHA = 1.6817928305074290f;
constexpr float QSCALE = 0.088388347648318440f * 1.4426950408889634f;
constexpr float HID_SCALE = 32.0f, W2_SCALE = 128.0f;
constexpr int MODN = NMOD * DM;
constexpr int KSPLIT = 8;
constexpr size_t MiB = 1u << 20;
constexpr size_t WS_CTL = 0, CTL_ZERO_BYTES = 1 * MiB;
constexpr size_t WS_MODTAB = 1 * MiB;
constexpr size_t WS_PART = 2 * MiB;
constexpr size_t WS_W = 16 * MiB, W_LAYER = 96 * MiB, W_MIXIN = 0, W_MIXOUT = 24 * MiB, W_W1 = 32 * MiB, W_W2 = 64 * MiB;
constexpr size_t WS_H = 400 * MiB, WS_Q = 464 * MiB, WS_K = 528 * MiB, WS_V = 592 * MiB, WS_O = 656 * MiB;
constexpr size_t WS_HID = 720 * MiB, WS_END = 976 * MiB;
constexpr size_t WS_K2 = 912 * MiB, WS_V2 = 1040 * MiB, WS_G2 = 1104 * MiB  , WS_NEED = 1168 * MiB;
constexpr size_t WS_G = WS_HID + 128 * MiB;
constexpr size_t WS_Y = WS_Q;
constexpr size_t WS_X16 = 976 * MiB;
constexpr size_t WS_ROWS = 9 * MiB;
constexpr size_t WS_ROWSH = WS_ROWS + 64 * 1024;
constexpr size_t W_MIXOUT_CS = 4 * MiB;
constexpr size_t W_MIXIN_CS = 12 * MiB;
constexpr size_t W_W1_CS = 16 * MiB;
constexpr size_t WS_SCR = 1040 * MiB;
static_assert(WS_PART + (size_t)KSPLIT * DEPTH * BATCH * MODN * 4 <= WS_ROWS && WS_ROWS + (size_t)BATCH * SEQ * 4 <= WS_W && WS_W + DEPTH * W_LAYER <= WS_H && WS_HID + (size_t)M * FF * 2 <= WS_END, "d_ws map");
constexpr int CW_GMASK = 16384;
constexpr int CW_GRP = 8192;
constexpr int CW_A1 = 2048;
constexpr int CW_VMAX = 1024;
constexpr int CW_BAR = 4096;
constexpr int RING_OFF = 0, RING_BYTES = 131072;
constexpr int LDSCTL_OFF = RING_BYTES, MISC_OFF = LDSCTL_OFF + 320;
constexpr int LDS_BYTES = 147456;
static_assert(MISC_OFF + 128 <= LDS_BYTES && sba::LDS_BYTES <= RING_BYTES, "LDS map");

struct Frame {
    LAS unsigned char* lds;
    int tid, lane, wave, vcu, G, vrow;
};
template <int CTRL, int ROWMASK> __device__ __forceinline__ float dpp_mov(float old, float v) {
    return __builtin_bit_cast(float, __builtin_amdgcn_update_dpp(__builtin_bit_cast(int, old), __builtin_bit_cast(int, v), CTRL, ROWMASK, 0xF, false));
}
__device__ __forceinline__ float wave_sum(float v) {
    v += dpp_mov<0xB1, 0xF>(v, v); v += dpp_mov<0x4E, 0xF>(v, v); v += dpp_mov<0x141, 0xF>(v, v); v += dpp_mov<0x140, 0xF>(v, v);
    v += dpp_mov<0x142, 0xA>(0.f, v); v += dpp_mov<0x143, 0xC>(0.f, v);
    return __builtin_bit_cast(float, __builtin_amdgcn_readlane(__builtin_bit_cast(int, v), 63));
}
__device__ __forceinline__ unsigned cvtpk_bf16(float lo, float hi) { unsigned r; asm volatile("v_cvt_pk_bf16_f32 %0, %1, %2" : "=v"(r) : "v"(lo), "v"(hi)); return r; }
__host__ __device__ __forceinline__ int conv_in_row(int n0) { if (n0 < DM) return 2 * DM + n0; if (n0 < 2 * DM) { const int j = n0 - DM; return 256 * (j / 128) + (j % 128); } const int j = n0 - 2 * DM; return 256 * (j / 128) + 128 + (j % 128); }
template <bool CONV_IN = false, bool FP8 = false>
__device__ __forceinline__ void p0_transpose_item(const float* W, int K, int N, bf16* WT, LAS float* scr, int item, int lane, int scaled_cols = 0, float scale = 1.f) {
    const int nblk = N / 32, kb = item / nblk, nb = item % nblk, k0 = 64 * kb, n0 = 32 * nb;
#pragma unroll 8
    for (int i = 0; i < 32; ++i) { const int kk = 2 * i + (lane >> 5); scr[kk * 33 + (lane & 31)] = __builtin_nontemporal_load(&W[(size_t)(k0 + kk) * N + n0 + (lane & 31)]); }
    LDS_WAIT(); asm volatile("" ::: "memory");
    const int c = lane & 7; const float sf = (n0 < scaled_cols) ? scale : 1.f;
#pragma unroll
    for (int j = 0; j < 4; ++j) { const int n = (lane >> 3) + 8 * j; const LAS float* s = scr + (8 * c) * 33 + n;
        if constexpr (FP8) { float t[8];
#pragma unroll
            for (int i = 0; i < 8; ++i) t[i] = fminf(fmaxf(s[i * 33] * sf, -448.0f), 448.0f);
            int p0 = 0, p1 = 0; p0 = __builtin_amdgcn_cvt_pk_fp8_f32(t[0], t[1], p0, false); p0 = __builtin_amdgcn_cvt_pk_fp8_f32(t[2], t[3], p0, true);
            p1 = __builtin_amdgcn_cvt_pk_fp8_f32(t[4], t[5], p1, false); p1 = __builtin_amdgcn_cvt_pk_fp8_f32(t[6], t[7], p1, true);
            uint2 o; o.x = (unsigned)p0; o.y = (unsigned)p1; *(uint2*)((unsigned char*)WT + (size_t)(n0 + n) * K + k0 + 8 * c) = o; }
        else {
        v4u o; o.x = cvtpk_bf16(s[0 * 33] * sf, s[1 * 33] * sf); o.y = cvtpk_bf16(s[2 * 33] * sf, s[3 * 33] * sf); o.z = cvtpk_bf16(s[4 * 33] * sf, s[5 * 33] * sf); o.w = cvtpk_bf16(s[6 * 33] * sf, s[7 * 33] * sf);
        *(v4u*)(WT + (size_t)((CONV_IN ? conv_in_row(n0) : n0) + n) * K + k0 + 8 * c) = o; } }
    LDS_WAIT(); asm volatile("" ::: "memory");
}

__device__ __forceinline__ void p0_w1_item(const float* W, int K, int N, signed char* WT8, float* cs, LAS float* scr, LAS float* red  , int item, int wave, int lane, int scaled_cols = 0, float cs_factor = 1.f) {
    const int n0 = 16 * item, c = lane & 15, kq = lane >> 4, kw = (K / NWAVES_) * wave;
    float mx = 0.f;
    for (int i = 0; i < K / NWAVES_ / 4; i += 16) { float t[16];
#pragma unroll
        for (int j = 0; j < 16; ++j) t[j] = W[(size_t)(kw + 4 * (i + j) + kq) * N + n0 + c];
#pragma unroll
        for (int j = 0; j < 16; ++j) mx = fmaxf(mx, fabsf(t[j])); }
    mx = fmaxf(mx, __shfl_xor(mx, 16)); mx = fmaxf(mx, __shfl_xor(mx, 32));
    if (lane < 16) red[wave * 16 + c] = mx;
    __syncthreads();
#pragma unroll
    for (int w = 0; w < NWAVES_; ++w) mx = fmaxf(mx, red[w * 16 + c]);
    const float sc = mx > 0.f ? mx * (1.0f / 127.0f) : 1.0f;
    if (wave == 0 && lane < 16) cs[n0 + c] = (n0 < scaled_cols) ? sc * cs_factor : sc;
    const int n = lane >> 2, kb = lane & 3; const float inv = 1.0f / __shfl(sc, n);
    for (int k0 = kw; k0 < kw + K / NWAVES_; k0 += 64) {
#pragma unroll
        for (int i = 0; i < 16; ++i) { const int kk = 4 * i + kq; scr[kk * 17 + c] = W[(size_t)(k0 + kk) * N + n0 + c]; }
        LDS_WAIT(); asm volatile("" ::: "memory");
        v4u o;
#pragma unroll
        for (int q = 0; q < 4; ++q) { unsigned w = 0;
#pragma unroll
            for (int j = 0; j < 4; ++j) { const int qv = __float2int_rn(scr[(16 * kb + 4 * q + j) * 17 + n] * inv); w |= ((unsigned)qv & 0xffu) << (8 * j); }
            o[q] = w; }
        *(v4u*)(WT8 + (size_t)(n0 + n) * K + k0 + 16 * kb) = o;
        LDS_WAIT(); asm volatile("" ::: "memory");
    }
    __syncthreads();
}
struct Args { const float* in[16]; float* out; unsigned char* ws; int ph_lo, ph_hi; };
constexpr int NPHASE = 2 + 7 * DEPTH;

__device__ __forceinline__ void phase_prologue_a(Frame& F, const Args& a, int lay_lo, int lay_hi, int rank, int nrank, bool with_gemv, int tr_shift = 0) {
    const int gw = rank * NWAVES + F.wave, NGW = nrank * NWAVES;
    LAS float* sil = (LAS float*)(F.lds + 69632);
    if (with_gemv) {
    for (int e = F.tid; e < BATCH * DM; e += NWAVES * 64) { const int b = e / DM, k = e % DM; const float cv = a.in[1][e]; sil[k * 4 + b] = cv / (1.0f + __expf(-cv)); }
    __syncthreads();
    constexpr int MCB = 192, NMCB = MODN / MCB;
    for (int task = gw; task < DEPTH * NMCB * KSPLIT; task += NGW) {
        const int l = task / (NMCB * KSPLIT), rem = task % (NMCB * KSPLIT), cb = rem / KSPLIT, kc = rem % KSPLIT;
        if (F.lane < MCB / 4) {
        const float* W = a.in[2] + (size_t)l * DM * MODN + (size_t)(kc * 256) * MODN + cb * MCB + 4 * F.lane;
        f32x4 acc0 = {0.f, 0.f, 0.f, 0.f}, acc1 = acc0, acc2 = acc0, acc3 = acc0;
        for (int k0 = 0; k0 < 256; k0 += 8) {
            f32x4 w[8];
#pragma unroll
            for (int j = 0; j < 8; ++j) w[j] = __builtin_nontemporal_load((const f32x4*)(W + (size_t)(k0 + j) * MODN));
#pragma unroll
            for (int j = 0; j < 8; ++j) { const f32x4 s = *(const LAS f32x4*)(sil + (kc * 256 + k0 + j) * 4); acc0 += w[j] * s[0]; acc1 += w[j] * s[1]; acc2 += w[j] * s[2]; acc3 += w[j] * s[3]; }
        }
        float* P = (float*)(a.ws + WS_PART) + ((size_t)(kc * DEPTH + l) * BATCH) * MODN + cb * MCB + 4 * F.lane;
        *(f32x4*)(P) = acc0; *(f32x4*)(P + MODN) = acc1; *(f32x4*)(P + 2 * MODN) = acc2; *(f32x4*)(P + 3 * MODN) = acc3;
        }
    }
    }
    LAS float* scr = (LAS float*)(F.lds + F.wave * 8704);
    constexpr int I_IN = (DM / 64) * (NMIX / 32), I_OUT = (DM / 64) * (DM / 32), I_2 = (FF / 64) * (DM / 32), I_LAYER = I_IN + I_OUT + I_2;
    for (int it = lay_lo * I_LAYER + (lay_lo ? tr_shift : 0) + gw; it < lay_hi * I_LAYER + (lay_hi < DEPTH ? tr_shift : 0); it += NGW) {
        const int l = it / I_LAYER; int r = it % I_LAYER; const int j = l >> 1;
        bf16* wl = (bf16*)(a.ws + WS_W + (size_t)l * W_LAYER);
        if (r < I_IN) { if (l & 1) p0_transpose_item<true>(a.in[8] + (size_t)j * DM * NMIX, DM, NMIX, (bf16*)((unsigned char*)wl + W_MIXIN), scr, r, F.lane); continue; }     r -= I_IN;
        if (r < I_OUT) { if (l & 1) p0_transpose_item(a.in[11] + (size_t)j * DM * DM, DM, DM, (bf16*)((unsigned char*)wl + W_MIXOUT), scr, r, F.lane); continue; }     r -= I_OUT;
        p0_transpose_item<false, true>(a.in[14] + (size_t)l * FF * DM, FF, DM, (bf16*)((unsigned char*)wl + W_W2), scr, r, F.lane, DM, W2_SCALE);
    }
    LAS float* red = (LAS float*)(F.lds + 102400);
    for (int it = rank; it < (DEPTH / 2) * (NMIX / 16); it += nrank) { const int ja = it / (NMIX / 16), r = it % (NMIX / 16); if (2 * ja < lay_lo || 2 * ja >= lay_hi) continue; unsigned char* wq = a.ws + WS_W + (size_t)(2 * ja) * W_LAYER + W_MIXIN;
        p0_w1_item(a.in[6] + (size_t)ja * DM * NMIX, DM, NMIX, (signed char*)wq, (float*)(wq + W_MIXIN_CS), scr, red, r, F.wave, F.lane, DM, QSCALE); }
    for (int it = rank; it < (DEPTH / 2) * (DM / 16); it += nrank) { const int ja = it / (DM / 16), r = it % (DM / 16); if (2 * ja < lay_lo || 2 * ja >= lay_hi) continue; unsigned char* wo = a.ws + WS_W + (size_t)(2 * ja) * W_LAYER + W_MIXOUT;
        p0_w1_item(a.in[7] + (size_t)ja * DM * DM, DM, DM, (signed char*)wo, (float*)(wo + W_MIXOUT_CS), scr, red, r, F.wave, F.lane); }
    for (int it = lay_lo * (FF / 16) + rank; it < lay_hi * (FF / 16); it += nrank) { const int l = it / (FF / 16), r = it % (FF / 16); unsigned char* w1 = a.ws + WS_W + (size_t)l * W_LAYER + W_W1;
        p0_w1_item(a.in[12] + (size_t)l * DM * FF, DM, FF, (signed char*)w1, (float*)(w1 + W_W1_CS), scr, red, r, F.wave, F.lane); }
}
typedef unsigned u32x2v __attribute__((ext_vector_type(2)));
__device__ __forceinline__ uint2 ld_nt_u2(const void* p) { const u32x2v v = __builtin_nontemporal_load((const u32x2v*)p); uint2 r; r.x = v[0]; r.y = v[1]; return r; }
__device__ __forceinline__ void st_nt_u2(void* p, const uint2 w) { const u32x2v v = {w.x, w.y}; __builtin_nontemporal_store(v, (u32x2v*)p); }
__device__ __forceinline__ uint2 q16_pack(const f32x4 v, float inv) {
    const int a = __float2int_rn(v[0] * inv), b = __float2int_rn(v[1] * inv), c = __float2int_rn(v[2] * inv), d = __float2int_rn(v[3] * inv);
    uint2 w; w.x = ((unsigned)a & 0xffffu) | ((unsigned)b << 16); w.y = ((unsigned)c & 0xffffu) | ((unsigned)d << 16); return w;
}
__device__ __forceinline__ f32x4 q16_unpack(const uint2 w, float sc) {
    const f32x4 v = {(float)((int)(w.x << 16) >> 16), (float)((int)w.x >> 16), (float)((int)(w.y << 16) >> 16), (float)((int)w.y >> 16)}; return v * sc;
}
__device__ __forceinline__ float wave_max(float v) {
    v = fmaxf(v, dpp_mov<0xB1, 0xF>(v, v)); v = fmaxf(v, dpp_mov<0x4E, 0xF>(v, v)); v = fmaxf(v, dpp_mov<0x141, 0xF>(v, v)); v = fmaxf(v, dpp_mov<0x140, 0xF>(v, v));
    v = fmaxf(v, dpp_mov<0x142, 0xA>(0.f, v)); v = fmaxf(v, dpp_mov<0x143, 0xC>(0.f, v));
    return __builtin_bit_cast(float, __builtin_amdgcn_readlane(__builtin_bit_cast(int, v), 63));
}
__device__ __forceinline__ void phase_prologue_b(Frame& F, const Args& a) {
    const float* part = (const float*)(a.ws + WS_PART); float* modtab = (float*)(a.ws + WS_MODTAB); const float* mod_b = a.in[3];
    for (int e = F.vcu * NWAVES * 64 + F.tid; e < DEPTH * BATCH * MODN; e += F.G * NWAVES * 64) {
        const int l = e / (BATCH * MODN), rem = e % (BATCH * MODN), b = rem / MODN, n = rem % MODN;
        float s = mod_b[l * MODN + n];
#pragma unroll
        for (int kc = 0; kc < KSPLIT; ++kc) s += part[((size_t)(kc * DEPTH + l) * BATCH + b) * MODN + n];
        if ((n / DM) % 3 != 0) s += 1.0f;
        modtab[e] = s;
    }
    const int rows_wg = M / F.G, row0 = F.vrow * rows_wg, b = row0 / SEQ;
    LAS float* ST = (LAS float*)(F.lds);
    for (int c = F.tid; c < 2 * DM; c += NWAVES * 64) {
        float s = mod_b[c];
#pragma unroll
        for (int kc = 0; kc < KSPLIT; ++kc) s += part[((size_t)(kc * DEPTH + 0) * BATCH + b) * MODN + c];
        ST[c] = (c >= DM) ? s + 1.0f : s;
    }
    __syncthreads();
    const int rows_wave = rows_wg / NWAVES;
    f32x4 Sv0[8], Tv0[8];
#pragma unroll
    for (int j = 0; j < 8; ++j) { Tv0[j] = *(const LAS f32x4*)(ST + 4 * F.lane + 256 * j); Sv0[j] = *(const LAS f32x4*)(ST + DM + 4 * F.lane + 256 * j); }
    f32x4 xn[8];
    { const float* x0 = a.in[0] + ((size_t)row0 + F.wave * rows_wave) * DM;
#pragma unroll
      for (int j = 0; j < 8; ++j) xn[j] = __builtin_nontemporal_load((const f32x4*)(x0 + 4 * F.lane + 256 * j)); }
    for (int r = 0; r < rows_wave; ++r) {
        const size_t row = (size_t)row0 + F.wave * rows_wave + r;
        const float* xr = a.in[0] + row * DM; short* qr = (short*)(a.ws + WS_X16) + row * DM; unsigned char* hr = a.ws + WS_H + row * DM;
        f32x4 v[8]; float mx = 0.f;
#pragma unroll
        for (int j = 0; j < 8; ++j) { v[j] = xn[j]; mx = fmaxf(fmaxf(mx, fmaxf(fabsf(v[j][0]), fabsf(v[j][1]))), fmaxf(fabsf(v[j][2]), fabsf(v[j][3]))); }
        if (r + 1 < rows_wave) {
#pragma unroll
            for (int j = 0; j < 8; ++j) xn[j] = __builtin_nontemporal_load((const f32x4*)(xr + DM + 4 * F.lane + 256 * j)); }
        mx = wave_max(mx); const float rs = mx > 0.f ? mx * (1.0f / 32767.0f) : 1.0f, inv = 1.0f / rs;
        if (F.lane == 0) ((float*)(a.ws + WS_ROWS))[row] = rs;
        f32x4 hv[8]; float mh = 0.f;
#pragma unroll
        for (int j = 0; j < 8; ++j) { const int col = 4 * F.lane + 256 * j;
            hv[j] = v[j] * Sv0[j] + Tv0[j];
            mh = fmaxf(fmaxf(mh, fmaxf(fabsf(hv[j][0]), fabsf(hv[j][1]))), fmaxf(fabsf(hv[j][2]), fabsf(hv[j][3])));
            st_nt_u2(qr + col, q16_pack(v[j], inv)); }
        mh = wave_max(mh); const float hs = mh > 0.f ? mh * (1.0f / 127.0f) : 1.0f, hinv = 1.0f / hs;
        if (F.lane == 0) ((float*)(a.ws + WS_ROWSH))[row] = hs;
        signed char* h8 = (signed char*)hr;
#pragma unroll
        for (int j = 0; j < 8; ++j) { const unsigned w = ((unsigned)__float2int_rn(hv[j][0] * hinv) & 0xffu) | (((unsigned)__float2int_rn(hv[j][1] * hinv) & 0xffu) << 8) | (((unsigned)__float2int_rn(hv[j][2] * hinv) & 0xffu) << 16) | ((unsigned)__float2int_rn(hv[j][3] * hinv) << 24);
            *(unsigned*)(h8 + 4 * F.lane + 256 * j) = w; }
    }
}
__device__ __forceinline__ void phase_ln(Frame& F, const Args& a, const bf16* Y, const float* lg, const float* lb, const float* Tn, const float* Sn, bool write_h, long xo_off = 0, long ho_off = 0, long qo_off = 0, bool h_int8 = false) {
    const int rows_wg = M / F.G, row0 = F.vrow * rows_wg, b = row0 / SEQ, rows_wave = rows_wg / NWAVES;
    LAS float* ST = (LAS float*)(F.lds);
    for (int c = F.tid; c < DM; c += NWAVES * 64) { ST[c] = Sn[(size_t)b * MODN + c]; ST[DM + c] = Tn[(size_t)b * MODN + c]; ST[2 * DM + c] = lg[c]; ST[3 * DM + c] = lb[c]; }
    __syncthreads();
    f32x4 Sv[8], Tv[8];
#pragma unroll
    for (int j = 0; j < 8; ++j) { Sv[j] = *(const LAS f32x4*)(ST + 4 * F.lane + 256 * j); Tv[j] = *(const LAS f32x4*)(ST + DM + 4 * F.lane + 256 * j); }
#define g4_(j) (*(const LAS f32x4*)(ST + 2 * DM + 4 * F.lane + 256 * (j)))
#define b4_(j) (*(const LAS f32x4*)(ST + 3 * DM + 4 * F.lane + 256 * (j)))
    uint2 yw[8], xw[8]; float rs_raw;
    { const size_t row = (size_t)row0 + F.wave * rows_wave; const bf16* yr = Y + row * DM; const short* qr = (const short*)(a.ws + WS_X16) + row * DM;
#pragma unroll
      for (int j = 0; j < 8; ++j) { yw[j] = ld_nt_u2((yr + 4 * F.lane + 256 * j)); xw[j] = ld_nt_u2((qr + 4 * F.lane + 256 * j)); }
      rs_raw = ((const float*)(a.ws + WS_ROWS))[row]; }
    for (int r = 0; r < rows_wave; ++r) {
        const size_t row = (size_t)row0 + F.wave * rows_wave + r;
        float* xr = a.out + row * DM; short* qr = (short*)(a.ws + WS_X16) + row * DM; bf16* hr = (bf16*)(a.ws + WS_H) + row * DM;
        float* rsp = (float*)(a.ws + WS_ROWS) + row; const float rs_in = rs_raw * DN_ALPHA;
        f32x4 v[8]; float s = 0.f;
#pragma unroll
        for (int j = 0; j < 8; ++j) { const f32x4 yv = {__uint_as_float(yw[j].x << 16), __uint_as_float(yw[j].x & 0xffff0000u), __uint_as_float(yw[j].y << 16), __uint_as_float(yw[j].y & 0xffff0000u)};
            v[j] = q16_unpack(xw[j], rs_in) + yv; s += (v[j][0] + v[j][1]) + (v[j][2] + v[j][3]); }
        if (r + 1 < rows_wave) { const bf16* yn = Y + (row + 1) * DM; const short* qn = (const short*)(a.ws + WS_X16) + (row + 1) * DM;
#pragma unroll
            for (int j = 0; j < 8; ++j) { yw[j] = ld_nt_u2((yn + 4 * F.lane + 256 * j)); xw[j] = ld_nt_u2((qn + 4 * F.lane + 256 * j)); }
            rs_raw = ((const float*)(a.ws + WS_ROWS))[row + 1]; }
        const float mean = wave_sum(s) * (1.0f / DM); float s2 = 0.f;
#pragma unroll
        for (int j = 0; j < 8; ++j) { v[j] = v[j] - mean; s2 += (v[j][0] * v[j][0] + v[j][1] * v[j][1]) + (v[j][2] * v[j][2] + v[j][3] * v[j][3]); }
        const float rstd = 1.0f / sqrtf(wave_sum(s2) * (1.0f / DM) + LN_EPS);
        if (!write_h) {
#pragma unroll
            for (int j = 0; j < 8; ++j) { const int col = 4 * F.lane + 256 * j; __builtin_nontemporal_store((v[j] * rstd) * g4_(j) + b4_(j), (f32x4*)(xr + xo_off + col)); }
        } else {
            float mx = 0.f;
            if (h_int8) {
                float mh = 0.f;
#pragma unroll
                for (int j = 0; j < 8; ++j) { v[j] = (v[j] * rstd) * g4_(j) + b4_(j); const f32x4 hv = v[j] * Sv[j] + Tv[j];
                    mx = fmaxf(fmaxf(mx, fmaxf(fabsf(v[j][0]), fabsf(v[j][1]))), fmaxf(fabsf(v[j][2]), fabsf(v[j][3])));
                    mh = fmaxf(fmaxf(mh, fmaxf(fabsf(hv[0]), fabsf(hv[1]))), fmaxf(fabsf(hv[2]), fabsf(hv[3]))); if (j & 1) asm volatile("" ::: "memory"); }
                mh = wave_max(mh); const float hs = mh > 0.f ? mh * (1.0f / 127.0f) : 1.0f, hinv = 1.0f / hs;
                if (F.lane == 0 && qo_off == 0) ((float*)(a.ws + WS_ROWSH))[row] = hs;
                signed char* h8 = (signed char*)(a.ws + WS_H) + row * DM + ho_off;
#pragma unroll
                for (int j = 0; j < 8; ++j) { const f32x4 hv = (v[j] * Sv[j] + Tv[j]) * hinv;
                    const unsigned w = ((unsigned)__float2int_rn(hv[0]) & 0xffu) | (((unsigned)__float2int_rn(hv[1]) & 0xffu) << 8) | (((unsigned)__float2int_rn(hv[2]) & 0xffu) << 16) | ((unsigned)__float2int_rn(hv[3]) << 24);
                    *(unsigned*)(h8 + 4 * F.lane + 256 * j) = w; if (j & 1) asm volatile("" ::: "memory"); }
            } else {
#pragma unroll
            for (int j = 0; j < 8; ++j) { v[j] = (v[j] * rstd) * g4_(j) + b4_(j); const f32x4 hv = v[j] * Sv[j] + Tv[j];
                mx = fmaxf(fmaxf(mx, fmaxf(fabsf(v[j][0]), fabsf(v[j][1]))), fmaxf(fabsf(v[j][2]), fabsf(v[j][3])));
                uint2 w; w.x = cvtpk_bf16(hv[0], hv[1]); w.y = cvtpk_bf16(hv[2], hv[3]); *(uint2*)(hr + ho_off + 4 * F.lane + 256 * j) = w; }
            }
            mx = wave_max(mx); const float rs = mx > 0.f ? mx * (1.0f / 32767.0f) : 1.0f, inv = 1.0f / rs;
            if (F.lane == 0 && qo_off == 0) *rsp = rs;
#pragma unroll
            for (int j = 0; j < 8; ++j) st_nt_u2(qr + qo_off + 4 * F.lane + 256 * j, q16_pack(v[j], inv));
        }
    }
}
#undef g4_
#undef b4_
__device__ __forceinline__ void bf8_to_f32(const bf16x8 v, float (&f)[8]) {
#pragma unroll
    for (int i = 0; i < 8; ++i) f[i] = __uint_as_float(((unsigned)(unsigned short)v[i]) << 16);
}
__device__ __forceinline__ void phase_conv(Frame& F, const Args& a, const float* cw, const float* cb, const bf16* Gg) {
    const bf16* Bg = (const bf16*)(a.ws + WS_Q); bf16* Out = (bf16*)(a.ws + WS_O);
    constexpr int TT = 8; const int rows_wg = M / F.G, ntask = (rows_wg / TT) * (DM / 8);
    for (int task = F.tid; task < ntask; task += NWAVES * 64) {
        const int chunk = task & (DM / 8 - 1), run = F.vrow * (rows_wg / TT) + task / (DM / 8), ch0 = chunk * 8, m0 = run * TT; const bool first = (m0 % SEQ) == 0;
        float w0[8], w1[8], w2[8], bb[8];
#pragma unroll
        for (int i = 0; i < 8; ++i) { w0[i] = cw[ch0 + i]; w1[i] = cw[DM + ch0 + i]; w2[i] = cw[2 * DM + ch0 + i]; bb[i] = cb[ch0 + i]; }
        float g2[8], g1[8];
        if (first) {
#pragma unroll
            for (int i = 0; i < 8; ++i) { g2[i] = 0.f; g1[i] = 0.f; }
        } else { bf8_to_f32(*(const bf16x8*)(Gg + (size_t)(m0 - 2) * DM + ch0), g2); bf8_to_f32(*(const bf16x8*)(Gg + (size_t)(m0 - 1) * DM + ch0), g1); }
        bf16x8 gr[TT], br[TT];
#pragma unroll
        for (int t = 0; t < TT; ++t) { gr[t] = __builtin_nontemporal_load((const bf16x8*)(Gg + (size_t)(m0 + t) * DM + ch0)); br[t] = __builtin_nontemporal_load((const bf16x8*)(Bg + (size_t)(m0 + t) * DM + ch0)); }
#pragma unroll
        for (int t = 0; t < TT; ++t) {
            float bg[8], g0[8], y[8];
            bf8_to_f32(gr[t], g0); bf8_to_f32(br[t], bg);
#pragma unroll
            for (int i = 0; i < 8; ++i) { y[i] = bg[i] * (w0[i] * g2[i] + w1[i] * g1[i] + w2[i] * g0[i] + bb[i]); g2[i] = g1[i]; g1[i] = g0[i]; }
            v4u o; o.x = cvtpk_bf16(y[0], y[1]); o.y = cvtpk_bf16(y[2], y[3]); o.z = cvtpk_bf16(y[4], y[5]); o.w = cvtpk_bf16(y[6], y[7]);
            *(v4u*)(Out + (size_t)(m0 + t) * DM + ch0) = o;
        }
    }
}

#ifndef MK_MF32
#define MK_MF32 0
#endif
#ifndef MK_STAGGER_US
#define MK_STAGGER_US 60
#endif
#ifndef MK_DUP
#define MK_DUP 0
#endif
#define NREP(bit) ((MK_DUP & (bit)) ? 2 : 1)
#ifndef MK_DIS
#define MK_DIS 0
#endif
__global__ void __launch_bounds__(NWAVES * 64, 2) mk_fwd(Args args) {
    extern __shared__ __attribute__((aligned(16))) unsigned char lds[];
    Frame F;
    F.lds = (LAS unsigned char*)lds;
    volatile LAS unsigned* MISC = (volatile LAS unsigned*)(F.lds + MISC_OFF);
    F.tid = threadIdx.x; F.lane = F.tid & 63; F.wave = __builtin_amdgcn_readfirstlane(F.tid >> 6);
    F.G = gridDim.x; { const int bx = blockIdx.x; F.vcu = (F.G % 8 == 0) ? (bx % 8) * (F.G / 8) + bx / 8 : bx; }
    unsigned char* ws = args.ws;
    const bool grp_mode = (F.G == 256);
    { const int bx = blockIdx.x, pm_ = 8 * (bx % 8) + (bx / 8) % 8; F.vrow = grp_mode ? 4 * pm_ + bx / 64 : F.vcu; }
    unsigned* grp_mask = (unsigned*)(ws + WS_CTL) + CW_GMASK + 64 * ((F.vrow >> 2) & 63);
    if (threadIdx.x == 0) (void)__hip_atomic_fetch_or(grp_mask, 1u << xb_xcc_id(), __ATOMIC_RELAXED, __HIP_MEMORY_SCOPE_AGENT);
    unsigned* grp_cnt = (unsigned*)(ws + WS_CTL) + CW_GRP + 64 * ((F.vrow >> 2) & 63);
    for (int u = F.tid; u < (LDS_BYTES - LDSCTL_OFF) / 4; u += NWAVES * 64) ((LAS unsigned*)(F.lds + LDSCTL_OFF))[u] = 0u;
    __syncthreads();
    XcdBarrier bar = xcd_barrier_post((unsigned*)(ws + WS_CTL) + CW_BAR, MISC + 8);
    const int lo = args.ph_lo, hi = args.ph_hi;
#define FRESH() do { int t_ = threadIdx.x; asm volatile("" : "+v"(t_)); F.tid = t_; F.lane = t_ & 63; F.wave = __builtin_amdgcn_readfirstlane(t_ >> 6); } while (0)
#define IN(k) (lo <= (k) && (k) < hi)
#define SEAM(k) do { if ((k) + 1 < hi) { xcd_barrier(bar); if (MK_DUP & 8192) xcd_barrier(bar); } } while (0)
#define CSEAM(k) do { if ((k) + 1 < hi) { if (grp_mode) { const int pm_ = F.vrow >> 2; unsigned* c0_ = (unsigned*)(ws + WS_CTL) + CW_GRP; unsigned* m0_ = (unsigned*)(ws + WS_CTL) + CW_GMASK; \
        grp_barrier(grp_cnt, grp_mask, MISC + 10, bar.bar, (pm_ % (SEQ / 256)) ? c0_ + 64 * (pm_ - 1) : nullptr, ((pm_ + 1) % (SEQ / 256)) ? m0_ + 64 * (pm_ + 1) : nullptr); } else xcd_barrier(bar); } } while (0)
#define ASEAM(k) do { if ((k) + 1 < hi) { if (grp_mode) { const int pm_ = F.vrow >> 2, f_ = pm_ - pm_ % (SEQ / 256); \
        prefix_barrier((unsigned*)(ws + WS_CTL) + CW_GRP, (unsigned*)(ws + WS_CTL) + CW_GMASK, pm_, f_, f_ + SEQ / 256 - 1, MISC + 10, bar.bar); } else xcd_barrier(bar); } } while (0)
#define GSEAM(k) do { if ((k) + 1 < hi) { if (grp_mode) grp_barrier(grp_cnt, grp_mask, MISC + 10, bar.bar); else xcd_barrier(bar); } } while (0)
    float* modtab = (float*)(ws + WS_MODTAB);
    const long scr_off = MK_DUP ? (long)((float*)(ws + WS_SCR) - args.out) : 0, hscr_off = MK_DUP ? (long)((bf16*)(ws + WS_SCR) - (bf16*)(ws + WS_H)) : 0, qscr_off = MK_DUP ? (long)((short*)(ws + WS_SCR + 64 * MiB) - (short*)(ws + WS_X16)) : 0;
    bf16* Hb = (bf16*)(ws + WS_H); bf16* Qb = (bf16*)(ws + WS_Q); bf16* Ob = (bf16*)(ws + WS_O); bf16* HIDb = (bf16*)(ws + WS_HID); bf16* Yb = (bf16*)(ws + WS_Y);

    if (IN(0)) {
#if !(MK_DIS & 1)
        for (int rep = 0; rep < NREP(1); ++rep) { FRESH(); phase_prologue_a(F, args, 0, grp_mode ? DEPTH - 1 : DEPTH, F.vcu, F.G, true, (DM / 64) * (NMIX / 32)); }
#endif
        SEAM(0); }
    if (IN(1)) {
#if !(MK_DIS & 2)
        for (int rep = 0; rep < NREP(2); ++rep) { FRESH(); phase_prologue_b(F, args); }
#endif
        SEAM(1);
        if (grp_mode && (F.vrow >> 2) >= (M / 256) / 2) {
            FRESH(); phase_prologue_a(F, args, DEPTH - 1, DEPTH, F.vrow - (M / 256) * 2, (M / 256) * 2, false, (DM / 64) * (NMIX / 32));
            asm volatile("s_waitcnt vmcnt(0)" ::: "memory"); __syncthreads();
            if (threadIdx.x == 0) { __builtin_amdgcn_fence(__ATOMIC_RELEASE, "agent"); asm volatile("s_waitcnt vmcnt(0)" ::: "memory"); (void)xb_add((unsigned*)(ws + WS_CTL) + CW_A1, 1u); }
        }
        }
    for (int l = 0; l < DEPTH; ++l) {
        const int pb = 2 + 7 * l, j = l >> 1; const bool is_conv = (l & 1) != 0;
        if (grp_mode && l == DEPTH - 1 && IN(pb + 0)) {
            if (threadIdx.x == 0) { unsigned* w_ = (unsigned*)(ws + WS_CTL) + CW_A1; XB_SPIN(xb_ld(w_) < (unsigned)((M / 256) * 2), bar.bar); __builtin_amdgcn_fence(__ATOMIC_ACQUIRE, "agent"); asm volatile("s_waitcnt vmcnt(0)" ::: "memory"); }
            __syncthreads(); }
        bf16* Gb = (bf16*)(ws + ((j & 1) ? WS_G2 : WS_G));
        bf16* Kb = (bf16*)(ws + ((j & 1) ? WS_K2 : WS_K)); bf16* Vb = (bf16*)(ws + ((j & 1) ? WS_V2 : WS_V));
        const unsigned char* wl = ws + WS_W + (size_t)l * W_LAYER;
        const float* mt = modtab + (size_t)l * BATCH * MODN;
        if (IN(pb + 0)) {
            pg8::Gemm g{Hb, (const bf16*)(wl + W_MIXIN), M, NMIX, DM}; pg8::StaticOrder S; S.init(M, NMIX, F.G, (int)blockIdx.x);
            if (is_conv) {
                pg8::EpiConvIn E{Gb, Qb, DM, DM / 128};
#if !(MK_DIS & 4)
                for (int rep = 0; rep < NREP(4); ++rep) pg8::gemm_phase<pg8::EpiConvIn, pg8::StaticOrder, true, true>(F.lds + RING_OFF, g, S, E);
#endif
            } else {
                pg8::EpiI8Bf16Split E{Qb, DM, (const float*)(ws + WS_ROWSH), (const float*)(wl + W_MIXIN + W_MIXIN_CS), DM, Kb, Vb, (unsigned*)(ws + WS_CTL) + CW_VMAX + 64 * j};
#if !(MK_DIS & 4)
                for (int rep = 0; rep < NREP(4); ++rep) pg8::gemm_phase<pg8::EpiI8Bf16Split, pg8::StaticOrder, true, true, 0, 1, true>(F.lds + RING_OFF, g, S, E);
#endif
#if (MK_DUP & 1024)
                { pg8::EpiNull EN; pg8::gemm_phase<pg8::EpiNull, pg8::StaticOrder, true, true, 0, 1, true>(F.lds + RING_OFF, g, S, EN); }
#endif
#if (MK_DUP & 262144)
                { pg8::EpiNull EN; pg8::gemm_phase<pg8::EpiNull, pg8::StaticOrder, true, true, 3>(F.lds + RING_OFF, g, S, EN); }
#endif
#if (MK_DUP & 524288)
                { pg8::EpiNull EN; pg8::gemm_phase<pg8::EpiNull, pg8::StaticOrder, true, true, 4>(F.lds + RING_OFF, g, S, EN); }
#endif
            }
            if (is_conv) CSEAM(pb + 0); else ASEAM(pb + 0);
        }
        if (IN(pb + 1)) {
            if (is_conv) {

#if !(MK_DIS & 16)
                for (int rep = 0; rep < NREP(16); ++rep) { FRESH(); phase_conv(F, args, args.in[9] + (size_t)j * 3 * DM, args.in[10] + (size_t)j * DM, Gb); }
#endif

            } else {

#if !(MK_DIS & 8)
                const int nunits = BATCH * NH * (SEQ / sba::UNIT_ROWS);
                unsigned* vmaxw = (unsigned*)(ws + WS_CTL) + CW_VMAX + 64 * j;
                for (int rep = 0; rep < NREP(8); ++rep) {
                    if (grp_mode) {
                        const int pm_ = F.vrow >> 2, j_ = F.vrow & 3; const float osc = pg8::o_scale_panels(vmaxw, pm_ - pm_ % (SEQ / 256), pm_);
                        for (int i = 0; i < NH / 4; ++i) sba::attn_unit(pm_ / (SEQ / sba::UNIT_ROWS), 4 * j_ + i, pm_ % (SEQ / sba::UNIT_ROWS), Qb, Kb, Vb, (signed char*)Ob, 1.0f / osc, (LAS char*)(F.lds + RING_OFF));
                    } else for (int u = F.vcu; u < nunits; u += F.G) { const int bh = u / (SEQ / sba::UNIT_ROWS), qb = u % (SEQ / sba::UNIT_ROWS);
                        const int pmu = (bh / NH) * (SEQ / 256) + qb; const float osc = pg8::o_scale_panels(vmaxw, pmu - qb, pmu); sba::attn_unit(bh / NH, bh % NH, qb, Qb, Kb, Vb, (signed char*)Ob, 1.0f / osc, (LAS char*)(F.lds + RING_OFF)); } }
#endif

            }
            GSEAM(pb + 1);
        }
        if (IN(pb + 2)) {
            pg8::Gemm g{Ob, (const bf16*)(wl + W_MIXOUT), M, DM, DM}; pg8::StaticOrder S; S.init(M, DM, F.G, (int)blockIdx.x);
#if !(MK_DIS & 32)
            if (is_conv) {
                pg8::EpiGateBf16<false> E{Yb, DM, nullptr, mt + 2 * DM, MODN, SEQ, 1.0f};
                for (int rep = 0; rep < NREP(32); ++rep) pg8::gemm_phase<pg8::EpiGateBf16<false>, pg8::StaticOrder, true, true>(F.lds + RING_OFF, g, S, E);
            } else {
                pg8::EpiI8GateBf16 E{Yb, DM, mt + 2 * DM, MODN, SEQ, (const float*)(wl + W_MIXOUT + W_MIXOUT_CS), (unsigned*)(ws + WS_CTL) + CW_VMAX + 64 * j};
                for (int rep = 0; rep < NREP(32); ++rep) pg8::gemm_phase<pg8::EpiI8GateBf16, pg8::StaticOrder, true, true, 0, 1, true>(F.lds + RING_OFF, g, S, E);
            }
            GSEAM(pb + 2);
#endif

        }
        if (IN(pb + 3)) {
#if !(MK_DIS & 64)
            for (int rep = 0; rep < NREP(64); ++rep) { const bool x_ = rep + 1 < NREP(64); FRESH(); phase_ln(F, args, Yb, args.in[4] + (size_t)(l * 2 + 0) * DM, args.in[5] + (size_t)(l * 2 + 0) * DM, mt + 3 * DM, mt + 4 * DM, true, x_ ? scr_off : 0, x_ ? hscr_off : 0, x_ ? qscr_off : 0, true); }
#endif
            GSEAM(pb + 3); }
        if (IN(pb + 4)) {
            pg8::Gemm g{Hb, (const bf16*)(wl + W_W1), M, FF, DM}; pg8::StaticOrder S; S.init(M, FF, F.G, (int)blockIdx.x);
            pg8::EpiI8Fp8Relu2 E{(unsigned char*)HIDb, FF, args.in[13] + (size_t)l * FF, (const float*)(ws + WS_ROWSH), (const float*)(wl + W_W1 + W_W1_CS), HID_SCALE};
#if !(MK_DIS & 128)
            for (int rep = 0; rep < NREP(128); ++rep) pg8::gemm_phase<pg8::EpiI8Fp8Relu2, pg8::StaticOrder, true, true, 0, 1, true>(F.lds + RING_OFF, g, S, E);
#endif

            GSEAM(pb + 4);
        }
        if (IN(pb + 5)) {
            pg8::Gemm g{HIDb, (const bf16*)(wl + W_W2), M, DM, FF}; pg8::StaticOrder S; S.init(M, DM, F.G, (int)blockIdx.x);
            pg8::EpiGateBf16<true, true> E{Yb, DM, args.in[15] + (size_t)l * DM, mt + 5 * DM, MODN, SEQ, 1.0f / (HID_SCALE * W2_SCALE)};
#if !(MK_DIS & 256)
#if (MK_DUP & 2048)
            { pg8::EpiNull EN; pg8::gemm_phase<pg8::EpiNull, pg8::StaticOrder, true, true, 0, 1>(F.lds + RING_OFF, g, S, EN); }
#endif
            for (int rep = 0; rep < NREP(256); ++rep) pg8::gemm_phase<pg8::EpiGateBf16<true, true>, pg8::StaticOrder, true, true, 0, 1>(F.lds + RING_OFF, g, S, E);
            GSEAM(pb + 5);
#endif

        }
        if (IN(pb + 6)) { const int nl = (l + 1 < DEPTH) ? l + 1 : l; const float* mtn = modtab + (size_t)nl * BATCH * MODN;

#if !(MK_DIS & 512)
            for (int rep = 0; rep < NREP(512); ++rep) { const bool x_ = rep + 1 < NREP(512); FRESH(); phase_ln(F, args, Yb, args.in[4] + (size_t)(l * 2 + 1) * DM, args.in[5] + (size_t)(l * 2 + 1) * DM, mtn + 0 * DM, mtn + 1 * DM, l + 1 < DEPTH, x_ ? scr_off : 0, x_ ? hscr_off : 0, x_ ? qscr_off : 0, ((l + 1) & 1) == 0); }
#endif
            GSEAM(pb + 6); }
    }
#undef IN
#undef SEAM
#undef GSEAM
#undef ASEAM
#undef CSEAM
}

extern "C" void kernel_launch(void* const* d_in, const int* in_sizes, int n_in, void* d_out, int out_size, void* d_ws, size_t ws_size, hipStream_t stream) {
    static int grid = 0;
    if (grid == 0) {
        if (n_in != 16 || in_sizes[0] != M * DM || out_size != M * DM || ws_size < WS_NEED + (MK_DUP ? 128 * MiB : 0)) { fprintf(stderr, "kernel_launch: unexpected shapes (n_in %d, in0 %d, out %d, ws %zu); nothing launched\n", n_in, n_in > 0 ? in_sizes[0] : -1, out_size, ws_size); grid = -1; return; }
        int dev = 0, cus = 0, per_cu = 0;
        if (hipGetDevice(&dev) != hipSuccess || hipDeviceGetAttribute(&cus, hipDeviceAttributeMultiprocessorCount, dev) != hipSuccess) { fprintf(stderr, "kernel_launch: device query failed\n"); grid = -1; return; }
        if (hipFuncSetAttribute((const void*)mk_fwd, hipFuncAttributeMaxDynamicSharedMemorySize, LDS_BYTES) != hipSuccess) { fprintf(stderr, "kernel_launch: hipFuncSetAttribute failed\n"); grid = -1; return; }
        if (hipOccupancyMaxActiveBlocksPerMultiprocessor(&per_cu, (const void*)mk_fwd, NWAVES * 64, LDS_BYTES) != hipSuccess || per_cu < 1) { fprintf(stderr, "kernel_launch: occupancy query reports %d workgroups per CU\n", per_cu); }
        (void)hipGetLastError();
        grid = cus;
        if (grid > 256) grid = 256;
        if (grid != 256 && grid != 128 && grid != 64) { fprintf(stderr, "kernel_launch: %d CUs: this kernel deals rows in M/grid blocks and needs 64, 128 or 256 workgroups; nothing launched\n", grid); grid = -1; return; }
    }
    if (grid < 0) return;
    if (hipMemsetAsync((char*)d_ws + WS_CTL, 0, CTL_ZERO_BYTES, stream) != hipSuccess) { fprintf(stderr, "kernel_launch: memset failed\n"); return; }
    Args a{};
    for (int i = 0; i < 16; ++i) a.in[i] = (const float*)d_in[i];
    a.out = (float*)d_out; a.ws = (unsigned char*)d_ws;
    a.ph_lo = 0; a.ph_hi = NPHASE;
    hipLaunchKernelGGL(mk_fwd, dim3(grid), dim3(NWAVES * 64), LDS_BYTES, stream, a);
    const hipError_t le = hipPeekAtLastError();
    if (le != hipSuccess) fprintf(stderr, "kernel_launch: launch failed: %s\n", hipGetErrorName(le));
}
```

```cpp
#include <hip/hip_runtime.h>
#include <hip/hip_bf16.h>
#include <cstdio>
#include <cstdint>
namespace pg8 {
#define PG8_LAS __attribute__((address_space(3)))
typedef unsigned short bf16_t;
typedef short bf16x8 __attribute__((ext_vector_type(8)));
typedef float f32x4 __attribute__((ext_vector_type(4)));
typedef unsigned u32x4 __attribute__((ext_vector_type(4)));
constexpr int BM = 256, BK = 64, HALF = 128, HTB = HALF * BK * 2  , STAGE_BYTES = 8 * HTB, NXCD = 8, WGM = 8;

__host__ __device__ __forceinline__ int lds_byte(int r, int c) { const int st = (r >> 4) * 2 + (c >> 5), rr = r & 15, cc = c & 31, ob = rr * 64 + cc * 2; return st * 1024 + (ob ^ (((ob >> 9) & 1) << 5)); }
__host__ __device__ __forceinline__ void stage_rc(int b, int& R, int& C) { const int st = b / 1024, sb = b % 1024, swz = sb ^ (((sb >> 9) & 1) << 5); R = (st >> 1) * 16 + swz / 64; C = (st & 1) * 32 + (swz % 64) / 2; }
__host__ __device__ __forceinline__ int perm32(int rho) { const int n = rho >> 4, i = rho & 15; return 8 * (i >> 2) + 4 * n + (i & 3); }

typedef float f32x16 __attribute__((ext_vector_type(16)));
__host__ __device__ __forceinline__ int lds_byte2(int r, int c) { const int rb = r >> 4, rr = r & 15, h = c >> 5, ch = (c & 31) >> 3; return (rb * 2 + h) * 1024 + rr * 64 + ((ch ^ ((rr >> 2) & 3)) << 4) + (c & 7) * 2; }
__host__ __device__ __forceinline__ void stage_rc2(int b, int& R, int& C) { const int p = b / 1024, l = (b % 1024) / 16, rr = l >> 2, cs = l & 3, ch = cs ^ ((rr >> 2) & 3); R = (p >> 1) * 16 + rr; C = (p & 1) * 32 + ch * 8; }
__host__ __device__ __forceinline__ int perm32b(int rho) { return (rho & 3) | (((rho >> 3) & 1) << 2) | (((rho >> 2) & 1) << 3) | (rho & 16); }

__host__ __device__ __forceinline__ int adj16_row(int bj, int R) { return 64 * (R >> 5) + 16 * ((R & 15) >> 2) + 8 * bj + 4 * ((R >> 4) & 1) + (R & 3); }
typedef int i32x8 __attribute__((ext_vector_type(8)));
typedef int i32x4 __attribute__((ext_vector_type(4)));
__device__ __forceinline__ i32x8 frag32(bf16x8 lo, bf16x8 hi) { const i32x4 a = __builtin_bit_cast(i32x4, lo), b = __builtin_bit_cast(i32x4, hi); return __builtin_shufflevector(a, b, 0, 1, 2, 3, 4, 5, 6, 7); }
__device__ __forceinline__ void mfma_fp8_tied(f32x4& acc, const i32x8 a, const i32x8 b, const int scl) {
    asm volatile("v_mfma_scale_f32_16x16x128_f8f6f4 %0, %1, %2, %0, %3, %3 op_sel_hi:[0,0,0]" : "+v"(acc) : "v"(a), "v"(b), "v"(scl));
}
struct Unit { int pm, pn; };
struct Gemm { const bf16_t* A; const bf16_t* Bt; int M, N, K; };

struct StaticOrder {
    int nM, nN, nwg, G, c;
    __host__ __device__ void init(int M, int N, int G_, int c_) { nM = M / BM; nN = N / BM; nwg = nM * nN; G = G_; c = c_; }
    __host__ __device__ bool next(int i, Unit& u) const {
        const long L = (long)i * G + c; if (L >= nwg) return false;
        int wgid = (int)L; { const int q = nwg / NXCD, r = nwg % NXCD, xcd = wgid % NXCD, off = wgid / NXCD; wgid = (xcd < r ? xcd * (q + 1) : r * (q + 1) + (xcd - r) * q) + off; }
        const int nig = WGM * nN, gid = wgid / nig, fm = gid * WGM, gsz = (nM - fm) < WGM ? (nM - fm) : WGM;
        u.pm = fm + ((wgid % nig) % gsz); u.pn = (wgid % nig) / gsz; return true;
    }
    __device__ __forceinline__ void a_ready(const Unit&) const {}
    __device__ __forceinline__ void done(const Unit&) const {}
};

__device__ __forceinline__ unsigned cvt_pk_bf16(float lo, float hi) { unsigned r; asm volatile("v_cvt_pk_bf16_f32 %0, %1, %2" : "=v"(r) : "v"(lo), "v"(hi)); return r; }
typedef float f32x2 __attribute__((ext_vector_type(2)));
#ifndef MK_WT
#define MK_WT 0
#endif
__device__ __forceinline__ void store16_wt(void* p, u32x4 v) {
#if MK_WT
    asm volatile("global_store_dwordx4 %0, %1, off sc1" :: "v"(p), "v"(v) : "memory");
#else
    *(u32x4*)p = v;
#endif
}

template <int ACT, bool HAS_BIAS> struct EpiBf16 {
    static constexpr bool PERM = true, AFTER_DRAIN = false; static constexpr int BPERM = 1; static_assert(ACT == 0 || ACT == 3, "EpiBf16: ACT is 0 (none) or 3 (squared relu)");
    int row_mask;
    bf16_t* O; int ldc; const float* bias; int split_cols; size_t split_stride;
    __device__ __forceinline__ void operator()(const f32x4 (&acc)[2][2][4][2], const Unit& u, int wr, int wc, int fr, int fq) const {
        const int row0 = (u.pm * BM + wr * 64 + fr) & row_mask; int colt = u.pn * BM; bf16_t* base = O;
        if (split_cols) { const int t = colt / split_cols; base += (size_t)t * split_stride; colt -= t * split_cols; }
        const int col0 = colt + wc * 32 + 8 * fq, bcol0 = u.pn * BM + wc * 32 + 8 * fq;
        f32x4 bv[2][2];
        if constexpr (HAS_BIAS) { int bcolv = bcol0; asm volatile("" : "+v"(bcolv));
#pragma unroll
            for (int bj = 0; bj < 2; ++bj)
#pragma unroll
                for (int n = 0; n < 2; ++n) bv[bj][n] = *(const f32x4*)(bias + bcolv + bj * HALF + 4 * n);
        }
#pragma unroll
        for (int ai = 0; ai < 2; ++ai)
#pragma unroll
            for (int m = 0; m < 4; ++m) { bf16_t* rowp = base + (size_t)(row0 + ai * HALF + m * 16) * ldc + col0;
#pragma unroll
                for (int bj = 0; bj < 2; ++bj) { f32x4 v0 = acc[ai][bj][m][0], v1 = acc[ai][bj][m][1];
                    if constexpr (HAS_BIAS) { v0 = v0 + bv[bj][0]; v1 = v1 + bv[bj][1]; }
                    if (ACT == 3) {
#pragma unroll
                        for (int j = 0; j < 4; ++j) { const float a = fmaxf(v0[j], 0.f), b = fmaxf(v1[j], 0.f); v0[j] = a * a; v1[j] = b * b; } }
                    u32x4 w; w.x = cvt_pk_bf16(v0[0], v0[1]); w.y = cvt_pk_bf16(v0[2], v0[3]); w.z = cvt_pk_bf16(v1[0], v1[1]); w.w = cvt_pk_bf16(v1[2], v1[3]);
                    store16_wt(rowp + bj * HALF, w); } }
    }
};
struct EpiResid {
    static constexpr bool PERM = false, AFTER_DRAIN = false; static constexpr int BPERM = 0;
    float* X; int ldc; const float* bias; const float* gate; int gate_bstride; int rows_per_batch; float alpha; long out_off;
    __device__ __forceinline__ void operator()(const f32x4 (&acc)[2][2][4][2], const Unit& u, int wr, int wc, int fr, int fq) const {
        const int row0 = u.pm * BM + wr * 64 + fr, col0 = u.pn * BM + wc * 32 + 4 * fq;
        const float* gp = gate + (size_t)((u.pm * BM) / rows_per_batch) * gate_bstride;
        f32x4 bv[2][2], gv[2][2];
#pragma unroll
        for (int bj = 0; bj < 2; ++bj)
#pragma unroll
            for (int n = 0; n < 2; ++n) { bv[bj][n] = bias ? *(const f32x4*)(bias + col0 + bj * HALF + n * 16) : (f32x4){0.f, 0.f, 0.f, 0.f}; gv[bj][n] = *(const f32x4*)(gp + col0 + bj * HALF + n * 16); }
#pragma unroll
        for (int ai = 0; ai < 2; ++ai)
#pragma unroll
            for (int m = 0; m < 4; ++m) { float* rowp = X + (size_t)(row0 + ai * HALF + m * 16) * ldc + col0;
#pragma unroll
                for (int bj = 0; bj < 2; ++bj)
#pragma unroll
                    for (int n = 0; n < 2; ++n) { const f32x4 xo = *(const f32x4*)(rowp + bj * HALF + n * 16); *(f32x4*)(rowp + out_off + bj * HALF + n * 16) = xo * alpha + gv[bj][n] * (acc[ai][bj][m][n] + bv[bj][n]); }
                if (m & 1) asm volatile("" ::: "memory"); }
    }
};


template <bool HAS_BIAS, bool SCALED = false> struct EpiGateBf16 {
    static constexpr bool PERM = true, AFTER_DRAIN = false; static constexpr int BPERM = 1;
    bf16_t* O; int ldc; const float* bias; const float* gate; int gate_bstride; int rows_per_batch; float ascale;
    __device__ __forceinline__ void operator()(const f32x4 (&acc)[2][2][4][2], const Unit& u, int wr, int wc, int fr, int fq) const {
        const int row0 = u.pm * BM + wr * 64 + fr, col0 = u.pn * BM + wc * 32 + 8 * fq;
        const float* gp = gate + (size_t)((u.pm * BM) / rows_per_batch) * gate_bstride;
        int colv = col0; asm volatile("" : "+v"(colv));
        f32x4 bv[2][2], gv[2][2];
#pragma unroll
        for (int bj = 0; bj < 2; ++bj)
#pragma unroll
            for (int n = 0; n < 2; ++n) { if constexpr (HAS_BIAS) bv[bj][n] = *(const f32x4*)(bias + colv + bj * HALF + 4 * n); gv[bj][n] = *(const f32x4*)(gp + colv + bj * HALF + 4 * n); }
#pragma unroll
        for (int ai = 0; ai < 2; ++ai)
#pragma unroll
            for (int m = 0; m < 4; ++m) { bf16_t* rowp = O + (size_t)(row0 + ai * HALF + m * 16) * ldc + col0;
#pragma unroll
                for (int bj = 0; bj < 2; ++bj) { f32x4 v0 = acc[ai][bj][m][0], v1 = acc[ai][bj][m][1]; if constexpr (SCALED) { v0 = v0 * ascale; v1 = v1 * ascale; } if constexpr (HAS_BIAS) { v0 = v0 + bv[bj][0]; v1 = v1 + bv[bj][1]; } v0 = v0 * gv[bj][0]; v1 = v1 * gv[bj][1];
                    u32x4 w; w.x = cvt_pk_bf16(v0[0], v0[1]); w.y = cvt_pk_bf16(v0[2], v0[3]); w.z = cvt_pk_bf16(v1[0], v1[1]); w.w = cvt_pk_bf16(v1[2], v1[3]);
                    store16_wt(rowp + bj * HALF, w); } }
    }
};

struct EpiConvIn {
    static constexpr bool PERM = true, AFTER_DRAIN = false; static constexpr int BPERM = 1;
    bf16_t* Gt; bf16_t* Bg; int ldc; int CT;
    __device__ __forceinline__ void operator()(const f32x4 (&acc)[2][2][4][2], const Unit& u, int wr, int wc, int fr, int fq) const {
        const int row0 = u.pm * BM + wr * 64 + fr;
        if (u.pn < CT) {
            const int col0 = u.pn * HALF + wc * 32 + 8 * fq;
#pragma unroll
            for (int ai = 0; ai < 2; ++ai)
#pragma unroll
                for (int m = 0; m < 4; ++m) { const f32x4 v0 = acc[ai][0][m][0] * acc[ai][1][m][0], v1 = acc[ai][0][m][1] * acc[ai][1][m][1];
                    u32x4 w; w.x = cvt_pk_bf16(v0[0], v0[1]); w.y = cvt_pk_bf16(v0[2], v0[3]); w.z = cvt_pk_bf16(v1[0], v1[1]); w.w = cvt_pk_bf16(v1[2], v1[3]);
                    store16_wt(Gt + (size_t)(row0 + ai * HALF + m * 16) * ldc + col0, w); }
        } else {
            const int col0 = (u.pn - CT) * BM + wc * 32 + 8 * fq;
#pragma unroll
            for (int ai = 0; ai < 2; ++ai)
#pragma unroll
                for (int m = 0; m < 4; ++m) { bf16_t* rowp = Bg + (size_t)(row0 + ai * HALF + m * 16) * ldc + col0;
#pragma unroll
                    for (int bj = 0; bj < 2; ++bj) { const f32x4 v0 = acc[ai][bj][m][0], v1 = acc[ai][bj][m][1];
                        u32x4 w; w.x = cvt_pk_bf16(v0[0], v0[1]); w.y = cvt_pk_bf16(v0[2], v0[3]); w.z = cvt_pk_bf16(v1[0], v1[1]); w.w = cvt_pk_bf16(v1[2], v1[3]);
                        store16_wt(rowp + bj * HALF, w); } }
        }
    }
};

struct EpiFp8Relu2 {
    static constexpr bool PERM = true, AFTER_DRAIN = false; static constexpr int BPERM = 2;
    unsigned char* O8; int ldc; const float* bias; float oscale;
    __device__ __forceinline__ void operator()(const f32x4 (&acc)[2][2][4][2], const Unit& u, int wr, int wc, int fr, int fq) const {
        const int row0 = u.pm * BM + wr * 64 + fr, col0 = u.pn * BM + wc * 64 + 16 * fq;
        int colv = col0; asm volatile("" : "+v"(colv));
        f32x4 bv[2][2];
#pragma unroll
        for (int bj = 0; bj < 2; ++bj)
#pragma unroll
            for (int n = 0; n < 2; ++n) bv[bj][n] = *(const f32x4*)(bias + colv + 8 * bj + 4 * n);
#pragma unroll
        for (int ai = 0; ai < 2; ++ai)
#pragma unroll
            for (int m = 0; m < 4; ++m) { u32x4 w;
#pragma unroll
                for (int bj = 0; bj < 2; ++bj)
#pragma unroll
                    for (int n = 0; n < 2; ++n) { f32x4 v = acc[ai][bj][m][n] + bv[bj][n];
#pragma unroll
                        for (int j = 0; j < 4; ++j) { const float a = fmaxf(v[j], 0.f); v[j] = fminf(a * a * oscale, 448.0f); }
                        int p = 0; p = __builtin_amdgcn_cvt_pk_fp8_f32(v[0], v[1], p, false); p = __builtin_amdgcn_cvt_pk_fp8_f32(v[2], v[3], p, true); w[2 * bj + n] = (unsigned)p; }
                *(u32x4*)(O8 + (size_t)(row0 + ai * HALF + m * 16) * ldc + col0) = w; }
    }
};

struct EpiI8Fp8Relu2 {
    static constexpr bool PERM = true, AFTER_DRAIN = false; static constexpr int BPERM = 2;
    unsigned char* O8; int ldc; const float* bias; const float* rowscale; const float* colscale; float oscale;
    __device__ __forceinline__ void operator()(const f32x4 (&acc)[2][2][4][2], const Unit& u, int wr, int wc, int fr, int fq) const {
        const int row0 = u.pm * BM + wr * 64 + fr, col0 = u.pn * BM + wc * 64 + 16 * fq;
        int colv = col0; asm volatile("" : "+v"(colv));
        const float sq = sqrtf(oscale);
        f32x4 bv[2][2], cv[2][2];
#pragma unroll
        for (int bj = 0; bj < 2; ++bj)
#pragma unroll
            for (int n = 0; n < 2; ++n) { bv[bj][n] = *(const f32x4*)(bias + colv + 8 * bj + 4 * n); cv[bj][n] = *(const f32x4*)(colscale + colv + 8 * bj + 4 * n); }
        float rsv[2][4];
#pragma unroll
        for (int ai = 0; ai < 2; ++ai)
#pragma unroll
            for (int m = 0; m < 4; ++m) rsv[ai][m] = rowscale[row0 + ai * HALF + m * 16];
        __builtin_amdgcn_sched_barrier(0);
#pragma unroll
        for (int bj = 0; bj < 2; ++bj)
#pragma unroll
            for (int n = 0; n < 2; ++n) { bv[bj][n] = bv[bj][n] * sq; cv[bj][n] = cv[bj][n] * sq; }
#pragma unroll
        for (int ai = 0; ai < 2; ++ai)
#pragma unroll
            for (int m = 0; m < 4; ++m) { const int row = row0 + ai * HALF + m * 16; const float rs = rsv[ai][m]; u32x4 w;
#pragma unroll
                for (int bj = 0; bj < 2; ++bj)
#pragma unroll
                    for (int n = 0; n < 2; ++n) { const i32x4 ia = __builtin_bit_cast(i32x4, acc[ai][bj][m][n]); const f32x4 rc = cv[bj][n] * rs;
                        f32x4 a = __builtin_elementwise_fma(__builtin_convertvector(ia, f32x4), rc, bv[bj][n]);
#pragma unroll
                        for (int j = 0; j < 4; ++j) a[j] = __builtin_amdgcn_fmed3f(a[j], 0.f, 21.166010f);
                        const f32x4 v = a * a;
                        int p = 0; p = __builtin_amdgcn_cvt_pk_fp8_f32(v[0], v[1], p, false); p = __builtin_amdgcn_cvt_pk_fp8_f32(v[2], v[3], p, true); w[2 * bj + n] = (unsigned)p; }
                *(u32x4*)(O8 + (size_t)row * ldc + col0) = w; }
    }
};

struct EpiI8Bf16Split {
    static constexpr bool PERM = true, AFTER_DRAIN = false; static constexpr int BPERM = 1;
    bf16_t* O; int ldc; const float* rowscale; const float* colscale; int split_cols; bf16_t* O1; bf16_t* O2; unsigned* vmax;
    __device__ __forceinline__ void operator()(const f32x4 (&acc)[2][2][4][2], const Unit& u, int wr, int wc, int fr, int fq) const {
        const int row0 = u.pm * BM + wr * 64 + fr; int colt = u.pn * BM; bf16_t* base = O;
        const int t = colt / split_cols; base = (t == 0) ? O : (t == 1) ? O1 : O2; colt -= t * split_cols; f32x4 vm4 = {0.f, 0.f, 0.f, 0.f};
        const int col0 = colt + wc * 32 + 8 * fq; int ccol = u.pn * BM + wc * 32 + 8 * fq; asm volatile("" : "+v"(ccol));
        f32x4 cv[2][2];
#pragma unroll
        for (int bj = 0; bj < 2; ++bj)
#pragma unroll
            for (int n = 0; n < 2; ++n) cv[bj][n] = *(const f32x4*)(colscale + ccol + bj * HALF + 4 * n);
        float rsv[2][4];
#pragma unroll
        for (int ai = 0; ai < 2; ++ai)
#pragma unroll
            for (int m = 0; m < 4; ++m) rsv[ai][m] = rowscale[row0 + ai * HALF + m * 16];
        __builtin_amdgcn_sched_barrier(0);
#pragma unroll
        for (int ai = 0; ai < 2; ++ai)
#pragma unroll
            for (int m = 0; m < 4; ++m) { const int row = row0 + ai * HALF + m * 16; const float rs = rsv[ai][m]; const size_t rowo = (size_t)row * ldc + col0;
#pragma unroll
                for (int bj = 0; bj < 2; ++bj) { const i32x4 i0 = __builtin_bit_cast(i32x4, acc[ai][bj][m][0]), i1 = __builtin_bit_cast(i32x4, acc[ai][bj][m][1]);
                    const f32x4 v0 = __builtin_convertvector(i0, f32x4) * (cv[bj][0] * rs), v1 = __builtin_convertvector(i1, f32x4) * (cv[bj][1] * rs);
                    if (t == 2) {
#pragma unroll
                        for (int j = 0; j < 4; ++j) vm4[j] = fmaxf(vm4[j], fmaxf(fabsf(v0[j]), fabsf(v1[j]))); }
                    u32x4 w; w.x = cvt_pk_bf16(v0[0], v0[1]); w.y = cvt_pk_bf16(v0[2], v0[3]); w.z = cvt_pk_bf16(v1[0], v1[1]); w.w = cvt_pk_bf16(v1[2], v1[3]);
                    *(u32x4*)(base + rowo + bj * HALF) = w; } }
        if (t == 2) { float vm = fmaxf(fmaxf(vm4[0], vm4[1]), fmaxf(vm4[2], vm4[3]));
#pragma unroll
            for (int o = 1; o < 64; o <<= 1) vm = fmaxf(vm, __shfl_xor(vm, o));
            if ((fr | fq) == 0) __hip_atomic_fetch_max(vmax + u.pm, __float_as_uint(vm), __ATOMIC_RELAXED, __HIP_MEMORY_SCOPE_AGENT); }
    }
};

__device__ __forceinline__ float o_scale_panels(unsigned* w, int first, int pm) {
    float t[16];
#pragma unroll
    for (int i = 0; i < 16; ++i) t[i] = __uint_as_float(__hip_atomic_load(w + first + i, __ATOMIC_RELAXED, __HIP_MEMORY_SCOPE_AGENT));
    float vm = 0.f;
#pragma unroll
    for (int i = 0; i < 16; ++i) vm = fmaxf(vm, (first + i <= pm) ? t[i] : 0.f);
    return vm > 0.f ? vm * (1.01f / 127.0f) : 1.0f;
}
struct EpiI8GateBf16 {
    static constexpr bool PERM = true, AFTER_DRAIN = false; static constexpr int BPERM = 1;
    bf16_t* O; int ldc; const float* gate; int gate_bstride; int rows_per_batch; const float* colscale; unsigned* vmax;
    __device__ __forceinline__ void operator()(const f32x4 (&acc)[2][2][4][2], const Unit& u, int wr, int wc, int fr, int fq) const {
        const int row0 = u.pm * BM + wr * 64 + fr, col0 = u.pn * BM + wc * 32 + 8 * fq;
        const float* gp = gate + (size_t)((u.pm * BM) / rows_per_batch) * gate_bstride;
        const float rs = o_scale_panels(vmax, u.pm - u.pm % (rows_per_batch / BM), u.pm);
        int colv = col0; asm volatile("" : "+v"(colv));
        f32x4 gv[2][2];
#pragma unroll
        for (int bj = 0; bj < 2; ++bj)
#pragma unroll
            for (int n = 0; n < 2; ++n) gv[bj][n] = *(const f32x4*)(gp + colv + bj * HALF + 4 * n) * *(const f32x4*)(colscale + colv + bj * HALF + 4 * n) * rs;
#pragma unroll
        for (int ai = 0; ai < 2; ++ai)
#pragma unroll
            for (int m = 0; m < 4; ++m) { bf16_t* rowp = O + (size_t)(row0 + ai * HALF + m * 16) * ldc + col0;
#pragma unroll
                for (int bj = 0; bj < 2; ++bj) { const i32x4 i0 = __builtin_bit_cast(i32x4, acc[ai][bj][m][0]), i1 = __builtin_bit_cast(i32x4, acc[ai][bj][m][1]);
                    const f32x4 v0 = __builtin_convertvector(i0, f32x4) * gv[bj][0], v1 = __builtin_convertvector(i1, f32x4) * gv[bj][1];
                    u32x4 w; w.x = cvt_pk_bf16(v0[0], v0[1]); w.y = cvt_pk_bf16(v0[2], v0[3]); w.z = cvt_pk_bf16(v1[0], v1[1]); w.w = cvt_pk_bf16(v1[2], v1[3]);
                    *(u32x4*)(rowp + bj * HALF) = w; } }
    }
};

struct EpiNull { static constexpr bool PERM = false, AFTER_DRAIN = false; static constexpr int BPERM = 0;
    __device__ __forceinline__ void operator()(const f32x4 (&acc)[2][2][4][2], const Unit& u, int wr, int wc, int fr, int fq) const {
#pragma unroll
        for (int ai = 0; ai < 2; ++ai)
#pragma unroll
            for (int m = 0; m < 4; ++m) asm volatile("" :: "v"(acc[ai][0][m][0]), "v"(acc[ai][0][m][1]), "v"(acc[ai][1][m][0]), "v"(acc[ai][1][m][1])); }
};

struct FixedOrder { int n;
    __device__ __forceinline__ bool next(int i, Unit& u) const { if (i >= n) return false; u.pm = 0; u.pn = 0; return true; }
    __device__ __forceinline__ void a_ready(const Unit&) const {}
    __device__ __forceinline__ void done(const Unit&) const {}
};
template <class Epi, class Sched, bool ALIGN_EPI = false, bool SP2 = false, int SKEL = 0, int ES = 2  , bool I8 = false    >
__device__ __forceinline__ void gemm_phase(PG8_LAS unsigned char* lds, const Gemm g, const Sched& S, const Epi& E) {
    typedef double f64x2v __attribute__((ext_vector_type(2)));
    int tid_ = threadIdx.x; asm volatile("" : "+v"(tid_));
    const int tid = tid_, wid = __builtin_amdgcn_readfirstlane(tid >> 6), lane = tid & 63, wr = wid >> 2, wc = wid & 3, fr = lane & 15, fq = lane >> 4;
    const int K = g.K, KB = K * ES  , nt = KB / (BK * 2);
    unsigned voffA[2], voffB[2], voffB1[2];
#pragma unroll
    for (int i = 0; i < 2; ++i) { int R, C; stage_rc(tid * 16 + i * 8192, R, C);
        voffA[i] = (unsigned)(R * KB + C * 2);
        if constexpr (Epi::BPERM == 2) { voffB[i] = (unsigned)(adj16_row(0, R) * KB + C * 2); voffB1[i] = (unsigned)(adj16_row(1, R) * KB + C * 2); }
        else { const int Rb = Epi::PERM ? ((R & ~31) + perm32(R & 31)) : R; voffB[i] = (unsigned)(Rb * KB + C * 2); voffB1[i] = voffB[i]; } }
    const unsigned bh1 = (Epi::BPERM == 2) ? 0u : (unsigned)HALF * (unsigned)KB;
    const unsigned kstep = (unsigned)(BK * 2);
    const unsigned hstep = (unsigned)HALF * (unsigned)KB;
    const unsigned tstep = 2u * hstep;
    const unsigned ldsw = (unsigned)wid * 1024u;
    const int aoff = lds_byte(wr * 64 + fr, fq * 8), boff = lds_byte(wc * 32 + fr, fq * 8);
#define PG8_SA(b, h) (((b) * 2 + (h)) * HTB)
#define PG8_SB(b, h) ((4 + (b) * 2 + (h)) * HTB)
#define PG8_STAGE_R(rsrc, bufoff, soff, voff) do { if constexpr (SKEL != 2 && SKEL != 3) { _Pragma("unroll") for (int _i = 0; _i < 2; ++_i) \
        __builtin_amdgcn_raw_ptr_buffer_load_lds(rsrc, (PG8_LAS void*)(lds + (bufoff) + ldsw + _i * 8192), 16, (int)(voff)[_i], (int)(soff), 0, 0); } } while (0)
#define PG8_LDA(dst, b, h) do { if constexpr (SKEL != 2 && SKEL != 4) { _Pragma("unroll") for (int m = 0; m < 4; ++m) _Pragma("unroll") for (int k = 0; k < 2; ++k) dst[m][k] = *(const PG8_LAS bf16x8*)(lds + PG8_SA(b, h) + aoff + m * 2048 + k * 1024); } } while (0)
#define PG8_LDB(dst, b, h) do { if constexpr (SKEL != 2 && SKEL != 4) { _Pragma("unroll") for (int n = 0; n < 2; ++n) _Pragma("unroll") for (int k = 0; k < 2; ++k) dst[n][k] = *(const PG8_LAS bf16x8*)(lds + PG8_SB(b, h) + boff + n * 2048 + k * 1024); } } while (0)
#define PG8_MMA(ai, bj, At, Bt) do { __builtin_amdgcn_s_setprio(1); if constexpr (ES == 2) { _Pragma("unroll") for (int m = 0; m < 4; ++m) _Pragma("unroll") for (int n = 0; n < 2; ++n) _Pragma("unroll") for (int k = 0; k < 2; ++k) \
        { if constexpr (SKEL != 1) acc[ai][bj][m][n] = __builtin_amdgcn_mfma_f32_16x16x32_bf16(Bt[n][k], At[m][k], acc[ai][bj][m][n], 0, 0, 0); else asm volatile("" :: "v"(Bt[n][k]), "v"(At[m][k])); } } \
      else if constexpr (I8) { _Pragma("unroll") for (int m = 0; m < 4; ++m) _Pragma("unroll") for (int n = 0; n < 2; ++n) _Pragma("unroll") for (int k = 0; k < 2; ++k) \
        acc[ai][bj][m][n] = __builtin_bit_cast(f32x4, __builtin_amdgcn_mfma_i32_16x16x64_i8(__builtin_bit_cast(i32x4, Bt[n][k]), __builtin_bit_cast(i32x4, At[m][k]), __builtin_bit_cast(i32x4, acc[ai][bj][m][n]), 0, 0, 0)); } \
      else { _Pragma("unroll") for (int m = 0; m < 4; ++m) _Pragma("unroll") for (int n = 0; n < 2; ++n) \
        mfma_fp8_tied(acc[ai][bj][m][n], frag32(Bt[n][0], Bt[n][1]), frag32(At[m][0], At[m][1]), scl1); } \
      __builtin_amdgcn_s_setprio(0); } while (0)
#define PG8_WAIT_V(n) asm volatile("s_waitcnt vmcnt(" #n ")" ::: "memory")
#define PG8_WAIT_L(n) asm volatile("s_waitcnt lgkmcnt(" #n ")" ::: "memory")
#define PG8_BAR __builtin_amdgcn_s_barrier()
#define PG8_SCHED __builtin_amdgcn_sched_barrier(0)
    int scl1 = 0x7F7F7F7F; if constexpr (ES == 1 && !I8) asm volatile("" : "+v"(scl1));
    Unit cur, nxt; int ui = 0;
    if (!S.next(0, cur)) return;
    f32x4 acc[2][2][4][2];
#pragma unroll
    for (int a = 0; a < 2; ++a)
#pragma unroll
        for (int b = 0; b < 2; ++b)
#pragma unroll
            for (int m = 0; m < 4; ++m)
#pragma unroll
                for (int n = 0; n < 2; ++n) acc[a][b][m][n] = (f32x4){0.f, 0.f, 0.f, 0.f};
    bf16x8 At[4][2], B0[2][2], B1[2][2];
    if constexpr (SKEL == 2 || SKEL == 4) {
#pragma unroll
        for (int m = 0; m < 4; ++m)
#pragma unroll
            for (int k = 0; k < 2; ++k) asm volatile("" : "=v"(At[m][k]));
#pragma unroll
        for (int n = 0; n < 2; ++n)
#pragma unroll
            for (int k = 0; k < 2; ++k) { asm volatile("" : "=v"(B0[n][k])); asm volatile("" : "=v"(B1[n][k])); } }
    unsigned cA = (unsigned)cur.pm * tstep, cB = (unsigned)cur.pn * tstep;
    const __amdgpu_buffer_rsrc_t rsA = __builtin_amdgcn_make_buffer_rsrc((void*)g.A, 0, (int)((unsigned)g.M * (unsigned)KB), 0x00020000), rsB = __builtin_amdgcn_make_buffer_rsrc((void*)g.Bt, 0, (int)((unsigned)g.N * (unsigned)KB), 0x00020000);
    __builtin_amdgcn_s_waitcnt(0x0F70);
    S.a_ready(cur);
    if constexpr (SP2) {
        PG8_STAGE_R(rsB, PG8_SB(0, 0), cB, voffB); PG8_STAGE_R(rsB, PG8_SB(0, 1), cB + bh1, voffB1); PG8_STAGE_R(rsA, PG8_SA(0, 0), cA, voffA); PG8_STAGE_R(rsA, PG8_SA(0, 1), cA + hstep, voffA);
        if (wr == 1) PG8_BAR;
        PG8_WAIT_V(2); PG8_BAR;
        PG8_STAGE_R(rsB, PG8_SB(1, 0), cB + kstep, voffB); PG8_STAGE_R(rsA, PG8_SA(1, 0), cA + kstep, voffA); PG8_STAGE_R(rsB, PG8_SB(1, 1), cB + bh1 + kstep, voffB1);
        PG8_WAIT_V(6); PG8_BAR;
    } else {
        PG8_STAGE_R(rsB, PG8_SB(0, 0), cB, voffB); PG8_STAGE_R(rsA, PG8_SA(0, 0), cA, voffA); PG8_STAGE_R(rsB, PG8_SB(0, 1), cB + bh1, voffB1); PG8_STAGE_R(rsA, PG8_SA(0, 1), cA + hstep, voffA);
        if (wr == 1) PG8_BAR;
        PG8_WAIT_V(4); PG8_BAR;
        PG8_STAGE_R(rsB, PG8_SB(1, 0), cB + kstep, voffB); PG8_STAGE_R(rsA, PG8_SA(1, 0), cA + kstep, voffA); PG8_STAGE_R(rsB, PG8_SB(1, 1), cB + bh1 + kstep, voffB1);
        PG8_WAIT_V(6); PG8_BAR;
    }
    for (;;) {
        const bool has_next = S.next(ui + 1, nxt);
        const unsigned nA = has_next ? (unsigned)nxt.pm * tstep : cA, nB = has_next ? (unsigned)nxt.pn * tstep : cB;
        for (int t = 0; t < nt; t += 2) {
            const bool last = (t == nt - 2);
            const unsigned a1 = cA + (unsigned)(t + 1) * kstep;
            const unsigned a2 = last ? nA : cA + (unsigned)(t + 2) * kstep, b2 = last ? nB : cB + (unsigned)(t + 2) * kstep;
            const unsigned a3 = a2 + kstep, b3 = b2 + kstep;
            if (last && has_next) S.a_ready(nxt);
            if constexpr (SP2) {
            PG8_LDB(B0, 0, 0); PG8_LDB(B1, 0, 1); PG8_SCHED; PG8_LDA(At, 0, 0); PG8_STAGE_R(rsA, PG8_SA(1, 1), a1 + hstep, voffA);
            PG8_WAIT_V(8); PG8_WAIT_L(0); PG8_BAR; PG8_MMA(0, 0, At, B0); PG8_MMA(0, 1, At, B1); PG8_BAR; PG8_SCHED;
            PG8_LDA(At, 0, 1); PG8_STAGE_R(rsB, PG8_SB(0, 0), b2, voffB); PG8_STAGE_R(rsB, PG8_SB(0, 1), b2 + bh1, voffB1); PG8_STAGE_R(rsA, PG8_SA(0, 0), a2, voffA);
            PG8_WAIT_V(8); PG8_WAIT_L(0); PG8_BAR; PG8_MMA(1, 0, At, B0); PG8_MMA(1, 1, At, B1); PG8_BAR; PG8_SCHED;
            PG8_LDB(B0, 1, 0); PG8_LDB(B1, 1, 1); PG8_SCHED; PG8_LDA(At, 1, 0); PG8_STAGE_R(rsA, PG8_SA(0, 1), a2 + hstep, voffA);
            PG8_WAIT_V(8); PG8_WAIT_L(0); PG8_BAR; PG8_MMA(0, 0, At, B0); PG8_MMA(0, 1, At, B1); PG8_BAR; PG8_SCHED;
            PG8_LDA(At, 1, 1); PG8_STAGE_R(rsB, PG8_SB(1, 0), b3, voffB); PG8_STAGE_R(rsB, PG8_SB(1, 1), b3 + bh1, voffB1); PG8_STAGE_R(rsA, PG8_SA(1, 0), a3, voffA);
            PG8_WAIT_V(8); PG8_WAIT_L(0); PG8_BAR; PG8_MMA(1, 0, At, B0); PG8_MMA(1, 1, At, B1); PG8_BAR; PG8_SCHED;
            } else {
            PG8_LDB(B0, 0, 0); PG8_SCHED; PG8_LDA(At, 0, 0); PG8_STAGE_R(rsA, PG8_SA(1, 1), a1 + hstep, voffA);
            PG8_WAIT_L(8); PG8_BAR; PG8_WAIT_L(0); PG8_MMA(0, 0, At, B0); PG8_BAR; PG8_SCHED;
            PG8_LDB(B1, 0, 1); PG8_STAGE_R(rsB, PG8_SB(0, 0), b2, voffB);
            PG8_BAR; PG8_WAIT_L(0); PG8_MMA(0, 1, At, B1); PG8_BAR;
            PG8_LDA(At, 0, 1); PG8_STAGE_R(rsA, PG8_SA(0, 0), a2, voffA);
            PG8_BAR; PG8_WAIT_L(0); PG8_MMA(1, 0, At, B0); PG8_BAR; PG8_SCHED;
            PG8_STAGE_R(rsB, PG8_SB(0, 1), b2 + bh1, voffB1);
            PG8_WAIT_V(6); PG8_BAR; PG8_MMA(1, 1, At, B1); PG8_BAR;
            PG8_LDB(B0, 1, 0); PG8_SCHED; PG8_LDA(At, 1, 0); PG8_STAGE_R(rsA, PG8_SA(0, 1), a2 + hstep, voffA);
            PG8_WAIT_L(8); PG8_BAR; PG8_WAIT_L(0); PG8_MMA(0, 0, At, B0); PG8_BAR; PG8_SCHED;
            PG8_LDB(B1, 1, 1); PG8_STAGE_R(rsB, PG8_SB(1, 0), b3, voffB);
            PG8_BAR; PG8_WAIT_L(0); PG8_MMA(0, 1, At, B1); PG8_BAR;
            PG8_LDA(At, 1, 1); PG8_STAGE_R(rsA, PG8_SA(1, 0), a3, voffA);
            PG8_BAR; PG8_WAIT_L(0); PG8_MMA(1, 0, At, B0); PG8_BAR; PG8_SCHED;
            PG8_STAGE_R(rsB, PG8_SB(1, 1), b3 + bh1, voffB1);
            PG8_WAIT_V(6); PG8_BAR; PG8_MMA(1, 1, At, B1); PG8_BAR;
            }
        }
        if constexpr (ALIGN_EPI) { if (wr == 0) PG8_BAR; }
        if constexpr (ES == 1 && !I8) asm volatile("s_nop 15\n\ts_nop 15" ::: "memory");
        if constexpr (!Epi::AFTER_DRAIN) { E(acc, cur, wr, wc, fr, fq); S.done(cur); }
        if (!has_next) break;
#pragma unroll
        for (int a = 0; a < 2; ++a)
#pragma unroll
            for (int b = 0; b < 2; ++b)
#pragma unroll
                for (int m = 0; m < 4; ++m)
#pragma unroll
                    for (int n = 0; n < 2; ++n) { double z0, z1; asm volatile("v_mov_b64 %0, 0\n\tv_mov_b64 %1, 0" : "=v"(z0), "=v"(z1)); const f64x2v zz = {z0, z1}; acc[a][b][m][n] = __builtin_bit_cast(f32x4, zz); }
        cur = nxt; cA = nA; cB = nB; ++ui;
        if constexpr (ALIGN_EPI) { if (wr == 1) PG8_BAR; }
    }
    PG8_WAIT_V(0);
    if constexpr (!ALIGN_EPI) { if (wr == 0) PG8_BAR; }
    PG8_BAR;
    if constexpr (Epi::AFTER_DRAIN) { E.fused(acc, cur, wr, wc, fr, fq, lds, wid, lane); S.done(cur); }
#undef PG8_SA
#undef PG8_SB
#undef PG8_STAGE_R
#undef PG8_LDA
#undef PG8_LDB
#undef PG8_MMA
#undef PG8_WAIT_V
#undef PG8_WAIT_L
#undef PG8_BAR
#undef PG8_SCHED
}


template <int ACT, bool HAS_BIAS> struct Epi32Bf16 {
    static constexpr bool PERM = true, AFTER_DRAIN = false; static_assert(ACT == 0 || ACT == 3, "Epi32Bf16: ACT is 0 (none) or 3 (squared relu)");
    bf16_t* O; int ldc; const float* bias; int split_cols; size_t split_stride;
    __device__ __forceinline__ void operator()(const f32x16 (&acc)[2][2][2], const Unit& u, int wr, int wc, int r32, int hi) const {
        const int row0 = u.pm * BM + wr * 64 + r32; int colt = u.pn * BM; bf16_t* base = O;
        if (split_cols) { const int t = colt / split_cols; base += (size_t)t * split_stride; colt -= t * split_cols; }
        const int col0 = colt + wc * 32 + 8 * hi, bcol0 = u.pn * BM + wc * 32 + 8 * hi;
        f32x4 bv[2][4];
        if constexpr (HAS_BIAS) {
#pragma unroll
            for (int bj = 0; bj < 2; ++bj)
#pragma unroll
                for (int q = 0; q < 4; ++q) bv[bj][q] = *(const f32x4*)(bias + bcol0 + bj * HALF + (q >> 1) * 16 + (q & 1) * 4);
        }
#pragma unroll
        for (int ai = 0; ai < 2; ++ai)
#pragma unroll
            for (int mb = 0; mb < 2; ++mb) { bf16_t* rowp = base + (size_t)(row0 + ai * HALF + mb * 32) * ldc + col0;
#pragma unroll
                for (int bj = 0; bj < 2; ++bj)
#pragma unroll
                    for (int t = 0; t < 2; ++t) { float v[8];
#pragma unroll
                        for (int j = 0; j < 8; ++j) { v[j] = acc[ai][bj][mb][8 * t + j]; if constexpr (HAS_BIAS) v[j] += bv[bj][2 * t + (j >> 2)][j & 3]; if (ACT == 3) { const float a = fmaxf(v[j], 0.f); v[j] = a * a; } }
                        u32x4 w; w.x = cvt_pk_bf16(v[0], v[1]); w.y = cvt_pk_bf16(v[2], v[3]); w.z = cvt_pk_bf16(v[4], v[5]); w.w = cvt_pk_bf16(v[6], v[7]);
                        store16_wt(rowp + bj * HALF + 16 * t, w); } }
    }
};
template <bool HAS_BIAS> struct Epi32GateBf16 {
    static constexpr bool PERM = true, AFTER_DRAIN = false;
    bf16_t* O; int ldc; const float* bias; const float* gate; int gate_bstride; int rows_per_batch;
    __device__ __forceinline__ void operator()(const f32x16 (&acc)[2][2][2], const Unit& u, int wr, int wc, int r32, int hi) const {
        const int row0 = u.pm * BM + wr * 64 + r32, col0 = u.pn * BM + wc * 32 + 8 * hi;
        const float* gp = gate + (size_t)((u.pm * BM) / rows_per_batch) * gate_bstride;
        f32x4 bv[2][4], gv[2][4];
#pragma unroll
        for (int bj = 0; bj < 2; ++bj)
#pragma unroll
            for (int q = 0; q < 4; ++q) { const int c = col0 + bj * HALF + (q >> 1) * 16 + (q & 1) * 4; if constexpr (HAS_BIAS) bv[bj][q] = *(const f32x4*)(bias + c); gv[bj][q] = *(const f32x4*)(gp + c); }
#pragma unroll
        for (int ai = 0; ai < 2; ++ai)
#pragma unroll
            for (int mb = 0; mb < 2; ++mb) { bf16_t* rowp = O + (size_t)(row0 + ai * HALF + mb * 32) * ldc + col0;
#pragma unroll
                for (int bj = 0; bj < 2; ++bj)
#pragma unroll
                    for (int t = 0; t < 2; ++t) { float v[8];
#pragma unroll
                        for (int j = 0; j < 8; ++j) { v[j] = acc[ai][bj][mb][8 * t + j]; if constexpr (HAS_BIAS) v[j] += bv[bj][2 * t + (j >> 2)][j & 3]; v[j] *= gv[bj][2 * t + (j >> 2)][j & 3]; }
                        u32x4 w; w.x = cvt_pk_bf16(v[0], v[1]); w.y = cvt_pk_bf16(v[2], v[3]); w.z = cvt_pk_bf16(v[4], v[5]); w.w = cvt_pk_bf16(v[6], v[7]);
                        store16_wt(rowp + bj * HALF + 16 * t, w); } }
    }
};
struct Epi32Null { static constexpr bool PERM = true, AFTER_DRAIN = false;
    __device__ __forceinline__ void operator()(const f32x16 (&acc)[2][2][2], const Unit& u, int wr, int wc, int r32, int hi) const {
#pragma unroll
        for (int ai = 0; ai < 2; ++ai)
#pragma unroll
            for (int bj = 0; bj < 2; ++bj) asm volatile("" :: "v"(acc[ai][bj][0]), "v"(acc[ai][bj][1])); }
};
template <class Epi, class Sched, bool ALIGN_EPI = false, bool SP2 = false, int SKEL = 0  >
__device__ __forceinline__ void gemm_phase32(PG8_LAS unsigned char* lds, const Gemm g, const Sched& S, const Epi& E) {
    int tid_ = threadIdx.x; asm volatile("" : "+v"(tid_));
    const int tid = tid_, wid = __builtin_amdgcn_readfirstlane(tid >> 6), lane = tid & 63, wr = wid >> 2, wc = wid & 3, r32 = lane & 31, hi = lane >> 5;
    const int K = g.K, nt = K / BK;
    unsigned voffA[2], voffB[2];
#pragma unroll
    for (int i = 0; i < 2; ++i) { int R, C; stage_rc2(tid * 16 + i * 8192, R, C); const int Rb = (R & ~31) + perm32b(R & 31);
        voffA[i] = (unsigned)(R * K + C) * 2u; voffB[i] = (unsigned)(Rb * K + C) * 2u; }
    const unsigned kstep = (unsigned)(BK * 2);
    const unsigned hstep = (unsigned)HALF * (unsigned)K * 2u;
    const unsigned tstep = 2u * hstep;
    const unsigned ldsw = (unsigned)wid * 1024u;
    const int aoff0 = lds_byte2(wr * 64 + r32, hi * 8), boff0 = lds_byte2(wc * 32 + r32, hi * 8); const int aoffs[2] = {aoff0, aoff0 ^ 32}, boffs[2] = {boff0, boff0 ^ 32};
#define PG8_SA(b, h) (((b) * 2 + (h)) * HTB)
#define PG8_SB(b, h) ((4 + (b) * 2 + (h)) * HTB)
#define PG8_STAGE_R(rsrc, bufoff, soff, voff) do { if constexpr (SKEL != 2) { _Pragma("unroll") for (int _i = 0; _i < 2; ++_i) \
        __builtin_amdgcn_raw_ptr_buffer_load_lds(rsrc, (PG8_LAS void*)(lds + (bufoff) + ldsw + _i * 8192), 16, (int)(voff)[_i], (int)(soff), 0, 0); } } while (0)
#define PG8_LDA(dst, b, h) do { if constexpr (SKEL != 2) { _Pragma("unroll") for (int m = 0; m < 2; ++m) _Pragma("unroll") for (int k = 0; k < 4; ++k) dst[m][k] = *(const PG8_LAS bf16x8*)(lds + PG8_SA(b, h) + aoffs[k & 1] + m * 4096 + (k >> 1) * 1024); } } while (0)
#define PG8_LDB(dst, b, h) do { if constexpr (SKEL != 2) { _Pragma("unroll") for (int k = 0; k < 4; ++k) dst[k] = *(const PG8_LAS bf16x8*)(lds + PG8_SB(b, h) + boffs[k & 1] + (k >> 1) * 1024); } } while (0)
#define PG8_MMA(ai, bj, At, Bt) do { __builtin_amdgcn_s_setprio(1); _Pragma("unroll") for (int k = 0; k < 4; ++k) _Pragma("unroll") for (int m = 0; m < 2; ++m) \
        { if constexpr (SKEL != 1) acc[ai][bj][m] = __builtin_amdgcn_mfma_f32_32x32x16_bf16(Bt[k], At[m][k], acc[ai][bj][m], 0, 0, 0); else asm volatile("" :: "v"(Bt[k]), "v"(At[m][k])); } __builtin_amdgcn_s_setprio(0); } while (0)
#define PG8_WAIT_V(n) asm volatile("s_waitcnt vmcnt(" #n ")" ::: "memory")
#define PG8_WAIT_L(n) asm volatile("s_waitcnt lgkmcnt(" #n ")" ::: "memory")
#define PG8_BAR __builtin_amdgcn_s_barrier()
#define PG8_SCHED __builtin_amdgcn_sched_barrier(0)
    Unit cur, nxt; int ui = 0;
    if (!S.next(0, cur)) return;
    f32x16 acc[2][2][2];
#pragma unroll
    for (int a = 0; a < 2; ++a)
#pragma unroll
        for (int b = 0; b < 2; ++b)
#pragma unroll
            for (int m = 0; m < 2; ++m) acc[a][b][m] = f32x16{};
    bf16x8 At[2][4], B0[4], B1[4];
    if constexpr (SKEL == 2) {
#pragma unroll
        for (int m = 0; m < 2; ++m)
#pragma unroll
            for (int k = 0; k < 4; ++k) asm volatile("" : "=v"(At[m][k]));
#pragma unroll
        for (int k = 0; k < 4; ++k) { asm volatile("" : "=v"(B0[k])); asm volatile("" : "=v"(B1[k])); } }
    unsigned cA = (unsigned)cur.pm * tstep, cB = (unsigned)cur.pn * tstep;
    const __amdgpu_buffer_rsrc_t rsA = __builtin_amdgcn_make_buffer_rsrc((void*)g.A, 0, (int)((unsigned)g.M * (unsigned)K * 2u), 0x00020000), rsB = __builtin_amdgcn_make_buffer_rsrc((void*)g.Bt, 0, (int)((unsigned)g.N * (unsigned)K * 2u), 0x00020000);
    S.a_ready(cur);
    if constexpr (SP2) {
        PG8_STAGE_R(rsB, PG8_SB(0, 0), cB, voffB); PG8_STAGE_R(rsB, PG8_SB(0, 1), cB + hstep, voffB); PG8_STAGE_R(rsA, PG8_SA(0, 0), cA, voffA); PG8_STAGE_R(rsA, PG8_SA(0, 1), cA + hstep, voffA);
        if (wr == 1) PG8_BAR;
        PG8_WAIT_V(2); PG8_BAR;
        PG8_STAGE_R(rsB, PG8_SB(1, 0), cB + kstep, voffB); PG8_STAGE_R(rsA, PG8_SA(1, 0), cA + kstep, voffA); PG8_STAGE_R(rsB, PG8_SB(1, 1), cB + hstep + kstep, voffB);
        PG8_WAIT_V(6); PG8_BAR;
    } else {
        PG8_STAGE_R(rsB, PG8_SB(0, 0), cB, voffB); PG8_STAGE_R(rsA, PG8_SA(0, 0), cA, voffA); PG8_STAGE_R(rsB, PG8_SB(0, 1), cB + hstep, voffB); PG8_STAGE_R(rsA, PG8_SA(0, 1), cA + hstep, voffA);
        if (wr == 1) PG8_BAR;
        PG8_WAIT_V(4); PG8_BAR;
        PG8_STAGE_R(rsB, PG8_SB(1, 0), cB + kstep, voffB); PG8_STAGE_R(rsA, PG8_SA(1, 0), cA + kstep, voffA); PG8_STAGE_R(rsB, PG8_SB(1, 1), cB + hstep + kstep, voffB);
        PG8_WAIT_V(6); PG8_BAR;
    }
    for (;;) {
        const bool has_next = S.next(ui + 1, nxt);
        const unsigned nA = has_next ? (unsigned)nxt.pm * tstep : cA, nB = has_next ? (unsigned)nxt.pn * tstep : cB;
        for (int t = 0; t < nt; t += 2) {
            const bool last = (t == nt - 2);
            const unsigned a1 = cA + (unsigned)(t + 1) * kstep;
            const unsigned a2 = last ? nA : cA + (unsigned)(t + 2) * kstep, b2 = last ? nB : cB + (unsigned)(t + 2) * kstep;
            const unsigned a3 = a2 + kstep, b3 = b2 + kstep;
            if (last && has_next) S.a_ready(nxt);
            if constexpr (SP2) {
            PG8_LDB(B0, 0, 0); PG8_LDB(B1, 0, 1); PG8_SCHED; PG8_LDA(At, 0, 0); PG8_STAGE_R(rsA, PG8_SA(1, 1), a1 + hstep, voffA);
            PG8_WAIT_V(8); PG8_WAIT_L(0); PG8_BAR; PG8_MMA(0, 0, At, B0); PG8_MMA(0, 1, At, B1); PG8_BAR; PG8_SCHED;
            PG8_LDA(At, 0, 1); PG8_STAGE_R(rsB, PG8_SB(0, 0), b2, voffB); PG8_STAGE_R(rsB, PG8_SB(0, 1), b2 + hstep, voffB); PG8_STAGE_R(rsA, PG8_SA(0, 0), a2, voffA);
            PG8_WAIT_V(8); PG8_WAIT_L(0); PG8_BAR; PG8_MMA(1, 0, At, B0); PG8_MMA(1, 1, At, B1); PG8_BAR; PG8_SCHED;
            PG8_LDB(B0, 1, 0); PG8_LDB(B1, 1, 1); PG8_SCHED; PG8_LDA(At, 1, 0); PG8_STAGE_R(rsA, PG8_SA(0, 1), a2 + hstep, voffA);
            PG8_WAIT_V(8); PG8_WAIT_L(0); PG8_BAR; PG8_MMA(0, 0, At, B0); PG8_MMA(0, 1, At, B1); PG8_BAR; PG8_SCHED;
            PG8_LDA(At, 1, 1); PG8_STAGE_R(rsB, PG8_SB(1, 0), b3, voffB); PG8_STAGE_R(rsB, PG8_SB(1, 1), b3 + hstep, voffB); PG8_STAGE_R(rsA, PG8_SA(1, 0), a3, voffA);
            PG8_WAIT_V(8); PG8_WAIT_L(0); PG8_BAR; PG8_MMA(1, 0, At, B0); PG8_MMA(1, 1, At, B1); PG8_BAR; PG8_SCHED;
            } else {
            PG8_LDB(B0, 0, 0); PG8_SCHED; PG8_LDA(At, 0, 0); PG8_STAGE_R(rsA, PG8_SA(1, 1), a1 + hstep, voffA);
            PG8_WAIT_L(8); PG8_BAR; PG8_WAIT_L(0); PG8_MMA(0, 0, At, B0); PG8_BAR; PG8_SCHED;
            PG8_LDB(B1, 0, 1); PG8_STAGE_R(rsB, PG8_SB(0, 0), b2, voffB);
            PG8_BAR; PG8_WAIT_L(0); PG8_MMA(0, 1, At, B1); PG8_BAR;
            PG8_LDA(At, 0, 1); PG8_STAGE_R(rsA, PG8_SA(0, 0), a2, voffA);
            PG8_BAR; PG8_WAIT_L(0); PG8_MMA(1, 0, At, B0); PG8_BAR; PG8_SCHED;
            PG8_STAGE_R(rsB, PG8_SB(0, 1), b2 + hstep, voffB);
            PG8_WAIT_V(6); PG8_BAR; PG8_MMA(1, 1, At, B1); PG8_BAR;
            PG8_LDB(B0, 1, 0); PG8_SCHED; PG8_LDA(At, 1, 0); PG8_STAGE_R(rsA, PG8_SA(0, 1), a2 + hstep, voffA);
            PG8_WAIT_L(8); PG8_BAR; PG8_WAIT_L(0); PG8_MMA(0, 0, At, B0); PG8_BAR; PG8_SCHED;
            PG8_LDB(B1, 1, 1); PG8_STAGE_R(rsB, PG8_SB(1, 0), b3, voffB);
            PG8_BAR; PG8_WAIT_L(0); PG8_MMA(0, 1, At, B1); PG8_BAR;
            PG8_LDA(At, 1, 1); PG8_STAGE_R(rsA, PG8_SA(1, 0), a3, voffA);
            PG8_BAR; PG8_WAIT_L(0); PG8_MMA(1, 0, At, B0); PG8_BAR; PG8_SCHED;
            PG8_STAGE_R(rsB, PG8_SB(1, 1), b3 + hstep, voffB);
            PG8_WAIT_V(6); PG8_BAR; PG8_MMA(1, 1, At, B1); PG8_BAR;
            }
        }
        if constexpr (ALIGN_EPI) { if (wr == 0) PG8_BAR; }
        if constexpr (!Epi::AFTER_DRAIN) { E(acc, cur, wr, wc, r32, hi); S.done(cur); }
        if (!has_next) break;
#pragma unroll
        for (int a = 0; a < 2; ++a)
#pragma unroll
            for (int b = 0; b < 2; ++b)
#pragma unroll
                for (int m = 0; m < 2; ++m) acc[a][b][m] = f32x16{};
        cur = nxt; cA = nA; cB = nB; ++ui;
        if constexpr (ALIGN_EPI) { if (wr == 1) PG8_BAR; }
    }
    PG8_WAIT_V(0);
    if constexpr (!ALIGN_EPI) { if (wr == 0) PG8_BAR; }
    PG8_BAR;
    static_assert(!Epi::AFTER_DRAIN, "gemm_phase32: no drained epilogues");
#undef PG8_SA
#undef PG8_SB
#undef PG8_STAGE_R
#undef PG8_LDA
#undef PG8_LDB
#undef PG8_MMA
#undef PG8_WAIT_V
#undef PG8_WAIT_L
#undef PG8_BAR
#undef PG8_SCHED
}
}

namespace sba {
using bf16x8 = __attribute__((ext_vector_type(8))) short;
using s16x4  = __attribute__((ext_vector_type(4))) short;
using f32x16 = __attribute__((ext_vector_type(16))) float;
using u32x4  = __attribute__((ext_vector_type(4))) unsigned;
typedef _Float16 f16x8 __attribute__((ext_vector_type(8)));
#define SBA_LAS __attribute__((address_space(3)))
constexpr int D = 128, NW = 8, QBLK = 32, KVBLK = 64, LDR = 2048, SEQ = 4096, NHEAD = 16, UNIT_ROWS = QBLK * NW;
constexpr int SHM_V = KVBLK * D * 2, SHM_K = KVBLK * D * 2;
constexpr int OFF_V = 0, OFF_K = 2 * SHM_V, OFF_FLAG = 2 * SHM_V + 2 * SHM_K, OFF_OST = OFF_FLAG + 128, LDS_BYTES = OFF_OST + NW * 4096;
constexpr float DEAD = -152.f;
constexpr float NEG = -30000.f;
#define SBA_KSWZ(row, colB) ((row) * 256 + ((colB) ^ (((row) & 7) << 4)))
#define SBA_SBAR() __builtin_amdgcn_sched_barrier(0)
__device__ __forceinline__ int crow(int r, int hi) { return (r & 3) + 8 * (r >> 2) + 4 * hi; }
__device__ __forceinline__ unsigned cvtpk(float lo, float hi) { unsigned r; asm volatile("v_cvt_pk_bf16_f32 %0, %1, %2" : "=v"(r) : "v"(lo), "v"(hi)); return r; }
__device__ __forceinline__ unsigned pkh(float lo, float hi) { return __builtin_bit_cast(unsigned, __builtin_amdgcn_cvt_pkrtz(lo, hi)); }
__device__ __forceinline__ int v_st(int k, int c) { const int kk = (k & ~0xC) | ((k & 4) << 1) | ((k & 8) >> 1); return ((kk >> 3) * 4 + (c >> 5)) * 512 + ((kk & 7) * 32 + (c & 31)) * 2; }
__device__ __forceinline__ int v_rd_base(int lane) { return ((lane & 3) << 3) | (((lane >> 2) & 3) << 6) | (((lane >> 4) & 1) << 5) | (((lane >> 5) & 1) << 8); }
constexpr int v_rd_off(int d0, int ks, int half) { return d0 * 512 + ks * 4096 + half * 2048; }
template <int OFF> __device__ __forceinline__ s16x4 tr_read(int vb) { s16x4 r; asm volatile("ds_read_b64_tr_b16 %0, %1 offset:%2" : "=&v"(r) : "v"(vb), "i"(OFF) : "memory"); return r; }
template <int D0> __device__ __forceinline__ void pv_one(f32x16& od, int vb, bf16x8 pa0, bf16x8 pa1, bf16x8 pa2, bf16x8 pa3) {
  const s16x4 l0 = tr_read<v_rd_off(D0, 0, 0)>(vb), h0 = tr_read<v_rd_off(D0, 0, 1)>(vb), l1 = tr_read<v_rd_off(D0, 1, 0)>(vb), h1 = tr_read<v_rd_off(D0, 1, 1)>(vb);
  const s16x4 l2 = tr_read<v_rd_off(D0, 2, 0)>(vb), h2 = tr_read<v_rd_off(D0, 2, 1)>(vb), l3 = tr_read<v_rd_off(D0, 3, 0)>(vb), h3 = tr_read<v_rd_off(D0, 3, 1)>(vb);
  asm volatile("s_waitcnt lgkmcnt(0)" ::: "memory"); SBA_SBAR();
#define SBA_PK(L, H) (bf16x8){L[0], L[1], L[2], L[3], H[0], H[1], H[2], H[3]}
  od = __builtin_amdgcn_mfma_f32_32x32x16_bf16(pa0, SBA_PK(l0, h0), od, 0, 0, 0);
  od = __builtin_amdgcn_mfma_f32_32x32x16_bf16(pa1, SBA_PK(l1, h1), od, 0, 0, 0);
  od = __builtin_amdgcn_mfma_f32_32x32x16_bf16(pa2, SBA_PK(l2, h2), od, 0, 0, 0);
  od = __builtin_amdgcn_mfma_f32_32x32x16_bf16(pa3, SBA_PK(l3, h3), od, 0, 0, 0);
#undef SBA_PK
}
__device__ __forceinline__ void qkt(f32x16& p0, f32x16& p1, const SBA_LAS char* Ks, const bf16x8* qr, int r32, int hi) {
  p0 = f32x16{}; p1 = f32x16{};
#pragma unroll
  for (int d0 = 0; d0 < 8; ++d0) { const int cb = (d0 * 16 + hi * 8) * 2;
    const bf16x8 b0 = *(const SBA_LAS bf16x8*)(Ks + SBA_KSWZ(r32, cb));
    const bf16x8 b1 = *(const SBA_LAS bf16x8*)(Ks + SBA_KSWZ(32 + r32, cb));
    p0 = __builtin_amdgcn_mfma_f32_32x32x16_bf16(b0, qr[d0], p0, 0, 0, 0);
    p1 = __builtin_amdgcn_mfma_f32_32x32x16_bf16(b1, qr[d0], p1, 0, 0, 0); }
}
__device__ __forceinline__ void sb_elem(float z, float& lb, float& l1) {
  const float e = __builtin_amdgcn_exp2f(-__builtin_fabsf(z));
  const float L = __builtin_amdgcn_logf(1.0f + e);
  lb = __builtin_amdgcn_fmed3f(z, 0.f, -3.0e38f) - L; l1 = lb - z;
}

__device__ __forceinline__ void attn_unit(int b, int h, int qb, const unsigned short* __restrict__ Q, const unsigned short* __restrict__ K, const unsigned short* __restrict__ V,
                                          signed char* __restrict__ O, float oinv, SBA_LAS char* lds) {
  int tid_ = threadIdx.x; asm volatile("" : "+v"(tid_));
  const int tid = tid_, wid = __builtin_amdgcn_readfirstlane(tid >> 6), lane = tid & 63, r32 = lane & 31, hi = lane >> 5;
  SBA_LAS char* V_lds = lds + OFF_V; SBA_LAS char* K_lds = lds + OFF_K; volatile SBA_LAS unsigned* flags = (volatile SBA_LAS unsigned*)(lds + OFF_FLAG);
  const long rowbase = (long)b * SEQ; const int q0 = qb * UNIT_ROWS;
  bf16x8 qr[8];
  { const unsigned short* Qw = Q + (rowbase + q0 + wid * QBLK + r32) * LDR + h * D + hi * 8;
#pragma unroll
    for (int d0 = 0; d0 < 8; ++d0) qr[d0] = *(const bf16x8*)(Qw + d0 * 16); }
  const unsigned short* Kh = K + rowbase * LDR + h * D; const unsigned short* Vh = V + rowbase * LDR + h * D;
  const int sr = tid >> 4, sc = (tid & 15) * 8, vst0 = v_st(sr, sc), vst1 = v_st(32 + sr, sc);
  const int vb0 = (int)(uintptr_t)V_lds + v_rd_base(lane);
  bf16x8 vs0, vs1, ks0, ks1;
#define SBA_SLOAD(k0) do { vs0 = *(const bf16x8*)(Vh + (long)((k0) + sr) * LDR + sc); vs1 = *(const bf16x8*)(Vh + (long)((k0) + 32 + sr) * LDR + sc); \
    ks0 = *(const bf16x8*)(Kh + (long)((k0) + sr) * LDR + sc); ks1 = *(const bf16x8*)(Kh + (long)((k0) + 32 + sr) * LDR + sc); } while (0)
#define SBA_SWRITE(bf) do { *(SBA_LAS bf16x8*)(V_lds + (bf) * SHM_V + vst0) = vs0; *(SBA_LAS bf16x8*)(V_lds + (bf) * SHM_V + vst1) = vs1; const int kc = sc * 2; \
    *(SBA_LAS bf16x8*)(K_lds + (bf) * SHM_K + SBA_KSWZ(sr, kc)) = ks0; *(SBA_LAS bf16x8*)(K_lds + (bf) * SHM_K + SBA_KSWZ(32 + sr, kc)) = ks1; } while (0)
  f16x8 U0, U1, ONES;
  { u32x4 w0, w1;
#pragma unroll
    for (int p = 0; p < 4; ++p) { const int ka = crow(2 * p, hi), kb = crow(2 * p + 1, hi), kc2 = crow(8 + 2 * p, hi), kd = crow(8 + 2 * p + 1, hi);
      w0[p] = (ka > r32 ? 0x3C00u : 0u) | (kb > r32 ? 0x3C000000u : 0u); w1[p] = (kc2 > r32 ? 0x3C00u : 0u) | (kd > r32 ? 0x3C000000u : 0u); }
    U0 = __builtin_bit_cast(f16x8, w0); U1 = __builtin_bit_cast(f16x8, w1);
    const u32x4 wo = {0x3C003C00u, 0x3C003C00u, 0x3C003C00u, 0x3C003C00u}; ONES = __builtin_bit_cast(f16x8, wo); }
  const int kt_top = 4 * qb + 3, my_kt = 4 * qb + (wid >> 1);
  const int ql = r32 + 32 * (wid & 1);
  float carry = 0.f; bool dead = false; f32x16 o[4] = {};
  SBA_SLOAD(kt_top * KVBLK); asm volatile("s_waitcnt vmcnt(0)" ::: "memory"); SBA_SWRITE(0); __syncthreads();
  for (int i = 0;; ++i) {
    const int kt = kt_top - i, cur = i & 1;
    if (kt > 0) SBA_SLOAD((kt - 1) * KVBLK);
    if (kt <= my_kt && !dead) {
      f32x16 p0, p1;
      qkt(p0, p1, K_lds + cur * SHM_K, qr, r32, hi);
      f32x16 lb0, lb1; float l10[16], l11[16];
#pragma unroll
      for (int r = 0; r < 16; ++r) { float a, c; sb_elem(p0[r], a, c); lb0[r] = a; l10[r] = c; sb_elem(p1[r], a, c); lb1[r] = a; l11[r] = c; }
      if (kt == my_kt) {
#pragma unroll
        for (int r = 0; r < 16; ++r) { const int k0 = crow(r, hi); const bool v0 = k0 < ql, v1 = (k0 + 32) < ql;
          l10[r] = v0 ? l10[r] : 0.f; lb0[r] = v0 ? lb0[r] : NEG; l11[r] = v1 ? l11[r] : 0.f; lb1[r] = v1 ? lb1[r] : NEG; }
      }
      const float lbk0 = lb0[0], l1k0 = l10[0];
      f16x8 h00, h01, h10, h11;
      { u32x4 a, c, e, g;
#pragma unroll
        for (int p = 0; p < 4; ++p) { a[p] = pkh(l10[2 * p], l10[2 * p + 1]); c[p] = pkh(l10[8 + 2 * p], l10[8 + 2 * p + 1]); e[p] = pkh(l11[2 * p], l11[2 * p + 1]); g[p] = pkh(l11[8 + 2 * p], l11[8 + 2 * p + 1]); }
        h00 = __builtin_bit_cast(f16x8, a); h01 = __builtin_bit_cast(f16x8, c); h10 = __builtin_bit_cast(f16x8, e); h11 = __builtin_bit_cast(f16x8, g); }
      lb1 = __builtin_amdgcn_mfma_f32_32x32x16_f16(U0, h10, lb1, 0, 0, 0); lb1 = __builtin_amdgcn_mfma_f32_32x32x16_f16(U1, h11, lb1, 0, 0, 0);
      lb0 = __builtin_amdgcn_mfma_f32_32x32x16_f16(U0, h00, lb0, 0, 0, 0); lb0 = __builtin_amdgcn_mfma_f32_32x32x16_f16(U1, h01, lb0, 0, 0, 0);
      lb0 = __builtin_amdgcn_mfma_f32_32x32x16_f16(ONES, h10, lb0, 0, 0, 0); lb0 = __builtin_amdgcn_mfma_f32_32x32x16_f16(ONES, h11, lb0, 0, 0, 0);
      float tot = (hi == 0) ? (lb0[0] - lbk0) + l1k0 : 0.f;
      { auto rr = __builtin_amdgcn_permlane32_swap(__float_as_uint(tot), __float_as_uint(tot), false, false); tot = __uint_as_float(rr[0]) + __uint_as_float(rr[1]); }
#pragma unroll
      for (int r = 0; r < 16; ++r) { lb0[r] = __builtin_amdgcn_exp2f(lb0[r] + carry); lb1[r] = __builtin_amdgcn_exp2f(lb1[r] + carry); }
      carry += tot;
      bf16x8 pa0, pa1, pa2, pa3;
#define SBA_PK4(P, BASE, OUT) do { unsigned a0 = cvtpk(P[BASE + 0], P[BASE + 1]), a1 = cvtpk(P[BASE + 2], P[BASE + 3]);   \
    unsigned b0 = cvtpk(P[BASE + 4], P[BASE + 5]), b1 = cvtpk(P[BASE + 6], P[BASE + 7]);                              \
    auto r0 = __builtin_amdgcn_permlane32_swap(a0, b0, false, false); auto r1 = __builtin_amdgcn_permlane32_swap(a1, b1, false, false); \
    u32x4 w = {r0[0], r1[0], r0[1], r1[1]}; OUT = __builtin_bit_cast(bf16x8, w); } while (0)
      SBA_PK4(lb0, 0, pa0); SBA_PK4(lb0, 8, pa1); SBA_PK4(lb1, 0, pa2); SBA_PK4(lb1, 8, pa3);
#undef SBA_PK4
      SBA_SBAR();
      const int vb = vb0 + cur * SHM_V;
      pv_one<0>(o[0], vb, pa0, pa1, pa2, pa3); pv_one<1>(o[1], vb, pa0, pa1, pa2, pa3); pv_one<2>(o[2], vb, pa0, pa1, pa2, pa3); pv_one<3>(o[3], vb, pa0, pa1, pa2, pa3);
      dead = !__any(carry > DEAD);
    }
    if (lane == 0) flags[cur * 8 + wid] = (kt > my_kt || !dead) ? 1u : 0u;
    if (kt > 0) { asm volatile("s_waitcnt vmcnt(0)" ::: "memory"); SBA_SWRITE(cur ^ 1); }
    __syncthreads();
    if (kt == 0) break;
    unsigned any = 0u;
#pragma unroll
    for (int w = 0; w < 8; ++w) any |= flags[cur * 8 + w];
    if (__builtin_amdgcn_readfirstlane(any) == 0u) break;
  }
  { signed char* Ow = O + (rowbase + q0 + wid * QBLK) * LDR + h * D; SBA_LAS signed char* stg = (SBA_LAS signed char*)(lds + OFF_OST) + wid * 4096;
#pragma unroll
    for (int r = 0; r < 16; ++r) { const int orow = crow(r, hi);
#pragma unroll
      for (int d0 = 0; d0 < 4; ++d0) { int q = __float2int_rn(o[d0][r] * oinv); q = q > 127 ? 127 : (q < -127 ? -127 : q); stg[orow * 128 + d0 * 32 + r32] = (signed char)q; } }
    asm volatile("s_waitcnt lgkmcnt(0)" ::: "memory");
#pragma unroll
    for (int i = 0; i < 4; ++i) { const int row = i * 8 + (lane >> 3), ch = lane & 7; const u32x4 v = *(const SBA_LAS u32x4*)(stg + row * 128 + ch * 16);
      *(u32x4*)(Ow + (long)row * LDR + ch * 16) = v; }
    asm volatile("s_waitcnt lgkmcnt(0)" ::: "memory");
  }
#undef SBA_SLOAD
#undef SBA_SWRITE
}
}
#define GAS __attribute__((address_space(1)))
#define LAS __attribute__((address_space(3)))
typedef unsigned short bf16;
typedef unsigned v4u __attribute__((ext_vector_type(4)));
typedef float f32x4 __attribute__((ext_vector_type(4)));
typedef short bf16x8 __attribute__((ext_vector_type(8)));
typedef GAS unsigned gu32;
typedef GAS unsigned long long gu64;
#define RLX_AGENT __ATOMIC_RELAXED, __HIP_MEMORY_SCOPE_AGENT
#define LDS_WAIT() asm volatile("s_waitcnt lgkmcnt(0)" ::: "memory")
#define VM_WAIT() asm volatile("s_waitcnt vmcnt(0)" ::: "memory")
__device__ __forceinline__ unsigned long long rt() { return __builtin_amdgcn_s_memrealtime(); }
__device__ __forceinline__ unsigned f2bf(float f) { unsigned u = __builtin_bit_cast(unsigned, f); return (u + 0x7fffu + ((u >> 16) & 1u)) >> 16; }
__device__ __forceinline__ unsigned pk2(float lo, float hi) { return f2bf(lo) | (f2bf(hi) << 16); }

#define XB_TMO      128
#define XB_XCNT(j)  (256  + 64 * (j))
#define XB_XSUB(j)  (1280 + 64 * (j))
#define XB_XGEN(j)  (2304 + 64 * (j))
#define XB_TOP      3328
#define XB_TOPGEN   3392
#define XCD_BAR_WORDS 3456
#define XB_SPIN_CAP (1u << 18)

__device__ __forceinline__ unsigned xb_ld(unsigned* p)              { return __hip_atomic_load(p, __ATOMIC_RELAXED, __HIP_MEMORY_SCOPE_AGENT); }
__device__ __forceinline__ unsigned xb_add(unsigned* p, unsigned v) { return __hip_atomic_fetch_add(p, v, __ATOMIC_RELAXED, __HIP_MEMORY_SCOPE_AGENT); }
__device__ __forceinline__ unsigned xb_xcc_id() { return (unsigned)__builtin_amdgcn_s_getreg((3 << 11) | 20) & 0xFu; }
#define XB_SPIN(cond, bar) do { unsigned _sp = 0; while (cond) { __builtin_amdgcn_s_sleep(1); \
    if ((++_sp & 255u) == 0u) { if (xb_ld(&(bar)[XB_TMO])) break; if (_sp > XB_SPIN_CAP) { atomicAdd(&(bar)[XB_TMO], 1u); break; } } } } while (0)

struct XcdBarrier {
    unsigned* bar; unsigned x;
    volatile LAS unsigned* st;
};

__device__ __forceinline__ XcdBarrier xcd_barrier_post(unsigned* bar, volatile LAS unsigned* st) {
    XcdBarrier b; b.bar = bar; b.x = xb_xcc_id(); b.st = st;
    if (threadIdx.x == 0) (void)xb_add(&bar[XB_XCNT(b.x)], 1u);
    return b;
}
__device__ __forceinline__ void xcd_barrier_complete(unsigned* bar, unsigned x, unsigned& nloc, unsigned& nx) {
    const unsigned G = gridDim.x * gridDim.y * gridDim.z;
    unsigned sum, cnt, mine, sp = 0u;
    for (;;) {
        sum = 0u; cnt = 0u; mine = 0u;
#pragma unroll
        for (unsigned j = 0; j < 16; ++j) { const unsigned c = xb_ld(&bar[XB_XCNT(j)]); sum += c; cnt += (c > 0u) ? 1u : 0u; mine = (j == x) ? c : mine; }
        if (sum == G) break;
        __builtin_amdgcn_s_sleep(1);
        if ((++sp & 255u) == 0u) { if (xb_ld(&bar[XB_TMO])) break; if (sp > XB_SPIN_CAP) { atomicAdd(&bar[XB_TMO], 1u); break; } }
    }
    nloc = mine > 0u ? mine : 1u; nx = cnt > 0u ? cnt : 1u;
}

__device__ __forceinline__ void xcd_barrier(const XcdBarrier& b) {
    asm volatile("s_waitcnt vmcnt(0)" ::: "memory");
    __syncthreads();
    if (threadIdx.x == 0) {
        unsigned* bar = b.bar;
        __builtin_amdgcn_s_waitcnt(0);
        unsigned nloc = b.st[0], nx = b.st[1];
        if (nloc == 0u) { xcd_barrier_complete(bar, b.x, nloc, nx); b.st[0] = nloc; b.st[1] = nx; }
        const unsigned old = xb_add(&bar[XB_XSUB(b.x)], 1u);
        const unsigned gen = old / nloc;
        if (old + 1u == (gen + 1u) * nloc) {
            __builtin_amdgcn_fence(__ATOMIC_RELEASE, "agent");
            asm volatile("s_waitcnt vmcnt(0)" ::: "memory");
            const unsigned og = xb_add(&bar[XB_TOP], 1u);
            const unsigned tg = og / nx;
            if (og + 1u == (tg + 1u) * nx) xb_add(&bar[XB_TOPGEN], 1u);
            else XB_SPIN(xb_ld(&bar[XB_TOPGEN]) == tg, bar);
            __builtin_amdgcn_fence(__ATOMIC_ACQUIRE, "agent");
            xb_add(&bar[XB_XGEN(b.x)], 1u);
            asm volatile("s_waitcnt vmcnt(0)" ::: "memory");
        } else {
            XB_SPIN(xb_ld(&bar[XB_XGEN(b.x)]) == gen, bar);
            __builtin_amdgcn_fence(__ATOMIC_ACQUIRE, "agent");
            asm volatile("s_waitcnt vmcnt(0)" ::: "memory");
        }
    }
    __syncthreads();
}

template <unsigned NG = 4u>
__device__ __forceinline__ void grp_barrier(unsigned* cnt, unsigned* mask, volatile LAS unsigned* ep, unsigned* bar, unsigned* nb_cnt = nullptr, unsigned* nb_mask = nullptr) {
    asm volatile("s_waitcnt vmcnt(0)" ::: "memory");
    __syncthreads();
    if (threadIdx.x == 0) {
        __builtin_amdgcn_s_waitcnt(0);
        const unsigned e = ep[0] + 1u; ep[0] = e;
        unsigned st = ep[1];
        if (st == 0u) { const unsigned m = xb_ld(mask); st = (m != 0u && (m & (m - 1u)) == 0u) ? 1u : 2u; ep[1] = st; }
        bool fast = (st == 1u);
        if (fast && nb_mask) fast = (xb_ld(nb_mask) == xb_ld(mask));
        if (!fast) { __builtin_amdgcn_fence(__ATOMIC_RELEASE, "agent"); asm volatile("s_waitcnt vmcnt(0)" ::: "memory"); }
        (void)xb_add(cnt, 1u);
        const unsigned target = NG * e;
        XB_SPIN(xb_ld(cnt) < target, bar);
        if (nb_cnt) XB_SPIN(xb_ld(nb_cnt) < target, bar);
        __builtin_amdgcn_fence(__ATOMIC_ACQUIRE, "agent");
        asm volatile("s_waitcnt vmcnt(0)" ::: "memory");
    }
    __syncthreads();
}

template <unsigned NG = 4u>
__device__ __forceinline__ void prefix_barrier(unsigned* cnt0, unsigned* mask0, int pm, int first, int last, volatile LAS unsigned* ep, unsigned* bar) {
    asm volatile("s_waitcnt vmcnt(0)" ::: "memory");
    __syncthreads();
    if (threadIdx.x < 64) {
        int lane_ = threadIdx.x; asm volatile("" : "+v"(lane_)); const int lane = lane_;
        __builtin_amdgcn_s_waitcnt(0);
        unsigned e = 0u;
        if (lane == 0) { e = ep[0] + 1u; ep[0] = e; }
        e = __builtin_amdgcn_readfirstlane(e);
        const unsigned own = xb_ld(mask0 + 64 * pm);
        const int g = first + lane;
        const unsigned mg = (g > pm && g <= last) ? xb_ld(mask0 + 64 * g) : own;
        const bool fast = (own != 0u) && ((own & (own - 1u)) == 0u) && __all(mg == own);
        if (!fast && lane == 0) { __builtin_amdgcn_fence(__ATOMIC_RELEASE, "agent"); asm volatile("s_waitcnt vmcnt(0)" ::: "memory"); }
        if (lane == 0) (void)xb_add(cnt0 + 64 * pm, 1u);
        const unsigned target = NG * e;
        unsigned sp = 0u;
        for (;;) {
            const unsigned v = (g <= pm) ? xb_ld(cnt0 + 64 * g) : target;
            if (__all(v >= target)) break;
            __builtin_amdgcn_s_sleep(1);
            if ((++sp & 255u) == 0u) { if (xb_ld(&bar[XB_TMO])) break; if (sp > XB_SPIN_CAP) { if (lane == 0) atomicAdd(&bar[XB_TMO], 1u); break; } }
        }
        __builtin_amdgcn_fence(__ATOMIC_ACQUIRE, "agent");
        asm volatile("s_waitcnt vmcnt(0)" ::: "memory");
    }
    __syncthreads();
}

constexpr int NWAVES = 8, NWAVES_ = 8;
constexpr int BATCH = 4, SEQ = 4096, DM = 2048, NH = 16, HD = 128, FF = 8192, DEPTH = 4, NMOD = 6;
constexpr int M = BATCH * SEQ;
constexpr int NMIX = 3 * DM;
constexpr float LN_EPS = 1e-5f;
constexpr float DN_ALPHA = 1.6817928305074290f;
constexpr float QSCALE = 0.088388347648318440f * 1.4426950408889634f;
constexpr float HID_SCALE = 32.0f, W2_SCALE = 128.0f;
constexpr int MODN = NMOD * DM;
constexpr int KSPLIT = 8;
constexpr size_t MiB = 1u << 20;
constexpr size_t WS_CTL = 0, CTL_ZERO_BYTES = 1 * MiB;
constexpr size_t WS_MODTAB = 1 * MiB;
constexpr size_t WS_PART = 2 * MiB;
constexpr size_t WS_W = 16 * MiB, W_LAYER = 96 * MiB, W_MIXIN = 0, W_MIXOUT = 24 * MiB, W_W1 = 32 * MiB, W_W2 = 64 * MiB;
constexpr size_t WS_H = 400 * MiB, WS_Q = 464 * MiB, WS_K = 528 * MiB, WS_V = 592 * MiB, WS_O = 656 * MiB;
constexpr size_t WS_HID = 720 * MiB, WS_END = 976 * MiB;
constexpr size_t WS_K2 = 912 * MiB, WS_V2 = 1040 * MiB, WS_G2 = 1104 * MiB  , WS_NEED = 1168 * MiB;
constexpr size_t WS_G = WS_HID + 128 * MiB;
constexpr size_t WS_Y = WS_Q;
constexpr size_t WS_X16 = 976 * MiB;
constexpr size_t WS_ROWS = 9 * MiB;
constexpr size_t WS_ROWSH = WS_ROWS + 64 * 1024;
constexpr size_t W_MIXOUT_CS = 4 * MiB;
constexpr size_t W_MIXIN_CS = 12 * MiB;
constexpr size_t W_W1_CS = 16 * MiB;
constexpr size_t WS_SCR = 1040 * MiB;
static_assert(WS_PART + (size_t)KSPLIT * DEPTH * BATCH * MODN * 4 <= WS_ROWS && WS_ROWS + (size_t)BATCH * SEQ * 4 <= WS_W && WS_W + DEPTH * W_LAYER <= WS_H && WS_HID + (size_t)M * FF * 2 <= WS_END, "d_ws map");
constexpr int CW_GMASK = 16384;
constexpr int CW_GRP = 8192;
constexpr int CW_A1 = 2048;
constexpr int CW_VMAX = 1024;
constexpr int CW_BAR = 4096;
constexpr int RING_OFF = 0, RING_BYTES = 131072;
constexpr int LDSCTL_OFF = RING_BYTES, MISC_OFF = LDSCTL_OFF + 320;
constexpr int LDS_BYTES = 147456;
static_assert(MISC_OFF + 128 <= LDS_BYTES && sba::LDS_BYTES <= RING_BYTES, "LDS map");

struct Frame {
    LAS unsigned char* lds;
    int tid, lane, wave, vcu, G, vrow;
};
template <int CTRL, int ROWMASK> __device__ __forceinline__ float dpp_mov(float old, float v) {
    return __builtin_bit_cast(float, __builtin_amdgcn_update_dpp(__builtin_bit_cast(int, old), __builtin_bit_cast(int, v), CTRL, ROWMASK, 0xF, false));
}
__device__ __forceinline__ float wave_sum(float v) {
    v += dpp_mov<0xB1, 0xF>(v, v); v += dpp_mov<0x4E, 0xF>(v, v); v += dpp_mov<0x141, 0xF>(v, v); v += dpp_mov<0x140, 0xF>(v, v);
    v += dpp_mov<0x142, 0xA>(0.f, v); v += dpp_mov<0x143, 0xC>(0.f, v);
    return __builtin_bit_cast(float, __builtin_amdgcn_readlane(__builtin_bit_cast(int, v), 63));
}
__device__ __forceinline__ unsigned cvtpk_bf16(float lo, float hi) { unsigned r; asm volatile("v_cvt_pk_bf16_f32 %0, %1, %2" : "=v"(r) : "v"(lo), "v"(hi)); return r; }
__host__ __device__ __forceinline__ int conv_in_row(int n0) { if (n0 < DM) return 2 * DM + n0; if (n0 < 2 * DM) { const int j = n0 - DM; return 256 * (j / 128) + (j % 128); } const int j = n0 - 2 * DM; return 256 * (j / 128) + 128 + (j % 128); }
template <bool CONV_IN = false, bool FP8 = false>
__device__ __forceinline__ void p0_transpose_item(const float* W, int K, int N, bf16* WT, LAS float* scr, int item, int lane, int scaled_cols = 0, float scale = 1.f) {
    const int nblk = N / 32, kb = item / nblk, nb = item % nblk, k0 = 64 * kb, n0 = 32 * nb;
#pragma unroll 8
    for (int i = 0; i < 32; ++i) { const int kk = 2 * i + (lane >> 5); scr[kk * 33 + (lane & 31)] = __builtin_nontemporal_load(&W[(size_t)(k0 + kk) * N + n0 + (lane & 31)]); }
    LDS_WAIT(); asm volatile("" ::: "memory");
    const int c = lane & 7; const float sf = (n0 < scaled_cols) ? scale : 1.f;
#pragma unroll
    for (int j = 0; j < 4; ++j) { const int n = (lane >> 3) + 8 * j; const LAS float* s = scr + (8 * c) * 33 + n;
        if constexpr (FP8) { float t[8];
#pragma unroll
            for (int i = 0; i < 8; ++i) t[i] = fminf(fmaxf(s[i * 33] * sf, -448.0f), 448.0f);
            int p0 = 0, p1 = 0; p0 = __builtin_amdgcn_cvt_pk_fp8_f32(t[0], t[1], p0, false); p0 = __builtin_amdgcn_cvt_pk_fp8_f32(t[2], t[3], p0, true);
            p1 = __builtin_amdgcn_cvt_pk_fp8_f32(t[4], t[5], p1, false); p1 = __builtin_amdgcn_cvt_pk_fp8_f32(t[6], t[7], p1, true);
            uint2 o; o.x = (unsigned)p0; o.y = (unsigned)p1; *(uint2*)((unsigned char*)WT + (size_t)(n0 + n) * K + k0 + 8 * c) = o; }
        else {
        v4u o; o.x = cvtpk_bf16(s[0 * 33] * sf, s[1 * 33] * sf); o.y = cvtpk_bf16(s[2 * 33] * sf, s[3 * 33] * sf); o.z = cvtpk_bf16(s[4 * 33] * sf, s[5 * 33] * sf); o.w = cvtpk_bf16(s[6 * 33] * sf, s[7 * 33] * sf);
        *(v4u*)(WT + (size_t)((CONV_IN ? conv_in_row(n0) : n0) + n) * K + k0 + 8 * c) = o; } }
    LDS_WAIT(); asm volatile("" ::: "memory");
}

__device__ __forceinline__ void p0_w1_item(const float* W, int K, int N, signed char* WT8, float* cs, LAS float* scr, LAS float* red  , int item, int wave, int lane, int scaled_cols = 0, float cs_factor = 1.f) {
    const int n0 = 16 * item, c = lane & 15, kq = lane >> 4, kw = (K / NWAVES_) * wave;
    float mx = 0.f;
    for (int i = 0; i < K / NWAVES_ / 4; i += 16) { float t[16];
#pragma unroll
        for (int j = 0; j < 16; ++j) t[j] = W[(size_t)(kw + 4 * (i + j) + kq) * N + n0 + c];
#pragma unroll
        for (int j = 0; j < 16; ++j) mx = fmaxf(mx, fabsf(t[j])); }
    mx = fmaxf(mx, __shfl_xor(mx, 16)); mx = fmaxf(mx, __shfl_xor(mx, 32));
    if (lane < 16) red[wave * 16 + c] = mx;
    __syncthreads();
#pragma unroll
    for (int w = 0; w < NWAVES_; ++w) mx = fmaxf(mx, red[w * 16 + c]);
    const float sc = mx > 0.f ? mx * (1.0f / 127.0f) : 1.0f;
    if (wave == 0 && lane < 16) cs[n0 + c] = (n0 < scaled_cols) ? sc * cs_factor : sc;
    const int n = lane >> 2, kb = lane & 3; const float inv = 1.0f / __shfl(sc, n);
    for (int k0 = kw; k0 < kw + K / NWAVES_; k0 += 64) {
#pragma unroll
        for (int i = 0; i < 16; ++i) { const int kk = 4 * i + kq; scr[kk * 17 + c] = W[(size_t)(k0 + kk) * N + n0 + c]; }
        LDS_WAIT(); asm volatile("" ::: "memory");
        v4u o;
#pragma unroll
        for (int q = 0; q < 4; ++q) { unsigned w = 0;
#pragma unroll
            for (int j = 0; j < 4; ++j) { const int qv = __float2int_rn(scr[(16 * kb + 4 * q + j) * 17 + n] * inv); w |= ((unsigned)qv & 0xffu) << (8 * j); }
            o[q] = w; }
        *(v4u*)(WT8 + (size_t)(n0 + n) * K + k0 + 16 * kb) = o;
        LDS_WAIT(); asm volatile("" ::: "memory");
    }
    __syncthreads();
}
struct Args { const float* in[16]; float* out; unsigned char* ws; int ph_lo, ph_hi; };
constexpr int NPHASE = 2 + 7 * DEPTH;

__device__ __forceinline__ void phase_prologue_a(Frame& F, const Args& a, int lay_lo, int lay_hi, int rank, int nrank, bool with_gemv, int tr_shift = 0) {
    const int gw = rank * NWAVES + F.wave, NGW = nrank * NWAVES;
    LAS float* sil = (LAS float*)(F.lds + 69632);
    if (with_gemv) {
    for (int e = F.tid; e < BATCH * DM; e += NWAVES * 64) { const int b = e / DM, k = e % DM; const float cv = a.in[1][e]; sil[k * 4 + b] = cv / (1.0f + __expf(-cv)); }
    __syncthreads();
    constexpr int MCB = 192, NMCB = MODN / MCB;
    for (int task = gw; task < DEPTH * NMCB * KSPLIT; task += NGW) {
        const int l = task / (NMCB * KSPLIT), rem = task % (NMCB * KSPLIT), cb = rem / KSPLIT, kc = rem % KSPLIT;
        if (F.lane < MCB / 4) {
        const float* W = a.in[2] + (size_t)l * DM * MODN + (size_t)(kc * 256) * MODN + cb * MCB + 4 * F.lane;
        f32x4 acc0 = {0.f, 0.f, 0.f, 0.f}, acc1 = acc0, acc2 = acc0, acc3 = acc0;
        for (int k0 = 0; k0 < 256; k0 += 8) {
            f32x4 w[8];
#pragma unroll
            for (int j = 0; j < 8; ++j) w[j] = __builtin_nontemporal_load((const f32x4*)(W + (size_t)(k0 + j) * MODN));
#pragma unroll
            for (int j = 0; j < 8; ++j) { const f32x4 s = *(const LAS f32x4*)(sil + (kc * 256 + k0 + j) * 4); acc0 += w[j] * s[0]; acc1 += w[j] * s[1]; acc2 += w[j] * s[2]; acc3 += w[j] * s[3]; }
        }
        float* P = (float*)(a.ws + WS_PART) + ((size_t)(kc * DEPTH + l) * BATCH) * MODN + cb * MCB + 4 * F.lane;
        *(f32x4*)(P) = acc0; *(f32x4*)(P + MODN) = acc1; *(f32x4*)(P + 2 * MODN) = acc2; *(f32x4*)(P + 3 * MODN) = acc3;
        }
    }
    }
    LAS float* scr = (LAS float*)(F.lds + F.wave * 8704);
    constexpr int I_IN = (DM / 64) * (NMIX / 32), I_OUT = (DM / 64) * (DM / 32), I_2 = (FF / 64) * (DM / 32), I_LAYER = I_IN + I_OUT + I_2;
    for (int it = lay_lo * I_LAYER + (lay_lo ? tr_shift : 0) + gw; it < lay_hi * I_LAYER + (lay_hi < DEPTH ? tr_shift : 0); it += NGW) {
        const int l = it / I_LAYER; int r = it % I_LAYER; const int j = l >> 1;
        bf16* wl = (bf16*)(a.ws + WS_W + (size_t)l * W_LAYER);
        if (r < I_IN) { if (l & 1) p0_transpose_item<true>(a.in[8] + (size_t)j * DM * NMIX, DM, NMIX, (bf16*)((unsigned char*)wl + W_MIXIN), scr, r, F.lane); continue; }     r -= I_IN;
        if (r < I_OUT) { if (l & 1) p0_transpose_item(a.in[11] + (size_t)j * DM * DM, DM, DM, (bf16*)((unsigned char*)wl + W_MIXOUT), scr, r, F.lane); continue; }     r -= I_OUT;
        p0_transpose_item<false, true>(a.in[14] + (size_t)l * FF * DM, FF, DM, (bf16*)((unsigned char*)wl + W_W2), scr, r, F.lane, DM, W2_SCALE);
    }
    LAS float* red = (LAS float*)(F.lds + 102400);
    for (int it = rank; it < (DEPTH / 2) * (NMIX / 16); it += nrank) { const int ja = it / (NMIX / 16), r = it % (NMIX / 16); if (2 * ja < lay_lo || 2 * ja >= lay_hi) continue; unsigned char* wq = a.ws + WS_W + (size_t)(2 * ja) * W_LAYER + W_MIXIN;
        p0_w1_item(a.in[6] + (size_t)ja * DM * NMIX, DM, NMIX, (signed char*)wq, (float*)(wq + W_MIXIN_CS), scr, red, r, F.wave, F.lane, DM, QSCALE); }
    for (int it = rank; it < (DEPTH / 2) * (DM / 16); it += nrank) { const int ja = it / (DM / 16), r = it % (DM / 16); if (2 * ja < lay_lo || 2 * ja >= lay_hi) continue; unsigned char* wo = a.ws + WS_W + (size_t)(2 * ja) * W_LAYER + W_MIXOUT;
        p0_w1_item(a.in[7] + (size_t)ja * DM * DM, DM, DM, (signed char*)wo, (float*)(wo + W_MIXOUT_CS), scr, red, r, F.wave, F.lane); }
    for (int it = lay_lo * (FF / 16) + rank; it < lay_hi * (FF / 16); it += nrank) { const int l = it / (FF / 16), r = it % (FF / 16); unsigned char* w1 = a.ws + WS_W + (size_t)l * W_LAYER + W_W1;
        p0_w1_item(a.in[12] + (size_t)l * DM * FF, DM, FF, (signed char*)w1, (float*)(w1 + W_W1_CS), scr, red, r, F.wave, F.lane); }
}
typedef unsigned u32x2v __attribute__((ext_vector_type(2)));
__device__ __forceinline__ uint2 ld_nt_u2(const void* p) { const u32x2v v = __builtin_nontemporal_load((const u32x2v*)p); uint2 r; r.x = v[0]; r.y = v[1]; return r; }
__device__ __forceinline__ void st_nt_u2(void* p, const uint2 w) { const u32x2v v = {w.x, w.y}; __builtin_nontemporal_store(v, (u32x2v*)p); }
__device__ __forceinline__ uint2 q16_pack(const f32x4 v, float inv) {
    const int a = __float2int_rn(v[0] * inv), b = __float2int_rn(v[1] * inv), c = __float2int_rn(v[2] * inv), d = __float2int_rn(v[3] * inv);
    uint2 w; w.x = ((unsigned)a & 0xffffu) | ((unsigned)b << 16); w.y = ((unsigned)c & 0xffffu) | ((unsigned)d << 16); return w;
}
__device__ __forceinline__ f32x4 q16_unpack(const uint2 w, float sc) {
    const f32x4 v = {(float)((int)(w.x << 16) >> 16), (float)((int)w.x >> 16), (float)((int)(w.y << 16) >> 16), (float)((int)w.y >> 16)}; return v * sc;
}
__device__ __forceinline__ float wave_max(float v) {
    v = fmaxf(v, dpp_mov<0xB1, 0xF>(v, v)); v = fmaxf(v, dpp_mov<0x4E, 0xF>(v, v)); v = fmaxf(v, dpp_mov<0x141, 0xF>(v, v)); v = fmaxf(v, dpp_mov<0x140, 0xF>(v, v));
    v = fmaxf(v, dpp_mov<0x142, 0xA>(0.f, v)); v = fmaxf(v, dpp_mov<0x143, 0xC>(0.f, v));
    return __builtin_bit_cast(float, __builtin_amdgcn_readlane(__builtin_bit_cast(int, v), 63));
}
__device__ __forceinline__ void phase_prologue_b(Frame& F, const Args& a) {
    const float* part = (const float*)(a.ws + WS_PART); float* modtab = (float*)(a.ws + WS_MODTAB); const float* mod_b = a.in[3];
    for (int e = F.vcu * NWAVES * 64 + F.tid; e < DEPTH * BATCH * MODN; e += F.G * NWAVES * 64) {
        const int l = e / (BATCH * MODN), rem = e % (BATCH * MODN), b = rem / MODN, n = rem % MODN;
        float s = mod_b[l * MODN + n];
#pragma unroll
        for (int kc = 0; kc < KSPLIT; ++kc) s += part[((size_t)(kc * DEPTH + l) * BATCH + b) * MODN + n];
        if ((n / DM) % 3 != 0) s += 1.0f;
        modtab[e] = s;
    }
    const int rows_wg = M / F.G, row0 = F.vrow * rows_wg, b = row0 / SEQ;
    LAS float* ST = (LAS float*)(F.lds);
    for (int c = F.tid; c < 2 * DM; c += NWAVES * 64) {
        float s = mod_b[c];
#pragma unroll
        for (int kc = 0; kc < KSPLIT; ++kc) s += part[((size_t)(kc * DEPTH + 0) * BATCH + b) * MODN + c];
        ST[c] = (c >= DM) ? s + 1.0f : s;
    }
    __syncthreads();
    const int rows_wave = rows_wg / NWAVES;
    f32x4 Sv0[8], Tv0[8];
#pragma unroll
    for (int j = 0; j < 8; ++j) { Tv0[j] = *(const LAS f32x4*)(ST + 4 * F.lane + 256 * j); Sv0[j] = *(const LAS f32x4*)(ST + DM + 4 * F.lane + 256 * j); }
    f32x4 xn[8];
    { const float* x0 = a.in[0] + ((size_t)row0 + F.wave * rows_wave) * DM;
#pragma unroll
      for (int j = 0; j < 8; ++j) xn[j] = __builtin_nontemporal_load((const f32x4*)(x0 + 4 * F.lane + 256 * j)); }
    for (int r = 0; r < rows_wave; ++r) {
        const size_t row = (size_t)row0 + F.wave * rows_wave + r;
        const float* xr = a.in[0] + row * DM; short* qr = (short*)(a.ws + WS_X16) + row * DM; unsigned char* hr = a.ws + WS_H + row * DM;
        f32x4 v[8]; float mx = 0.f;
#pragma unroll
        for (int j = 0; j < 8; ++j) { v[j] = xn[j]; mx = fmaxf(fmaxf(mx, fmaxf(fabsf(v[j][0]), fabsf(v[j][1]))), fmaxf(fabsf(v[j][2]), fabsf(v[j][3]))); }
        if (r + 1 < rows_wave) {
#pragma unroll
            for (int j = 0; j < 8; ++j) xn[j] = __builtin_nontemporal_load((const f32x4*)(xr + DM + 4 * F.lane + 256 * j)); }
        mx = wave_max(mx); const float rs = mx > 0.f ? mx * (1.0f / 32767.0f) : 1.0f, inv = 1.0f / rs;
        if (F.lane == 0) ((float*)(a.ws + WS_ROWS))[row] = rs;
        f32x4 hv[8]; float mh = 0.f;
#pragma unroll
        for (int j = 0; j < 8; ++j) { const int col = 4 * F.lane + 256 * j;
            hv[j] = v[j] * Sv0[j] + Tv0[j];
            mh = fmaxf(fmaxf(mh, fmaxf(fabsf(hv[j][0]), fabsf(hv[j][1]))), fmaxf(fabsf(hv[j][2]), fabsf(hv[j][3])));
            st_nt_u2(qr + col, q16_pack(v[j], inv)); }
        mh = wave_max(mh); const float hs = mh > 0.f ? mh * (1.0f / 127.0f) : 1.0f, hinv = 1.0f / hs;
        if (F.lane == 0) ((float*)(a.ws + WS_ROWSH))[row] = hs;
        signed char* h8 = (signed char*)hr;
#pragma unroll
        for (int j = 0; j < 8; ++j) { const unsigned w = ((unsigned)__float2int_rn(hv[j][0] * hinv) & 0xffu) | (((unsigned)__float2int_rn(hv[j][1] * hinv) & 0xffu) << 8) | (((unsigned)__float2int_rn(hv[j][2] * hinv) & 0xffu) << 16) | ((unsigned)__float2int_rn(hv[j][3] * hinv) << 24);
            *(unsigned*)(h8 + 4 * F.lane + 256 * j) = w; }
    }
}
__device__ __forceinline__ void phase_ln(Frame& F, const Args& a, const bf16* Y, const float* lg, const float* lb, const float* Tn, const float* Sn, bool write_h, long xo_off = 0, long ho_off = 0, long qo_off = 0, bool h_int8 = false) {
    const int rows_wg = M / F.G, row0 = F.vrow * rows_wg, b = row0 / SEQ, rows_wave = rows_wg / NWAVES;
    LAS float* ST = (LAS float*)(F.lds);
    for (int c = F.tid; c < DM; c += NWAVES * 64) { ST[c] = Sn[(size_t)b * MODN + c]; ST[DM + c] = Tn[(size_t)b * MODN + c]; ST[2 * DM + c] = lg[c]; ST[3 * DM + c] = lb[c]; }
    __syncthreads();
    f32x4 Sv[8], Tv[8];
#pragma unroll
    for (int j = 0; j < 8; ++j) { Sv[j] = *(const LAS f32x4*)(ST + 4 * F.lane + 256 * j); Tv[j] = *(const LAS f32x4*)(ST + DM + 4 * F.lane + 256 * j); }
#define g4_(j) (*(const LAS f32x4*)(ST + 2 * DM + 4 * F.lane + 256 * (j)))
#define b4_(j) (*(const LAS f32x4*)(ST + 3 * DM + 4 * F.lane + 256 * (j)))
    uint2 yw[8], xw[8]; float rs_raw;
    { const size_t row = (size_t)row0 + F.wave * rows_wave; const bf16* yr = Y + row * DM; const short* qr = (const short*)(a.ws + WS_X16) + row * DM;
#pragma unroll
      for (int j = 0; j < 8; ++j) { yw[j] = ld_nt_u2((yr + 4 * F.lane + 256 * j)); xw[j] = ld_nt_u2((qr + 4 * F.lane + 256 * j)); }
      rs_raw = ((const float*)(a.ws + WS_ROWS))[row]; }
    for (int r = 0; r < rows_wave; ++r) {
        const size_t row = (size_t)row0 + F.wave * rows_wave + r;
        float* xr = a.out + row * DM; short* qr = (short*)(a.ws + WS_X16) + row * DM; bf16* hr = (bf16*)(a.ws + WS_H) + row * DM;
        float* rsp = (float*)(a.ws + WS_ROWS) + row; const float rs_in = rs_raw * DN_ALPHA;
        f32x4 v[8]; f32x4 sv = {0.f, 0.f, 0.f, 0.f};
#pragma unroll
        for (int j = 0; j < 8; ++j) { const f32x4 yv = {__uint_as_float(yw[j].x << 16), __uint_as_float(yw[j].x & 0xffff0000u), __uint_as_float(yw[j].y << 16), __uint_as_float(yw[j].y & 0xffff0000u)};
            v[j] = q16_unpack(xw[j], rs_in) + yv; sv += v[j]; }
        const float s = (sv[0] + sv[1]) + (sv[2] + sv[3]);
        if (r + 1 < rows_wave) { const bf16* yn = Y + (row + 1) * DM; const short* qn = (const short*)(a.ws + WS_X16) + (row + 1) * DM;
#pragma unroll
            for (int j = 0; j < 8; ++j) { yw[j] = ld_nt_u2((yn + 4 * F.lane + 256 * j)); xw[j] = ld_nt_u2((qn + 4 * F.lane + 256 * j)); }
            rs_raw = ((const float*)(a.ws + WS_ROWS))[row + 1]; }
        const float mean = wave_sum(s) * (1.0f / DM); f32x4 s2v = {0.f, 0.f, 0.f, 0.f};
#pragma unroll
        for (int j = 0; j < 8; ++j) { v[j] = v[j] - mean; s2v = __builtin_elementwise_fma(v[j], v[j], s2v); }
        const float s2 = (s2v[0] + s2v[1]) + (s2v[2] + s2v[3]);
        const float rstd = 1.0f / sqrtf(wave_sum(s2) * (1.0f / DM) + LN_EPS);
        if (!write_h) {
#pragma unroll
            for (int j = 0; j < 8; ++j) { const int col = 4 * F.lane + 256 * j; __builtin_nontemporal_store((v[j] * rstd) * g4_(j) + b4_(j), (f32x4*)(xr + xo_off + col)); }
        } else {
            float mx = 0.f;
            if (h_int8) {
                float mh = 0.f;
#pragma unroll
                for (int j = 0; j < 8; ++j) { v[j] = (v[j] * rstd) * g4_(j) + b4_(j); const f32x4 hv = v[j] * Sv[j] + Tv[j];
                    mx = fmaxf(fmaxf(mx, fmaxf(fabsf(v[j][0]), fabsf(v[j][1]))), fmaxf(fabsf(v[j][2]), fabsf(v[j][3])));
                    mh = fmaxf(fmaxf(mh, fmaxf(fabsf(hv[0]), fabsf(hv[1]))), fmaxf(fabsf(hv[2]), fabsf(hv[3]))); if (j & 1) asm volatile("" ::: "memory"); }
                mh = wave_max(mh); const float hs = mh > 0.f ? mh * (1.0f / 127.0f) : 1.0f, hinv = 1.0f / hs;
                if (F.lane == 0 && qo_off == 0) ((float*)(a.ws + WS_ROWSH))[row] = hs;
                signed char* h8 = (signed char*)(a.ws + WS_H) + row * DM + ho_off;
#pragma unroll
                for (int j = 0; j < 8; ++j) { const f32x4 hv = (v[j] * Sv[j] + Tv[j]) * hinv;
                    const unsigned w = ((unsigned)__float2int_rn(hv[0]) & 0xffu) | (((unsigned)__float2int_rn(hv[1]) & 0xffu) << 8) | (((unsigned)__float2int_rn(hv[2]) & 0xffu) << 16) | ((unsigned)__float2int_rn(hv[3]) << 24);
                    *(unsigned*)(h8 + 4 * F.lane + 256 * j) = w; if (j & 1) asm volatile("" ::: "memory"); }
            } else {
#pragma unroll
            for (int j = 0; j < 8; ++j) { v[j] = (v[j] * rstd) * g4_(j) + b4_(j); const f32x4 hv = v[j] * Sv[j] + Tv[j];
                mx = fmaxf(fmaxf(mx, fmaxf(fabsf(v[j][0]), fabsf(v[j][1]))), fmaxf(fabsf(v[j][2]), fabsf(v[j][3])));
                uint2 w; w.x = cvtpk_bf16(hv[0], hv[1]); w.y = cvtpk_bf16(hv[2], hv[3]); *(uint2*)(hr + ho_off + 4 * F.lane + 256 * j) = w; }
            }
            mx = wave_max(mx); const float rs = mx > 0.f ? mx * (1.0f / 32767.0f) : 1.0f, inv = 1.0f / rs;
            if (F.lane == 0 && qo_off == 0) *rsp = rs;
#pragma unroll
            for (int j = 0; j < 8; ++j) st_nt_u2(qr + qo_off + 4 * F.lane + 256 * j, q16_pack(v[j], inv));
        }
    }
}
#undef g4_
#undef b4_
__device__ __forceinline__ void bf8_to_f32(const bf16x8 v, float (&f)[8]) {
#pragma unroll
    for (int i = 0; i < 8; ++i) f[i] = __uint_as_float(((unsigned)(unsigned short)v[i]) << 16);
}
__device__ __forceinline__ void phase_conv(Frame& F, const Args& a, const float* cw, const float* cb, const bf16* Gg) {
    const bf16* Bg = (const bf16*)(a.ws + WS_Q); bf16* Out = (bf16*)(a.ws + WS_O);
    constexpr int TT = 8; const int rows_wg = M / F.G, ntask = (rows_wg / TT) * (DM / 8);
    for (int task = F.tid; task < ntask; task += NWAVES * 64) {
        const int chunk = task & (DM / 8 - 1), run = F.vrow * (rows_wg / TT) + task / (DM / 8), ch0 = chunk * 8, m0 = run * TT; const bool first = (m0 % SEQ) == 0;
        float w0[8], w1[8], w2[8], bb[8];
#pragma unroll
        for (int i = 0; i < 8; ++i) { w0[i] = cw[ch0 + i]; w1[i] = cw[DM + ch0 + i]; w2[i] = cw[2 * DM + ch0 + i]; bb[i] = cb[ch0 + i]; }
        float g2[8], g1[8];
        if (first) {
#pragma unroll
            for (int i = 0; i < 8; ++i) { g2[i] = 0.f; g1[i] = 0.f; }
        } else { bf8_to_f32(*(const bf16x8*)(Gg + (size_t)(m0 - 2) * DM + ch0), g2); bf8_to_f32(*(const bf16x8*)(Gg + (size_t)(m0 - 1) * DM + ch0), g1); }
        bf16x8 gr[TT], br[TT];
#pragma unroll
        for (int t = 0; t < TT; ++t) { gr[t] = __builtin_nontemporal_load((const bf16x8*)(Gg + (size_t)(m0 + t) * DM + ch0)); br[t] = __builtin_nontemporal_load((const bf16x8*)(Bg + (size_t)(m0 + t) * DM + ch0)); }
#pragma unroll
        for (int t = 0; t < TT; ++t) {
            float bg[8], g0[8], y[8];
            bf8_to_f32(gr[t], g0); bf8_to_f32(br[t], bg);
#pragma unroll
            for (int i = 0; i < 8; ++i) { y[i] = bg[i] * (w0[i] * g2[i] + w1[i] * g1[i] + w2[i] * g0[i] + bb[i]); g2[i] = g1[i]; g1[i] = g0[i]; }
            v4u o; o.x = cvtpk_bf16(y[0], y[1]); o.y = cvtpk_bf16(y[2], y[3]); o.z = cvtpk_bf16(y[4], y[5]); o.w = cvtpk_bf16(y[6], y[7]);
            *(v4u*)(Out + (size_t)(m0 + t) * DM + ch0) = o;
        }
    }
}

#ifndef MK_MF32
#define MK_MF32 0
#endif
#ifndef MK_STAGGER_US
#define MK_STAGGER_US 60
#endif
#ifndef MK_DUP
#define MK_DUP 0
#endif
#define NREP(bit) ((MK_DUP & (bit)) ? 2 : 1)
#ifndef MK_DIS
#define MK_DIS 0
#endif
__global__ void __launch_bounds__(NWAVES * 64, 2) mk_fwd(Args args) {
    extern __shared__ __attribute__((aligned(16))) unsigned char lds[];
    Frame F;
    F.lds = (LAS unsigned char*)lds;
    volatile LAS unsigned* MISC = (volatile LAS unsigned*)(F.lds + MISC_OFF);
    F.tid = threadIdx.x; F.lane = F.tid & 63; F.wave = __builtin_amdgcn_readfirstlane(F.tid >> 6);
    F.G = gridDim.x; { const int bx = blockIdx.x; F.vcu = (F.G % 8 == 0) ? (bx % 8) * (F.G / 8) + bx / 8 : bx; }
    unsigned char* ws = args.ws;
    const bool grp_mode = (F.G == 256);
    { const int bx = blockIdx.x, pm_ = 8 * (bx % 8) + (bx / 8) % 8; F.vrow = grp_mode ? 4 * pm_ + bx / 64 : F.vcu; }
    unsigned* grp_mask = (unsigned*)(ws + WS_CTL) + CW_GMASK + 64 * ((F.vrow >> 2) & 63);
    if (threadIdx.x == 0) (void)__hip_atomic_fetch_or(grp_mask, 1u << xb_xcc_id(), __ATOMIC_RELAXED, __HIP_MEMORY_SCOPE_AGENT);
    unsigned* grp_cnt = (unsigned*)(ws + WS_CTL) + CW_GRP + 64 * ((F.vrow >> 2) & 63);
    for (int u = F.tid; u < (LDS_BYTES - LDSCTL_OFF) / 4; u += NWAVES * 64) ((LAS unsigned*)(F.lds + LDSCTL_OFF))[u] = 0u;
    __syncthreads();
    XcdBarrier bar = xcd_barrier_post((unsigned*)(ws + WS_CTL) + CW_BAR, MISC + 8);
    const int lo = args.ph_lo, hi = args.ph_hi;
#define FRESH() do { int t_ = threadIdx.x; asm volatile("" : "+v"(t_)); F.tid = t_; F.lane = t_ & 63; F.wave = __builtin_amdgcn_readfirstlane(t_ >> 6); } while (0)
#define IN(k) (lo <= (k) && (k) < hi)
#define SEAM(k) do { if ((k) + 1 < hi) { xcd_barrier(bar); if (MK_DUP & 8192) xcd_barrier(bar); } } while (0)
#define CSEAM(k) do { if ((k) + 1 < hi) { if (grp_mode) { const int pm_ = F.vrow >> 2; unsigned* c0_ = (unsigned*)(ws + WS_CTL) + CW_GRP; unsigned* m0_ = (unsigned*)(ws + WS_CTL) + CW_GMASK; \
        grp_barrier(grp_cnt, grp_mask, MISC + 10, bar.bar, (pm_ % (SEQ / 256)) ? c0_ + 64 * (pm_ - 1) : nullptr, ((pm_ + 1) % (SEQ / 256)) ? m0_ + 64 * (pm_ + 1) : nullptr); } else xcd_barrier(bar); } } while (0)
#define ASEAM(k) do { if ((k) + 1 < hi) { if (grp_mode) { const int pm_ = F.vrow >> 2, f_ = pm_ - pm_ % (SEQ / 256); \
        prefix_barrier((unsigned*)(ws + WS_CTL) + CW_GRP, (unsigned*)(ws + WS_CTL) + CW_GMASK, pm_, f_, f_ + SEQ / 256 - 1, MISC + 10, bar.bar); } else xcd_barrier(bar); } } while (0)
#define GSEAM(k) do { if ((k) + 1 < hi) { if (grp_mode) grp_barrier(grp_cnt, grp_mask, MISC + 10, bar.bar); else xcd_barrier(bar); } } while (0)
    float* modtab = (float*)(ws + WS_MODTAB);
    const long scr_off = MK_DUP ? (long)((float*)(ws + WS_SCR) - args.out) : 0, hscr_off = MK_DUP ? (long)((bf16*)(ws + WS_SCR) - (bf16*)(ws + WS_H)) : 0, qscr_off = MK_DUP ? (long)((short*)(ws + WS_SCR + 64 * MiB) - (short*)(ws + WS_X16)) : 0;
    bf16* Hb = (bf16*)(ws + WS_H); bf16* Qb = (bf16*)(ws + WS_Q); bf16* Ob = (bf16*)(ws + WS_O); bf16* HIDb = (bf16*)(ws + WS_HID); bf16* Yb = (bf16*)(ws + WS_Y);

    if (IN(0)) {
#if !(MK_DIS & 1)
        for (int rep = 0; rep < NREP(1); ++rep) { FRESH(); phase_prologue_a(F, args, 0, grp_mode ? DEPTH - 1 : DEPTH, F.vcu, F.G, true, (DM / 64) * (NMIX / 32)); }
#endif
        SEAM(0); }
    if (IN(1)) {
#if !(MK_DIS & 2)
        for (int rep = 0; rep < NREP(2); ++rep) { FRESH(); phase_prologue_b(F, args); }
#endif
        SEAM(1);
        if (grp_mode && (F.vrow >> 2) >= (M / 256) / 2) {
            FRESH(); phase_prologue_a(F, args, DEPTH - 1, DEPTH, F.vrow - (M / 256) * 2, (M / 256) * 2, false, (DM / 64) * (NMIX / 32));
            asm volatile("s_waitcnt vmcnt(0)" ::: "memory"); __syncthreads();
            if (threadIdx.x == 0) { __builtin_amdgcn_fence(__ATOMIC_RELEASE, "agent"); asm volatile("s_waitcnt vmcnt(0)" ::: "memory"); (void)xb_add((unsigned*)(ws + WS_CTL) + CW_A1, 1u); }
        }
        }
    for (int l = 0; l < DEPTH; ++l) {
        const int pb = 2 + 7 * l, j = l >> 1; const bool is_conv = (l & 1) != 0;
        if (grp_mode && l == DEPTH - 1 && IN(pb + 0)) {
            if (threadIdx.x == 0) { unsigned* w_ = (unsigned*)(ws + WS_CTL) + CW_A1; XB_SPIN(xb_ld(w_) < (unsigned)((M / 256) * 2), bar.bar); __builtin_amdgcn_fence(__ATOMIC_ACQUIRE, "agent"); asm volatile("s_waitcnt vmcnt(0)" ::: "memory"); }
            __syncthreads(); }
        bf16* Gb = (bf16*)(ws + ((j & 1) ? WS_G2 : WS_G));
        bf16* Kb = (bf16*)(ws + ((j & 1) ? WS_K2 : WS_K)); bf16* Vb = (bf16*)(ws + ((j & 1) ? WS_V2 : WS_V));
        const unsigned char* wl = ws + WS_W + (size_t)l * W_LAYER;
        const float* mt = modtab + (size_t)l * BATCH * MODN;
        if (IN(pb + 0)) {
            pg8::Gemm g{Hb, (const bf16*)(wl + W_MIXIN), M, NMIX, DM}; pg8::StaticOrder S; S.init(M, NMIX, F.G, (int)blockIdx.x);
            if (is_conv) {
                pg8::EpiConvIn E{Gb, Qb, DM, DM / 128};
#if !(MK_DIS & 4)
                for (int rep = 0; rep < NREP(4); ++rep) pg8::gemm_phase<pg8::EpiConvIn, pg8::StaticOrder, true, true>(F.lds + RING_OFF, g, S, E);
#endif
            } else {
                pg8::EpiI8Bf16Split E{Qb, DM, (const float*)(ws + WS_ROWSH), (const float*)(wl + W_MIXIN + W_MIXIN_CS), DM, Kb, Vb, (unsigned*)(ws + WS_CTL) + CW_VMAX + 64 * j};
#if !(MK_DIS & 4)
                for (int rep = 0; rep < NREP(4); ++rep) pg8::gemm_phase<pg8::EpiI8Bf16Split, pg8::StaticOrder, true, true, 0, 1, true>(F.lds + RING_OFF, g, S, E);
#endif
#if (MK_DUP & 1024)
                { pg8::EpiNull EN; pg8::gemm_phase<pg8::EpiNull, pg8::StaticOrder, true, true, 0, 1, true>(F.lds + RING_OFF, g, S, EN); }
#endif
#if (MK_DUP & 262144)
                { pg8::EpiNull EN; pg8::gemm_phase<pg8::EpiNull, pg8::StaticOrder, true, true, 3>(F.lds + RING_OFF, g, S, EN); }
#endif
#if (MK_DUP & 524288)
                { pg8::EpiNull EN; pg8::gemm_phase<pg8::EpiNull, pg8::StaticOrder, true, true, 4>(F.lds + RING_OFF, g, S, EN); }
#endif
            }
            if (is_conv) CSEAM(pb + 0); else ASEAM(pb + 0);
        }
        if (IN(pb + 1)) {
            if (is_conv) {

#if !(MK_DIS & 16)
                for (int rep = 0; rep < NREP(16); ++rep) { FRESH(); phase_conv(F, args, args.in[9] + (size_t)j * 3 * DM, args.in[10] + (size_t)j * DM, Gb); }
#endif

            } else {

#if !(MK_DIS & 8)
                const int nunits = BATCH * NH * (SEQ / sba::UNIT_ROWS);
                unsigned* vmaxw = (unsigned*)(ws + WS_CTL) + CW_VMAX + 64 * j;
                for (int rep = 0; rep < NREP(8); ++rep) {
                    if (grp_mode) {
                        const int pm_ = F.vrow >> 2, j_ = F.vrow & 3; const float osc = pg8::o_scale_panels(vmaxw, pm_ - pm_ % (SEQ / 256), pm_);
                        for (int i = 0; i < NH / 4; ++i) sba::attn_unit(pm_ / (SEQ / sba::UNIT_ROWS), 4 * j_ + i, pm_ % (SEQ / sba::UNIT_ROWS), Qb, Kb, Vb, (signed char*)Ob, 1.0f / osc, (LAS char*)(F.lds + RING_OFF));
                    } else for (int u = F.vcu; u < nunits; u += F.G) { const int bh = u / (SEQ / sba::UNIT_ROWS), qb = u % (SEQ / sba::UNIT_ROWS);
                        const int pmu = (bh / NH) * (SEQ / 256) + qb; const float osc = pg8::o_scale_panels(vmaxw, pmu - qb, pmu); sba::attn_unit(bh / NH, bh % NH, qb, Qb, Kb, Vb, (signed char*)Ob, 1.0f / osc, (LAS char*)(F.lds + RING_OFF)); } }
#endif

            }
            GSEAM(pb + 1);
        }
        if (IN(pb + 2)) {
            pg8::Gemm g{Ob, (const bf16*)(wl + W_MIXOUT), M, DM, DM}; pg8::StaticOrder S; S.init(M, DM, F.G, (int)blockIdx.x);
#if !(MK_DIS & 32)
            if (is_conv) {
                pg8::EpiGateBf16<false> E{Yb, DM, nullptr, mt + 2 * DM, MODN, SEQ, 1.0f};
                for (int rep = 0; rep < NREP(32); ++rep) pg8::gemm_phase<pg8::EpiGateBf16<false>, pg8::StaticOrder, true, true>(F.lds + RING_OFF, g, S, E);
            } else {
                pg8::EpiI8GateBf16 E{Yb, DM, mt + 2 * DM, MODN, SEQ, (const float*)(wl + W_MIXOUT + W_MIXOUT_CS), (unsigned*)(ws + WS_CTL) + CW_VMAX + 64 * j};
                for (int rep = 0; rep < NREP(32); ++rep) pg8::gemm_phase<pg8::EpiI8GateBf16, pg8::StaticOrder, true, true, 0, 1, true>(F.lds + RING_OFF, g, S, E);
            }
            GSEAM(pb + 2);
#endif

        }
        if (IN(pb + 3)) {
#if !(MK_DIS & 64)
            for (int rep = 0; rep < NREP(64); ++rep) { const bool x_ = rep + 1 < NREP(64); FRESH(); phase_ln(F, args, Yb, args.in[4] + (size_t)(l * 2 + 0) * DM, args.in[5] + (size_t)(l * 2 + 0) * DM, mt + 3 * DM, mt + 4 * DM, true, x_ ? scr_off : 0, x_ ? hscr_off : 0, x_ ? qscr_off : 0, true); }
#endif
            GSEAM(pb + 3); }
        if (IN(pb + 4)) {
            pg8::Gemm g{Hb, (const bf16*)(wl + W_W1), M, FF, DM}; pg8::StaticOrder S; S.init(M, FF, F.G, (int)blockIdx.x);
            pg8::EpiI8Fp8Relu2 E{(unsigned char*)HIDb, FF, args.in[13] + (size_t)l * FF, (const float*)(ws + WS_ROWSH), (const float*)(wl + W_W1 + W_W1_CS), HID_SCALE};
#if !(MK_DIS & 128)
            for (int rep = 0; rep < NREP(128); ++rep) pg8::gemm_phase<pg8::EpiI8Fp8Relu2, pg8::StaticOrder, true, true, 0, 1, true>(F.lds + RING_OFF, g, S, E);
#endif

            GSEAM(pb + 4);
        }
        if (IN(pb + 5)) {
            pg8::Gemm g{HIDb, (const bf16*)(wl + W_W2), M, DM, FF}; pg8::StaticOrder S; S.init(M, DM, F.G, (int)blockIdx.x);
            pg8::EpiGateBf16<true, true> E{Yb, DM, args.in[15] + (size_t)l * DM, mt + 5 * DM, MODN, SEQ, 1.0f / (HID_SCALE * W2_SCALE)};
#if !(MK_DIS & 256)
#if (MK_DUP & 2048)
            { pg8::EpiNull EN; pg8::gemm_phase<pg8::EpiNull, pg8::StaticOrder, true, true, 0, 1>(F.lds + RING_OFF, g, S, EN); }
#endif
            for (int rep = 0; rep < NREP(256); ++rep) pg8::gemm_phase<pg8::EpiGateBf16<true, true>, pg8::StaticOrder, true, true, 0, 1>(F.lds + RING_OFF, g, S, E);
            GSEAM(pb + 5);
#endif

        }
        if (IN(pb + 6)) { const int nl = (l + 1 < DEPTH) ? l + 1 : l; const float* mtn = modtab + (size_t)nl * BATCH * MODN;

#if !(MK_DIS & 512)
            for (int rep = 0; rep < NREP(512); ++rep) { const bool x_ = rep + 1 < NREP(512); FRESH(); phase_ln(F, args, Yb, args.in[4] + (size_t)(l * 2 + 1) * DM, args.in[5] + (size_t)(l * 2 + 1) * DM, mtn + 0 * DM, mtn + 1 * DM, l + 1 < DEPTH, x_ ? scr_off : 0, x_ ? hscr_off : 0, x_ ? qscr_off : 0, ((l + 1) & 1) == 0); }
#endif
            GSEAM(pb + 6); }
    }
#undef IN
#undef SEAM
#undef GSEAM
#undef ASEAM
#undef CSEAM
}

extern "C" void kernel_launch(void* const* d_in, const int* in_sizes, int n_in, void* d_out, int out_size, void* d_ws, size_t ws_size, hipStream_t stream) {
    static int grid = 0;
    if (grid == 0) {
        if (n_in != 16 || in_sizes[0] != M * DM || out_size != M * DM || ws_size < WS_NEED + (MK_DUP ? 128 * MiB : 0)) { fprintf(stderr, "kernel_launch: unexpected shapes (n_in %d, in0 %d, out %d, ws %zu); nothing launched\n", n_in, n_in > 0 ? in_sizes[0] : -1, out_size, ws_size); grid = -1; return; }
        int dev = 0, cus = 0, per_cu = 0;
        if (hipGetDevice(&dev) != hipSuccess || hipDeviceGetAttribute(&cus, hipDeviceAttributeMultiprocessorCount, dev) != hipSuccess) { fprintf(stderr, "kernel_launch: device query failed\n"); grid = -1; return; }
        if (hipFuncSetAttribute((const void*)mk_fwd, hipFuncAttributeMaxDynamicSharedMemorySize, LDS_BYTES) != hipSuccess) { fprintf(stderr, "kernel_launch: hipFuncSetAttribute failed\n"); grid = -1; return; }
        if (hipOccupancyMaxActiveBlocksPerMultiprocessor(&per_cu, (const void*)mk_fwd, NWAVES * 64, LDS_BYTES) != hipSuccess || per_cu < 1) { fprintf(stderr, "kernel_launch: occupancy query reports %d workgroups per CU\n", per_cu); }
        (void)hipGetLastError();
        grid = cus;
        if (grid > 256) grid = 256;
        if (grid != 256 && grid != 128 && grid != 64) { fprintf(stderr, "kernel_launch: %d CUs: this kernel deals rows in M/grid blocks and needs 64, 128 or 256 workgroups; nothing launched\n", grid); grid = -1; return; }
    }
    if (grid < 0) return;
    if (hipMemsetAsync((char*)d_ws + WS_CTL, 0, CTL_ZERO_BYTES, stream) != hipSuccess) { fprintf(stderr, "kernel_launch: memset failed\n"); return; }
    Args a{};
    for (int i = 0; i < 16; ++i) a.in[i] = (const float*)d_in[i];
    a.out = (float*)d_out; a.ws = (unsigned char*)d_ws;
    a.ph_lo = 0; a.ph_hi = NPHASE;
    hipLaunchKernelGGL(mk_fwd, dim3(grid), dim3(NWAVES * 64), LDS_BYTES, stream, a);
    const hipError_t le = hipPeekAtLastError();
    if (le != hipSuccess) fprintf(stderr, "kernel_launch: launch failed: %s\n", hipGetErrorName(le));
}
```

```cpp
#include <hip/hip_runtime.h>
#include <hip/hip_bf16.h>
#include <cstdio>
#include <cstdint>
namespace pg8 {
#define PG8_LAS __attribute__((address_space(3)))
typedef unsigned short bf16_t;
typedef short bf16x8 __attribute__((ext_vector_type(8)));
typedef float f32x4 __attribute__((ext_vector_type(4)));
typedef unsigned u32x4 __attribute__((ext_vector_type(4)));
constexpr int BM = 256, BK = 64, HALF = 128, HTB = HALF * BK * 2  , STAGE_BYTES = 8 * HTB, NXCD = 8, WGM = 8;

__host__ __device__ __forceinline__ int lds_byte(int r, int c) { const int st = (r >> 4) * 2 + (c >> 5), rr = r & 15, cc = c & 31, ob = rr * 64 + cc * 2; return st * 1024 + (ob ^ (((ob >> 9) & 1) << 5)); }
__host__ __device__ __forceinline__ void stage_rc(int b, int& R, int& C) { const int st = b / 1024, sb = b % 1024, swz = sb ^ (((sb >> 9) & 1) << 5); R = (st >> 1) * 16 + swz / 64; C = (st & 1) * 32 + (swz % 64) / 2; }
__host__ __device__ __forceinline__ int perm32(int rho) { const int n = rho >> 4, i = rho & 15; return 8 * (i >> 2) + 4 * n + (i & 3); }

typedef float f32x16 __attribute__((ext_vector_type(16)));
__host__ __device__ __forceinline__ int lds_byte2(int r, int c) { const int rb = r >> 4, rr = r & 15, h = c >> 5, ch = (c & 31) >> 3; return (rb * 2 + h) * 1024 + rr * 64 + ((ch ^ ((rr >> 2) & 3)) << 4) + (c & 7) * 2; }
__host__ __device__ __forceinline__ void stage_rc2(int b, int& R, int& C) { const int p = b / 1024, l = (b % 1024) / 16, rr = l >> 2, cs = l & 3, ch = cs ^ ((rr >> 2) & 3); R = (p >> 1) * 16 + rr; C = (p & 1) * 32 + ch * 8; }
__host__ __device__ __forceinline__ int perm32b(int rho) { return (rho & 3) | (((rho >> 3) & 1) << 2) | (((rho >> 2) & 1) << 3) | (rho & 16); }

__host__ __device__ __forceinline__ int adj16_row(int bj, int R) { return 64 * (R >> 5) + 16 * ((R & 15) >> 2) + 8 * bj + 4 * ((R >> 4) & 1) + (R & 3); }
typedef int i32x8 __attribute__((ext_vector_type(8)));
typedef int i32x4 __attribute__((ext_vector_type(4)));
__device__ __forceinline__ i32x8 frag32(bf16x8 lo, bf16x8 hi) { const i32x4 a = __builtin_bit_cast(i32x4, lo), b = __builtin_bit_cast(i32x4, hi); return __builtin_shufflevector(a, b, 0, 1, 2, 3, 4, 5, 6, 7); }
__device__ __forceinline__ void mfma_fp8_tied(f32x4& acc, const i32x8 a, const i32x8 b, const int scl) {
    asm volatile("v_mfma_scale_f32_16x16x128_f8f6f4 %0, %1, %2, %0, %3, %3 op_sel_hi:[0,0,0]" : "+v"(acc) : "v"(a), "v"(b), "v"(scl));
}
struct Unit { int pm, pn; };
struct Gemm { const bf16_t* A; const bf16_t* Bt; int M, N, K; };

struct StaticOrder {
    int nM, nN, nwg, G, c;
    __host__ __device__ void init(int M, int N, int G_, int c_) { nM = M / BM; nN = N / BM; nwg = nM * nN; G = G_; c = c_; }
    __host__ __device__ bool next(int i, Unit& u) const {
        const long L = (long)i * G + c; if (L >= nwg) return false;
        int wgid = (int)L; { const int q = nwg / NXCD, r = nwg % NXCD, xcd = wgid % NXCD, off = wgid / NXCD; wgid = (xcd < r ? xcd * (q + 1) : r * (q + 1) + (xcd - r) * q) + off; }
        const int nig = WGM * nN, gid = wgid / nig, fm = gid * WGM, gsz = (nM - fm) < WGM ? (nM - fm) : WGM;
        u.pm = fm + ((wgid % nig) % gsz); u.pn = (wgid % nig) / gsz; return true;
    }
    __device__ __forceinline__ void a_ready(const Unit&) const {}
    __device__ __forceinline__ void done(const Unit&) const {}
};

__device__ __forceinline__ unsigned cvt_pk_bf16(float lo, float hi) { unsigned r; asm volatile("v_cvt_pk_bf16_f32 %0, %1, %2" : "=v"(r) : "v"(lo), "v"(hi)); return r; }
typedef float f32x2 __attribute__((ext_vector_type(2)));
#ifndef MK_WT
#define MK_WT 0
#endif
__device__ __forceinline__ void store16_wt(void* p, u32x4 v) {
#if MK_WT
    asm volatile("global_store_dwordx4 %0, %1, off sc1" :: "v"(p), "v"(v) : "memory");
#else
    *(u32x4*)p = v;
#endif
}

template <int ACT, bool HAS_BIAS> struct EpiBf16 {
    static constexpr bool PERM = true, AFTER_DRAIN = false; static constexpr int BPERM = 1; static_assert(ACT == 0 || ACT == 3, "EpiBf16: ACT is 0 (none) or 3 (squared relu)");
    int row_mask;
    bf16_t* O; int ldc; const float* bias; int split_cols; size_t split_stride;
    __device__ __forceinline__ void operator()(const f32x4 (&acc)[2][2][4][2], const Unit& u, int wr, int wc, int fr, int fq) const {
        const int row0 = (u.pm * BM + wr * 64 + fr) & row_mask; int colt = u.pn * BM; bf16_t* base = O;
        if (split_cols) { const int t = colt / split_cols; base += (size_t)t * split_stride; colt -= t * split_cols; }
        const int col0 = colt + wc * 32 + 8 * fq, bcol0 = u.pn * BM + wc * 32 + 8 * fq;
        f32x4 bv[2][2];
        if constexpr (HAS_BIAS) { int bcolv = bcol0; asm volatile("" : "+v"(bcolv));
#pragma unroll
            for (int bj = 0; bj < 2; ++bj)
#pragma unroll
                for (int n = 0; n < 2; ++n) bv[bj][n] = *(const f32x4*)(bias + bcolv + bj * HALF + 4 * n);
        }
#pragma unroll
        for (int ai = 0; ai < 2; ++ai)
#pragma unroll
            for (int m = 0; m < 4; ++m) { bf16_t* rowp = base + (size_t)(row0 + ai * HALF + m * 16) * ldc + col0;
#pragma unroll
                for (int bj = 0; bj < 2; ++bj) { f32x4 v0 = acc[ai][bj][m][0], v1 = acc[ai][bj][m][1];
                    if constexpr (HAS_BIAS) { v0 = v0 + bv[bj][0]; v1 = v1 + bv[bj][1]; }
                    if (ACT == 3) {
#pragma unroll
                        for (int j = 0; j < 4; ++j) { const float a = fmaxf(v0[j], 0.f), b = fmaxf(v1[j], 0.f); v0[j] = a * a; v1[j] = b * b; } }
                    u32x4 w; w.x = cvt_pk_bf16(v0[0], v0[1]); w.y = cvt_pk_bf16(v0[2], v0[3]); w.z = cvt_pk_bf16(v1[0], v1[1]); w.w = cvt_pk_bf16(v1[2], v1[3]);
                    store16_wt(rowp + bj * HALF, w); } }
    }
};
struct EpiResid {
    static constexpr bool PERM = false, AFTER_DRAIN = false; static constexpr int BPERM = 0;
    float* X; int ldc; const float* bias; const float* gate; int gate_bstride; int rows_per_batch; float alpha; long out_off;
    __device__ __forceinline__ void operator()(const f32x4 (&acc)[2][2][4][2], const Unit& u, int wr, int wc, int fr, int fq) const {
        const int row0 = u.pm * BM + wr * 64 + fr, col0 = u.pn * BM + wc * 32 + 4 * fq;
        const float* gp = gate + (size_t)((u.pm * BM) / rows_per_batch) * gate_bstride;
        f32x4 bv[2][2], gv[2][2];
#pragma unroll
        for (int bj = 0; bj < 2; ++bj)
#pragma unroll
            for (int n = 0; n < 2; ++n) { bv[bj][n] = bias ? *(const f32x4*)(bias + col0 + bj * HALF + n * 16) : (f32x4){0.f, 0.f, 0.f, 0.f}; gv[bj][n] = *(const f32x4*)(gp + col0 + bj * HALF + n * 16); }
#pragma unroll
        for (int ai = 0; ai < 2; ++ai)
#pragma unroll
            for (int m = 0; m < 4; ++m) { float* rowp = X + (size_t)(row0 + ai * HALF + m * 16) * ldc + col0;
#pragma unroll
                for (int bj = 0; bj < 2; ++bj)
#pragma unroll
                    for (int n = 0; n < 2; ++n) { const f32x4 xo = *(const f32x4*)(rowp + bj * HALF + n * 16); *(f32x4*)(rowp + out_off + bj * HALF + n * 16) = xo * alpha + gv[bj][n] * (acc[ai][bj][m][n] + bv[bj][n]); }
                if (m & 1) asm volatile("" ::: "memory"); }
    }
};


template <bool HAS_BIAS, bool SCALED = false> struct EpiGateBf16 {
    static constexpr bool PERM = true, AFTER_DRAIN = false; static constexpr int BPERM = 1;
    bf16_t* O; int ldc; const float* bias; const float* gate; int gate_bstride; int rows_per_batch; float ascale;
    __device__ __forceinline__ void operator()(const f32x4 (&acc)[2][2][4][2], const Unit& u, int wr, int wc, int fr, int fq) const {
        const int row0 = u.pm * BM + wr * 64 + fr, col0 = u.pn * BM + wc * 32 + 8 * fq;
        const float* gp = gate + (size_t)((u.pm * BM) / rows_per_batch) * gate_bstride;
        int colv = col0; asm volatile("" : "+v"(colv));
        f32x4 bv[2][2], gv[2][2];
#pragma unroll
        for (int bj = 0; bj < 2; ++bj)
#pragma unroll
            for (int n = 0; n < 2; ++n) { if constexpr (HAS_BIAS) bv[bj][n] = *(const f32x4*)(bias + colv + bj * HALF + 4 * n); gv[bj][n] = *(const f32x4*)(gp + colv + bj * HALF + 4 * n); }
#pragma unroll
        for (int ai = 0; ai < 2; ++ai)
#pragma unroll
            for (int m = 0; m < 4; ++m) { bf16_t* rowp = O + (size_t)(row0 + ai * HALF + m * 16) * ldc + col0;
#pragma unroll
                for (int bj = 0; bj < 2; ++bj) { f32x4 v0 = acc[ai][bj][m][0], v1 = acc[ai][bj][m][1]; if constexpr (SCALED) { v0 = v0 * ascale; v1 = v1 * ascale; } if constexpr (HAS_BIAS) { v0 = v0 + bv[bj][0]; v1 = v1 + bv[bj][1]; } v0 = v0 * gv[bj][0]; v1 = v1 * gv[bj][1];
                    u32x4 w; w.x = cvt_pk_bf16(v0[0], v0[1]); w.y = cvt_pk_bf16(v0[2], v0[3]); w.z = cvt_pk_bf16(v1[0], v1[1]); w.w = cvt_pk_bf16(v1[2], v1[3]);
                    store16_wt(rowp + bj * HALF, w); } }
    }
};

struct EpiConvIn {
    static constexpr bool PERM = true, AFTER_DRAIN = false; static constexpr int BPERM = 1;
    bf16_t* Gt; bf16_t* Bg; int ldc; int CT;
    __device__ __forceinline__ void operator()(const f32x4 (&acc)[2][2][4][2], const Unit& u, int wr, int wc, int fr, int fq) const {
        const int row0 = u.pm * BM + wr * 64 + fr;
        if (u.pn < CT) {
            const int col0 = u.pn * HALF + wc * 32 + 8 * fq;
#pragma unroll
            for (int ai = 0; ai < 2; ++ai)
#pragma unroll
                for (int m = 0; m < 4; ++m) { const f32x4 v0 = acc[ai][0][m][0] * acc[ai][1][m][0], v1 = acc[ai][0][m][1] * acc[ai][1][m][1];
                    u32x4 w; w.x = cvt_pk_bf16(v0[0], v0[1]); w.y = cvt_pk_bf16(v0[2], v0[3]); w.z = cvt_pk_bf16(v1[0], v1[1]); w.w = cvt_pk_bf16(v1[2], v1[3]);
                    store16_wt(Gt + (size_t)(row0 + ai * HALF + m * 16) * ldc + col0, w); }
        } else {
            const int col0 = (u.pn - CT) * BM + wc * 32 + 8 * fq;
#pragma unroll
            for (int ai = 0; ai < 2; ++ai)
#pragma unroll
                for (int m = 0; m < 4; ++m) { bf16_t* rowp = Bg + (size_t)(row0 + ai * HALF + m * 16) * ldc + col0;
#pragma unroll
                    for (int bj = 0; bj < 2; ++bj) { const f32x4 v0 = acc[ai][bj][m][0], v1 = acc[ai][bj][m][1];
                        u32x4 w; w.x = cvt_pk_bf16(v0[0], v0[1]); w.y = cvt_pk_bf16(v0[2], v0[3]); w.z = cvt_pk_bf16(v1[0], v1[1]); w.w = cvt_pk_bf16(v1[2], v1[3]);
                        store16_wt(rowp + bj * HALF, w); } }
        }
    }
};

struct EpiFp8Relu2 {
    static constexpr bool PERM = true, AFTER_DRAIN = false; static constexpr int BPERM = 2;
    unsigned char* O8; int ldc; const float* bias; float oscale;
    __device__ __forceinline__ void operator()(const f32x4 (&acc)[2][2][4][2], const Unit& u, int wr, int wc, int fr, int fq) const {
        const int row0 = u.pm * BM + wr * 64 + fr, col0 = u.pn * BM + wc * 64 + 16 * fq;
        int colv = col0; asm volatile("" : "+v"(colv));
        f32x4 bv[2][2];
#pragma unroll
        for (int bj = 0; bj < 2; ++bj)
#pragma unroll
            for (int n = 0; n < 2; ++n) bv[bj][n] = *(const f32x4*)(bias + colv + 8 * bj + 4 * n);
#pragma unroll
        for (int ai = 0; ai < 2; ++ai)
#pragma unroll
            for (int m = 0; m < 4; ++m) { u32x4 w;
#pragma unroll
                for (int bj = 0; bj < 2; ++bj)
#pragma unroll
                    for (int n = 0; n < 2; ++n) { f32x4 v = acc[ai][bj][m][n] + bv[bj][n];
#pragma unroll
                        for (int j = 0; j < 4; ++j) { const float a = fmaxf(v[j], 0.f); v[j] = fminf(a * a * oscale, 448.0f); }
                        int p = 0; p = __builtin_amdgcn_cvt_pk_fp8_f32(v[0], v[1], p, false); p = __builtin_amdgcn_cvt_pk_fp8_f32(v[2], v[3], p, true); w[2 * bj + n] = (unsigned)p; }
                *(u32x4*)(O8 + (size_t)(row0 + ai * HALF + m * 16) * ldc + col0) = w; }
    }
};

struct EpiI8Fp8Relu2 {
    static constexpr bool PERM = true, AFTER_DRAIN = false; static constexpr int BPERM = 2;
    unsigned char* O8; int ldc; const float* bias; const float* rowscale; const float* colscale; float oscale;
    __device__ __forceinline__ void operator()(const f32x4 (&acc)[2][2][4][2], const Unit& u, int wr, int wc, int fr, int fq) const {
        const int row0 = u.pm * BM + wr * 64 + fr, col0 = u.pn * BM + wc * 64 + 16 * fq;
        int colv = col0; asm volatile("" : "+v"(colv));
        const float sq = sqrtf(oscale);
        f32x4 bv[2][2], cv[2][2];
#pragma unroll
        for (int bj = 0; bj < 2; ++bj)
#pragma unroll
            for (int n = 0; n < 2; ++n) { bv[bj][n] = *(const f32x4*)(bias + colv + 8 * bj + 4 * n); cv[bj][n] = *(const f32x4*)(colscale + colv + 8 * bj + 4 * n); }
        float rsv[2][4];
#pragma unroll
        for (int ai = 0; ai < 2; ++ai)
#pragma unroll
            for (int m = 0; m < 4; ++m) rsv[ai][m] = rowscale[row0 + ai * HALF + m * 16];
        __builtin_amdgcn_sched_barrier(0);
#pragma unroll
        for (int bj = 0; bj < 2; ++bj)
#pragma unroll
            for (int n = 0; n < 2; ++n) { bv[bj][n] = bv[bj][n] * sq; cv[bj][n] = cv[bj][n] * sq; }
#pragma unroll
        for (int ai = 0; ai < 2; ++ai)
#pragma unroll
            for (int m = 0; m < 4; ++m) { const int row = row0 + ai * HALF + m * 16; const float rs = rsv[ai][m]; u32x4 w;
#pragma unroll
                for (int bj = 0; bj < 2; ++bj)
#pragma unroll
                    for (int n = 0; n < 2; ++n) { const i32x4 ia = __builtin_bit_cast(i32x4, acc[ai][bj][m][n]); const f32x4 rc = cv[bj][n] * rs;
                        f32x4 a = __builtin_elementwise_fma(__builtin_convertvector(ia, f32x4), rc, bv[bj][n]);
#pragma unroll
                        for (int j = 0; j < 4; ++j) a[j] = __builtin_amdgcn_fmed3f(a[j], 0.f, 21.166010f);
                        const f32x4 v = a * a;
                        int p = 0; p = __builtin_amdgcn_cvt_pk_fp8_f32(v[0], v[1], p, false); p = __builtin_amdgcn_cvt_pk_fp8_f32(v[2], v[3], p, true); w[2 * bj + n] = (unsigned)p; }
                *(u32x4*)(O8 + (size_t)row * ldc + col0) = w; }
    }
};

struct EpiI8Bf16Split {
    static constexpr bool PERM = true, AFTER_DRAIN = false; static constexpr int BPERM = 1;
    bf16_t* O; int ldc; const float* rowscale; const float* colscale; int split_cols; bf16_t* O1; bf16_t* O2; unsigned* vmax;
    __device__ __forceinline__ void operator()(const f32x4 (&acc)[2][2][4][2], const Unit& u, int wr, int wc, int fr, int fq) const {
        const int row0 = u.pm * BM + wr * 64 + fr; int colt = u.pn * BM; bf16_t* base = O;
        const int t = colt / split_cols; base = (t == 0) ? O : (t == 1) ? O1 : O2; colt -= t * split_cols; f32x4 vm4 = {0.f, 0.f, 0.f, 0.f};
        const int col0 = colt + wc * 32 + 8 * fq; int ccol = u.pn * BM + wc * 32 + 8 * fq; asm volatile("" : "+v"(ccol));
        f32x4 cv[2][2];
#pragma unroll
        for (int bj = 0; bj < 2; ++bj)
#pragma unroll
            for (int n = 0; n < 2; ++n) cv[bj][n] = *(const f32x4*)(colscale + ccol + bj * HALF + 4 * n);
        float rsv[2][4];
#pragma unroll
        for (int ai = 0; ai < 2; ++ai)
#pragma unroll
            for (int m = 0; m < 4; ++m) rsv[ai][m] = rowscale[row0 + ai * HALF + m * 16];
        __builtin_amdgcn_sched_barrier(0);
#pragma unroll
        for (int ai = 0; ai < 2; ++ai)
#pragma unroll
            for (int m = 0; m < 4; ++m) { const int row = row0 + ai * HALF + m * 16; const float rs = rsv[ai][m]; const size_t rowo = (size_t)row * ldc + col0;
#pragma unroll
                for (int bj = 0; bj < 2; ++bj) { const i32x4 i0 = __builtin_bit_cast(i32x4, acc[ai][bj][m][0]), i1 = __builtin_bit_cast(i32x4, acc[ai][bj][m][1]);
                    const f32x4 v0 = __builtin_convertvector(i0, f32x4) * (cv[bj][0] * rs), v1 = __builtin_convertvector(i1, f32x4) * (cv[bj][1] * rs);
                    if (t == 2) {
#pragma unroll
                        for (int j = 0; j < 4; ++j) vm4[j] = fmaxf(vm4[j], fmaxf(fabsf(v0[j]), fabsf(v1[j]))); }
                    u32x4 w; w.x = cvt_pk_bf16(v0[0], v0[1]); w.y = cvt_pk_bf16(v0[2], v0[3]); w.z = cvt_pk_bf16(v1[0], v1[1]); w.w = cvt_pk_bf16(v1[2], v1[3]);
                    *(u32x4*)(base + rowo + bj * HALF) = w; } }
        if (t == 2) { float vm = fmaxf(fmaxf(vm4[0], vm4[1]), fmaxf(vm4[2], vm4[3]));
#pragma unroll
            for (int o = 1; o < 64; o <<= 1) vm = fmaxf(vm, __shfl_xor(vm, o));
            if ((fr | fq) == 0) __hip_atomic_fetch_max(vmax + u.pm, __float_as_uint(vm), __ATOMIC_RELAXED, __HIP_MEMORY_SCOPE_AGENT); }
    }
};

__device__ __forceinline__ float o_scale_panels(unsigned* w, int first, int pm) {
    float t[16];
#pragma unroll
    for (int i = 0; i < 16; ++i) t[i] = __uint_as_float(__hip_atomic_load(w + first + i, __ATOMIC_RELAXED, __HIP_MEMORY_SCOPE_AGENT));
    float vm = 0.f;
#pragma unroll
    for (int i = 0; i < 16; ++i) vm = fmaxf(vm, (first + i <= pm) ? t[i] : 0.f);
    return vm > 0.f ? vm * (1.01f / 127.0f) : 1.0f;
}
struct EpiI8GateBf16 {
    static constexpr bool PERM = true, AFTER_DRAIN = false; static constexpr int BPERM = 1;
    bf16_t* O; int ldc; const float* gate; int gate_bstride; int rows_per_batch; const float* colscale; unsigned* vmax;
    __device__ __forceinline__ void operator()(const f32x4 (&acc)[2][2][4][2], const Unit& u, int wr, int wc, int fr, int fq) const {
        const int row0 = u.pm * BM + wr * 64 + fr, col0 = u.pn * BM + wc * 32 + 8 * fq;
        const float* gp = gate + (size_t)((u.pm * BM) / rows_per_batch) * gate_bstride;
        const float rs = o_scale_panels(vmax, u.pm - u.pm % (rows_per_batch / BM), u.pm);
        int colv = col0; asm volatile("" : "+v"(colv));
        f32x4 gv[2][2];
#pragma unroll
        for (int bj = 0; bj < 2; ++bj)
#pragma unroll
            for (int n = 0; n < 2; ++n) gv[bj][n] = *(const f32x4*)(gp + colv + bj * HALF + 4 * n) * *(const f32x4*)(colscale + colv + bj * HALF + 4 * n) * rs;
#pragma unroll
        for (int ai = 0; ai < 2; ++ai)
#pragma unroll
            for (int m = 0; m < 4; ++m) { bf16_t* rowp = O + (size_t)(row0 + ai * HALF + m * 16) * ldc + col0;
#pragma unroll
                for (int bj = 0; bj < 2; ++bj) { const i32x4 i0 = __builtin_bit_cast(i32x4, acc[ai][bj][m][0]), i1 = __builtin_bit_cast(i32x4, acc[ai][bj][m][1]);
                    const f32x4 v0 = __builtin_convertvector(i0, f32x4) * gv[bj][0], v1 = __builtin_convertvector(i1, f32x4) * gv[bj][1];
                    u32x4 w; w.x = cvt_pk_bf16(v0[0], v0[1]); w.y = cvt_pk_bf16(v0[2], v0[3]); w.z = cvt_pk_bf16(v1[0], v1[1]); w.w = cvt_pk_bf16(v1[2], v1[3]);
                    *(u32x4*)(rowp + bj * HALF) = w; } }
    }
};

struct EpiNull { static constexpr bool PERM = false, AFTER_DRAIN = false; static constexpr int BPERM = 0;
    __device__ __forceinline__ void operator()(const f32x4 (&acc)[2][2][4][2], const Unit& u, int wr, int wc, int fr, int fq) const {
#pragma unroll
        for (int ai = 0; ai < 2; ++ai)
#pragma unroll
            for (int m = 0; m < 4; ++m) asm volatile("" :: "v"(acc[ai][0][m][0]), "v"(acc[ai][0][m][1]), "v"(acc[ai][1][m][0]), "v"(acc[ai][1][m][1])); }
};

struct FixedOrder { int n;
    __device__ __forceinline__ bool next(int i, Unit& u) const { if (i >= n) return false; u.pm = 0; u.pn = 0; return true; }
    __device__ __forceinline__ void a_ready(const Unit&) const {}
    __device__ __forceinline__ void done(const Unit&) const {}
};
template <class Epi, class Sched, bool ALIGN_EPI = false, bool SP2 = false, int SKEL = 0, int ES = 2  , bool I8 = false    >
__device__ __forceinline__ void gemm_phase(PG8_LAS unsigned char* lds, const Gemm g, const Sched& S, const Epi& E) {
    typedef double f64x2v __attribute__((ext_vector_type(2)));
    int tid_ = threadIdx.x; asm volatile("" : "+v"(tid_));
    const int tid = tid_, wid = __builtin_amdgcn_readfirstlane(tid >> 6), lane = tid & 63, wr = wid >> 2, wc = wid & 3, fr = lane & 15, fq = lane >> 4;
    const int K = g.K, KB = K * ES  , nt = KB / (BK * 2);
    unsigned voffA[2], voffB[2], voffB1[2];
#pragma unroll
    for (int i = 0; i < 2; ++i) { int R, C; stage_rc(tid * 16 + i * 8192, R, C);
        voffA[i] = (unsigned)(R * KB + C * 2);
        if constexpr (Epi::BPERM == 2) { voffB[i] = (unsigned)(adj16_row(0, R) * KB + C * 2); voffB1[i] = (unsigned)(adj16_row(1, R) * KB + C * 2); }
        else { const int Rb = Epi::PERM ? ((R & ~31) + perm32(R & 31)) : R; voffB[i] = (unsigned)(Rb * KB + C * 2); voffB1[i] = voffB[i]; } }
    const unsigned bh1 = (Epi::BPERM == 2) ? 0u : (unsigned)HALF * (unsigned)KB;
    const unsigned kstep = (unsigned)(BK * 2);
    const unsigned hstep = (unsigned)HALF * (unsigned)KB;
    const unsigned tstep = 2u * hstep;
    const unsigned ldsw = (unsigned)wid * 1024u;
    const int aoff = lds_byte(wr * 64 + fr, fq * 8), boff = lds_byte(wc * 32 + fr, fq * 8);
#define PG8_SA(b, h) (((b) * 2 + (h)) * HTB)
#define PG8_SB(b, h) ((4 + (b) * 2 + (h)) * HTB)
#define PG8_STAGE_R(rsrc, bufoff, soff, voff) do { if constexpr (SKEL != 2 && SKEL != 3) { _Pragma("unroll") for (int _i = 0; _i < 2; ++_i) \
        __builtin_amdgcn_raw_ptr_buffer_load_lds(rsrc, (PG8_LAS void*)(lds + (bufoff) + ldsw + _i * 8192), 16, (int)(voff)[_i], (int)(soff), 0, 0); } } while (0)
#define PG8_LDA(dst, b, h) do { if constexpr (SKEL != 2 && SKEL != 4) { _Pragma("unroll") for (int m = 0; m < 4; ++m) _Pragma("unroll") for (int k = 0; k < 2; ++k) dst[m][k] = *(const PG8_LAS bf16x8*)(lds + PG8_SA(b, h) + aoff + m * 2048 + k * 1024); } } while (0)
#define PG8_LDB(dst, b, h) do { if constexpr (SKEL != 2 && SKEL != 4) { _Pragma("unroll") for (int n = 0; n < 2; ++n) _Pragma("unroll") for (int k = 0; k < 2; ++k) dst[n][k] = *(const PG8_LAS bf16x8*)(lds + PG8_SB(b, h) + boff + n * 2048 + k * 1024); } } while (0)
#define PG8_MMA(ai, bj, At, Bt) do { __builtin_amdgcn_s_setprio(1); if constexpr (ES == 2) { _Pragma("unroll") for (int m = 0; m < 4; ++m) _Pragma("unroll") for (int n = 0; n < 2; ++n) _Pragma("unroll") for (int k = 0; k < 2; ++k) \
        { if constexpr (SKEL != 1) acc[ai][bj][m][n] = __builtin_amdgcn_mfma_f32_16x16x32_bf16(Bt[n][k], At[m][k], acc[ai][bj][m][n], 0, 0, 0); else asm volatile("" :: "v"(Bt[n][k]), "v"(At[m][k])); } } \
      else if constexpr (I8) { _Pragma("unroll") for (int m = 0; m < 4; ++m) _Pragma("unroll") for (int n = 0; n < 2; ++n) _Pragma("unroll") for (int k = 0; k < 2; ++k) \
        acc[ai][bj][m][n] = __builtin_bit_cast(f32x4, __builtin_amdgcn_mfma_i32_16x16x64_i8(__builtin_bit_cast(i32x4, Bt[n][k]), __builtin_bit_cast(i32x4, At[m][k]), __builtin_bit_cast(i32x4, acc[ai][bj][m][n]), 0, 0, 0)); } \
      else { _Pragma("unroll") for (int m = 0; m < 4; ++m) _Pragma("unroll") for (int n = 0; n < 2; ++n) \
        mfma_fp8_tied(acc[ai][bj][m][n], frag32(Bt[n][0], Bt[n][1]), frag32(At[m][0], At[m][1]), scl1); } \
      __builtin_amdgcn_s_setprio(0); } while (0)
#define PG8_WAIT_V(n) asm volatile("s_waitcnt vmcnt(" #n ")" ::: "memory")
#define PG8_WAIT_L(n) asm volatile("s_waitcnt lgkmcnt(" #n ")" ::: "memory")
#define PG8_BAR __builtin_amdgcn_s_barrier()
#define PG8_SCHED __builtin_amdgcn_sched_barrier(0)
    int scl1 = 0x7F7F7F7F; if constexpr (ES == 1 && !I8) asm volatile("" : "+v"(scl1));
    Unit cur, nxt; int ui = 0;
    if (!S.next(0, cur)) return;
    f32x4 acc[2][2][4][2];
#pragma unroll
    for (int a = 0; a < 2; ++a)
#pragma unroll
        for (int b = 0; b < 2; ++b)
#pragma unroll
            for (int m = 0; m < 4; ++m)
#pragma unroll
                for (int n = 0; n < 2; ++n) acc[a][b][m][n] = (f32x4){0.f, 0.f, 0.f, 0.f};
    bf16x8 At[4][2], B0[2][2], B1[2][2];
    if constexpr (SKEL == 2 || SKEL == 4) {
#pragma unroll
        for (int m = 0; m < 4; ++m)
#pragma unroll
            for (int k = 0; k < 2; ++k) asm volatile("" : "=v"(At[m][k]));
#pragma unroll
        for (int n = 0; n < 2; ++n)
#pragma unroll
            for (int k = 0; k < 2; ++k) { asm volatile("" : "=v"(B0[n][k])); asm volatile("" : "=v"(B1[n][k])); } }
    unsigned cA = (unsigned)cur.pm * tstep, cB = (unsigned)cur.pn * tstep;
    const __amdgpu_buffer_rsrc_t rsA = __builtin_amdgcn_make_buffer_rsrc((void*)g.A, 0, (int)((unsigned)g.M * (unsigned)KB), 0x00020000), rsB = __builtin_amdgcn_make_buffer_rsrc((void*)g.Bt, 0, (int)((unsigned)g.N * (unsigned)KB), 0x00020000);
    __builtin_amdgcn_s_waitcnt(0x0F70);
    S.a_ready(cur);
    if constexpr (SP2) {
        PG8_STAGE_R(rsB, PG8_SB(0, 0), cB, voffB); PG8_STAGE_R(rsB, PG8_SB(0, 1), cB + bh1, voffB1); PG8_STAGE_R(rsA, PG8_SA(0, 0), cA, voffA); PG8_STAGE_R(rsA, PG8_SA(0, 1), cA + hstep, voffA);
        if (wr == 1) PG8_BAR;
        PG8_WAIT_V(2); PG8_BAR;
        PG8_STAGE_R(rsB, PG8_SB(1, 0), cB + kstep, voffB); PG8_STAGE_R(rsA, PG8_SA(1, 0), cA + kstep, voffA); PG8_STAGE_R(rsB, PG8_SB(1, 1), cB + bh1 + kstep, voffB1);
        PG8_WAIT_V(6); PG8_BAR;
    } else {
        PG8_STAGE_R(rsB, PG8_SB(0, 0), cB, voffB); PG8_STAGE_R(rsA, PG8_SA(0, 0), cA, voffA); PG8_STAGE_R(rsB, PG8_SB(0, 1), cB + bh1, voffB1); PG8_STAGE_R(rsA, PG8_SA(0, 1), cA + hstep, voffA);
        if (wr == 1) PG8_BAR;
        PG8_WAIT_V(4); PG8_BAR;
        PG8_STAGE_R(rsB, PG8_SB(1, 0), cB + kstep, voffB); PG8_STAGE_R(rsA, PG8_SA(1, 0), cA + kstep, voffA); PG8_STAGE_R(rsB, PG8_SB(1, 1), cB + bh1 + kstep, voffB1);
        PG8_WAIT_V(6); PG8_BAR;
    }
    for (;;) {
        const bool has_next = S.next(ui + 1, nxt);
        const unsigned nA = has_next ? (unsigned)nxt.pm * tstep : cA, nB = has_next ? (unsigned)nxt.pn * tstep : cB;
        for (int t = 0; t < nt; t += 2) {
            const bool last = (t == nt - 2);
            const unsigned a1 = cA + (unsigned)(t + 1) * kstep;
            const unsigned a2 = last ? nA : cA + (unsigned)(t + 2) * kstep, b2 = last ? nB : cB + (unsigned)(t + 2) * kstep;
            const unsigned a3 = a2 + kstep, b3 = b2 + kstep;
            if (last && has_next) S.a_ready(nxt);
            if constexpr (SP2) {
            PG8_LDB(B0, 0, 0); PG8_LDB(B1, 0, 1); PG8_SCHED; PG8_LDA(At, 0, 0); PG8_STAGE_R(rsA, PG8_SA(1, 1), a1 + hstep, voffA);
            PG8_WAIT_V(8); PG8_WAIT_L(0); PG8_BAR; PG8_MMA(0, 0, At, B0); PG8_MMA(0, 1, At, B1); PG8_BAR; PG8_SCHED;
            PG8_LDA(At, 0, 1); PG8_STAGE_R(rsB, PG8_SB(0, 0), b2, voffB); PG8_STAGE_R(rsB, PG8_SB(0, 1), b2 + bh1, voffB1); PG8_STAGE_R(rsA, PG8_SA(0, 0), a2, voffA);
            PG8_WAIT_V(8); PG8_WAIT_L(0); PG8_BAR; PG8_MMA(1, 0, At, B0); PG8_MMA(1, 1, At, B1); PG8_BAR; PG8_SCHED;
            PG8_LDB(B0, 1, 0); PG8_LDB(B1, 1, 1); PG8_SCHED; PG8_LDA(At, 1, 0); PG8_STAGE_R(rsA, PG8_SA(0, 1), a2 + hstep, voffA);
            PG8_WAIT_V(8); PG8_WAIT_L(0); PG8_BAR; PG8_MMA(0, 0, At, B0); PG8_MMA(0, 1, At, B1); PG8_BAR; PG8_SCHED;
            PG8_LDA(At, 1, 1); PG8_STAGE_R(rsB, PG8_SB(1, 0), b3, voffB); PG8_STAGE_R(rsB, PG8_SB(1, 1), b3 + bh1, voffB1); PG8_STAGE_R(rsA, PG8_SA(1, 0), a3, voffA);
            PG8_WAIT_V(8); PG8_WAIT_L(0); PG8_BAR; PG8_MMA(1, 0, At, B0); PG8_MMA(1, 1, At, B1); PG8_BAR; PG8_SCHED;
            } else {
            PG8_LDB(B0, 0, 0); PG8_SCHED; PG8_LDA(At, 0, 0); PG8_STAGE_R(rsA, PG8_SA(1, 1), a1 + hstep, voffA);
            PG8_WAIT_L(8); PG8_BAR; PG8_WAIT_L(0); PG8_MMA(0, 0, At, B0); PG8_BAR; PG8_SCHED;
            PG8_LDB(B1, 0, 1); PG8_STAGE_R(rsB, PG8_SB(0, 0), b2, voffB);
            PG8_BAR; PG8_WAIT_L(0); PG8_MMA(0, 1, At, B1); PG8_BAR;
            PG8_LDA(At, 0, 1); PG8_STAGE_R(rsA, PG8_SA(0, 0), a2, voffA);
            PG8_BAR; PG8_WAIT_L(0); PG8_MMA(1, 0, At, B0); PG8_BAR; PG8_SCHED;
            PG8_STAGE_R(rsB, PG8_SB(0, 1), b2 + bh1, voffB1);
            PG8_WAIT_V(6); PG8_BAR; PG8_MMA(1, 1, At, B1); PG8_BAR;
            PG8_LDB(B0, 1, 0); PG8_SCHED; PG8_LDA(At, 1, 0); PG8_STAGE_R(rsA, PG8_SA(0, 1), a2 + hstep, voffA);
            PG8_WAIT_L(8); PG8_BAR; PG8_WAIT_L(0); PG8_MMA(0, 0, At, B0); PG8_BAR; PG8_SCHED;
            PG8_LDB(B1, 1, 1); PG8_STAGE_R(rsB, PG8_SB(1, 0), b3, voffB);
            PG8_BAR; PG8_WAIT_L(0); PG8_MMA(0, 1, At, B1); PG8_BAR;
            PG8_LDA(At, 1, 1); PG8_STAGE_R(rsA, PG8_SA(1, 0), a3, voffA);
            PG8_BAR; PG8_WAIT_L(0); PG8_MMA(1, 0, At, B0); PG8_BAR; PG8_SCHED;
            PG8_STAGE_R(rsB, PG8_SB(1, 1), b3 + bh1, voffB1);
            PG8_WAIT_V(6); PG8_BAR; PG8_MMA(1, 1, At, B1); PG8_BAR;
            }
        }
        if constexpr (ALIGN_EPI) { if (wr == 0) PG8_BAR; }
        if constexpr (ES == 1 && !I8) asm volatile("s_nop 15\n\ts_nop 15" ::: "memory");
        if constexpr (!Epi::AFTER_DRAIN) { E(acc, cur, wr, wc, fr, fq); S.done(cur); }
        if (!has_next) break;
#pragma unroll
        for (int a = 0; a < 2; ++a)
#pragma unroll
            for (int b = 0; b < 2; ++b)
#pragma unroll
                for (int m = 0; m < 4; ++m)
#pragma unroll
                    for (int n = 0; n < 2; ++n) { double z0, z1; asm volatile("v_mov_b64 %0, 0\n\tv_mov_b64 %1, 0" : "=v"(z0), "=v"(z1)); const f64x2v zz = {z0, z1}; acc[a][b][m][n] = __builtin_bit_cast(f32x4, zz); }
        cur = nxt; cA = nA; cB = nB; ++ui;
        if constexpr (ALIGN_EPI) { if (wr == 1) PG8_BAR; }
    }
    PG8_WAIT_V(0);
    if constexpr (!ALIGN_EPI) { if (wr == 0) PG8_BAR; }
    PG8_BAR;
    if constexpr (Epi::AFTER_DRAIN) { E.fused(acc, cur, wr, wc, fr, fq, lds, wid, lane); S.done(cur); }
#undef PG8_SA
#undef PG8_SB
#undef PG8_STAGE_R
#undef PG8_LDA
#undef PG8_LDB
#undef PG8_MMA
#undef PG8_WAIT_V
#undef PG8_WAIT_L
#undef PG8_BAR
#undef PG8_SCHED
}


template <int ACT, bool HAS_BIAS> struct Epi32Bf16 {
    static constexpr bool PERM = true, AFTER_DRAIN = false; static_assert(ACT == 0 || ACT == 3, "Epi32Bf16: ACT is 0 (none) or 3 (squared relu)");
    bf16_t* O; int ldc; const float* bias; int split_cols; size_t split_stride;
    __device__ __forceinline__ void operator()(const f32x16 (&acc)[2][2][2], const Unit& u, int wr, int wc, int r32, int hi) const {
        const int row0 = u.pm * BM + wr * 64 + r32; int colt = u.pn * BM; bf16_t* base = O;
        if (split_cols) { const int t = colt / split_cols; base += (size_t)t * split_stride; colt -= t * split_cols; }
        const int col0 = colt + wc * 32 + 8 * hi, bcol0 = u.pn * BM + wc * 32 + 8 * hi;
        f32x4 bv[2][4];
        if constexpr (HAS_BIAS) {
#pragma unroll
            for (int bj = 0; bj < 2; ++bj)
#pragma unroll
                for (int q = 0; q < 4; ++q) bv[bj][q] = *(const f32x4*)(bias + bcol0 + bj * HALF + (q >> 1) * 16 + (q & 1) * 4);
        }
#pragma unroll
        for (int ai = 0; ai < 2; ++ai)
#pragma unroll
            for (int mb = 0; mb < 2; ++mb) { bf16_t* rowp = base + (size_t)(row0 + ai * HALF + mb * 32) * ldc + col0;
#pragma unroll
                for (int bj = 0; bj < 2; ++bj)
#pragma unroll
                    for (int t = 0; t < 2; ++t) { float v[8];
#pragma unroll
                        for (int j = 0; j < 8; ++j) { v[j] = acc[ai][bj][mb][8 * t + j]; if constexpr (HAS_BIAS) v[j] += bv[bj][2 * t + (j >> 2)][j & 3]; if (ACT == 3) { const float a = fmaxf(v[j], 0.f); v[j] = a * a; } }
                        u32x4 w; w.x = cvt_pk_bf16(v[0], v[1]); w.y = cvt_pk_bf16(v[2], v[3]); w.z = cvt_pk_bf16(v[4], v[5]); w.w = cvt_pk_bf16(v[6], v[7]);
                        store16_wt(rowp + bj * HALF + 16 * t, w); } }
    }
};
template <bool HAS_BIAS> struct Epi32GateBf16 {
    static constexpr bool PERM = true, AFTER_DRAIN = false;
    bf16_t* O; int ldc; const float* bias; const float* gate; int gate_bstride; int rows_per_batch;
    __device__ __forceinline__ void operator()(const f32x16 (&acc)[2][2][2], const Unit& u, int wr, int wc, int r32, int hi) const {
        const int row0 = u.pm * BM + wr * 64 + r32, col0 = u.pn * BM + wc * 32 + 8 * hi;
        const float* gp = gate + (size_t)((u.pm * BM) / rows_per_batch) * gate_bstride;
        f32x4 bv[2][4], gv[2][4];
#pragma unroll
        for (int bj = 0; bj < 2; ++bj)
#pragma unroll
            for (int q = 0; q < 4; ++q) { const int c = col0 + bj * HALF + (q >> 1) * 16 + (q & 1) * 4; if constexpr (HAS_BIAS) bv[bj][q] = *(const f32x4*)(bias + c); gv[bj][q] = *(const f32x4*)(gp + c); }
#pragma unroll
        for (int ai = 0; ai < 2; ++ai)
#pragma unroll
            for (int mb = 0; mb < 2; ++mb) { bf16_t* rowp = O + (size_t)(row0 + ai * HALF + mb * 32) * ldc + col0;
#pragma unroll
                for (int bj = 0; bj < 2; ++bj)
#pragma unroll
                    for (int t = 0; t < 2; ++t) { float v[8];
#pragma unroll
                        for (int j = 0; j < 8; ++j) { v[j] = acc[ai][bj][mb][8 * t + j]; if constexpr (HAS_BIAS) v[j] += bv[bj][2 * t + (j >> 2)][j & 3]; v[j] *= gv[bj][2 * t + (j >> 2)][j & 3]; }
                        u32x4 w; w.x = cvt_pk_bf16(v[0], v[1]); w.y = cvt_pk_bf16(v[2], v[3]); w.z = cvt_pk_bf16(v[4], v[5]); w.w = cvt_pk_bf16(v[6], v[7]);
                        store16_wt(rowp + bj * HALF + 16 * t, w); } }
    }
};
struct Epi32Null { static constexpr bool PERM = true, AFTER_DRAIN = false;
    __device__ __forceinline__ void operator()(const f32x16 (&acc)[2][2][2], const Unit& u, int wr, int wc, int r32, int hi) const {
#pragma unroll
        for (int ai = 0; ai < 2; ++ai)
#pragma unroll
            for (int bj = 0; bj < 2; ++bj) asm volatile("" :: "v"(acc[ai][bj][0]), "v"(acc[ai][bj][1])); }
};
template <class Epi, class Sched, bool ALIGN_EPI = false, bool SP2 = false, int SKEL = 0  >
__device__ __forceinline__ void gemm_phase32(PG8_LAS unsigned char* lds, const Gemm g, const Sched& S, const Epi& E) {
    int tid_ = threadIdx.x; asm volatile("" : "+v"(tid_));
    const int tid = tid_, wid = __builtin_amdgcn_readfirstlane(tid >> 6), lane = tid & 63, wr = wid >> 2, wc = wid & 3, r32 = lane & 31, hi = lane >> 5;
    const int K = g.K, nt = K / BK;
    unsigned voffA[2], voffB[2];
#pragma unroll
    for (int i = 0; i < 2; ++i) { int R, C; stage_rc2(tid * 16 + i * 8192, R, C); const int Rb = (R & ~31) + perm32b(R & 31);
        voffA[i] = (unsigned)(R * K + C) * 2u; voffB[i] = (unsigned)(Rb * K + C) * 2u; }
    const unsigned kstep = (unsigned)(BK * 2);
    const unsigned hstep = (unsigned)HALF * (unsigned)K * 2u;
    const unsigned tstep = 2u * hstep;
    const unsigned ldsw = (unsigned)wid * 1024u;
    const int aoff0 = lds_byte2(wr * 64 + r32, hi * 8), boff0 = lds_byte2(wc * 32 + r32, hi * 8); const int aoffs[2] = {aoff0, aoff0 ^ 32}, boffs[2] = {boff0, boff0 ^ 32};
#define PG8_SA(b, h) (((b) * 2 + (h)) * HTB)
#define PG8_SB(b, h) ((4 + (b) * 2 + (h)) * HTB)
#define PG8_STAGE_R(rsrc, bufoff, soff, voff) do { if constexpr (SKEL != 2) { _Pragma("unroll") for (int _i = 0; _i < 2; ++_i) \
        __builtin_amdgcn_raw_ptr_buffer_load_lds(rsrc, (PG8_LAS void*)(lds + (bufoff) + ldsw + _i * 8192), 16, (int)(voff)[_i], (int)(soff), 0, 0); } } while (0)
#define PG8_LDA(dst, b, h) do { if constexpr (SKEL != 2) { _Pragma("unroll") for (int m = 0; m < 2; ++m) _Pragma("unroll") for (int k = 0; k < 4; ++k) dst[m][k] = *(const PG8_LAS bf16x8*)(lds + PG8_SA(b, h) + aoffs[k & 1] + m * 4096 + (k >> 1) * 1024); } } while (0)
#define PG8_LDB(dst, b, h) do { if constexpr (SKEL != 2) { _Pragma("unroll") for (int k = 0; k < 4; ++k) dst[k] = *(const PG8_LAS bf16x8*)(lds + PG8_SB(b, h) + boffs[k & 1] + (k >> 1) * 1024); } } while (0)
#define PG8_MMA(ai, bj, At, Bt) do { __builtin_amdgcn_s_setprio(1); _Pragma("unroll") for (int k = 0; k < 4; ++k) _Pragma("unroll") for (int m = 0; m < 2; ++m) \
        { if constexpr (SKEL != 1) acc[ai][bj][m] = __builtin_amdgcn_mfma_f32_32x32x16_bf16(Bt[k], At[m][k], acc[ai][bj][m], 0, 0, 0); else asm volatile("" :: "v"(Bt[k]), "v"(At[m][k])); } __builtin_amdgcn_s_setprio(0); } while (0)
#define PG8_WAIT_V(n) asm volatile("s_waitcnt vmcnt(" #n ")" ::: "memory")
#define PG8_WAIT_L(n) asm volatile("s_waitcnt lgkmcnt(" #n ")" ::: "memory")
#define PG8_BAR __builtin_amdgcn_s_barrier()
#define PG8_SCHED __builtin_amdgcn_sched_barrier(0)
    Unit cur, nxt; int ui = 0;
    if (!S.next(0, cur)) return;
    f32x16 acc[2][2][2];
#pragma unroll
    for (int a = 0; a < 2; ++a)
#pragma unroll
        for (int b = 0; b < 2; ++b)
#pragma unroll
            for (int m = 0; m < 2; ++m) acc[a][b][m] = f32x16{};
    bf16x8 At[2][4], B0[4], B1[4];
    if constexpr (SKEL == 2) {
#pragma unroll
        for (int m = 0; m < 2; ++m)
#pragma unroll
            for (int k = 0; k < 4; ++k) asm volatile("" : "=v"(At[m][k]));
#pragma unroll
        for (int k = 0; k < 4; ++k) { asm volatile("" : "=v"(B0[k])); asm volatile("" : "=v"(B1[k])); } }
    unsigned cA = (unsigned)cur.pm * tstep, cB = (unsigned)cur.pn * tstep;
    const __amdgpu_buffer_rsrc_t rsA = __builtin_amdgcn_make_buffer_rsrc((void*)g.A, 0, (int)((unsigned)g.M * (unsigned)K * 2u), 0x00020000), rsB = __builtin_amdgcn_make_buffer_rsrc((void*)g.Bt, 0, (int)((unsigned)g.N * (unsigned)K * 2u), 0x00020000);
    S.a_ready(cur);
    if constexpr (SP2) {
        PG8_STAGE_R(rsB, PG8_SB(0, 0), cB, voffB); PG8_STAGE_R(rsB, PG8_SB(0, 1), cB + hstep, voffB); PG8_STAGE_R(rsA, PG8_SA(0, 0), cA, voffA); PG8_STAGE_R(rsA, PG8_SA(0, 1), cA + hstep, voffA);
        if (wr == 1) PG8_BAR;
        PG8_WAIT_V(2); PG8_BAR;
        PG8_STAGE_R(rsB, PG8_SB(1, 0), cB + kstep, voffB); PG8_STAGE_R(rsA, PG8_SA(1, 0), cA + kstep, voffA); PG8_STAGE_R(rsB, PG8_SB(1, 1), cB + hstep + kstep, voffB);
        PG8_WAIT_V(6); PG8_BAR;
    } else {
        PG8_STAGE_R(rsB, PG8_SB(0, 0), cB, voffB); PG8_STAGE_R(rsA, PG8_SA(0, 0), cA, voffA); PG8_STAGE_R(rsB, PG8_SB(0, 1), cB + hstep, voffB); PG8_STAGE_R(rsA, PG8_SA(0, 1), cA + hstep, voffA);
        if (wr == 1) PG8_BAR;
        PG8_WAIT_V(4); PG8_BAR;
        PG8_STAGE_R(rsB, PG8_SB(1, 0), cB + kstep, voffB); PG8_STAGE_R(rsA, PG8_SA(1, 0), cA + kstep, voffA); PG8_STAGE_R(rsB, PG8_SB(1, 1), cB + hstep + kstep, voffB);
        PG8_WAIT_V(6); PG8_BAR;
    }
    for (;;) {
        const bool has_next = S.next(ui + 1, nxt);
        const unsigned nA = has_next ? (unsigned)nxt.pm * tstep : cA, nB = has_next ? (unsigned)nxt.pn * tstep : cB;
        for (int t = 0; t < nt; t += 2) {
            const bool last = (t == nt - 2);
            const unsigned a1 = cA + (unsigned)(t + 1) * kstep;
            const unsigned a2 = last ? nA : cA + (unsigned)(t + 2) * kstep, b2 = last ? nB : cB + (unsigned)(t + 2) * kstep;
            const unsigned a3 = a2 + kstep, b3 = b2 + kstep;
            if (last && has_next) S.a_ready(nxt);
            if constexpr (SP2) {
            PG8_LDB(B0, 0, 0); PG8_LDB(B1, 0, 1); PG8_SCHED; PG8_LDA(At, 0, 0); PG8_STAGE_R(rsA, PG8_SA(1, 1), a1 + hstep, voffA);
            PG8_WAIT_V(8); PG8_WAIT_L(0); PG8_BAR; PG8_MMA(0, 0, At, B0); PG8_MMA(0, 1, At, B1); PG8_BAR; PG8_SCHED;
            PG8_LDA(At, 0, 1); PG8_STAGE_R(rsB, PG8_SB(0, 0), b2, voffB); PG8_STAGE_R(rsB, PG8_SB(0, 1), b2 + hstep, voffB); PG8_STAGE_R(rsA, PG8_SA(0, 0), a2, voffA);
            PG8_WAIT_V(8); PG8_WAIT_L(0); PG8_BAR; PG8_MMA(1, 0, At, B0); PG8_MMA(1, 1, At, B1); PG8_BAR; PG8_SCHED;
            PG8_LDB(B0, 1, 0); PG8_LDB(B1, 1, 1); PG8_SCHED; PG8_LDA(At, 1, 0); PG8_STAGE_R(rsA, PG8_SA(0, 1), a2 + hstep, voffA);
            PG8_WAIT_V(8); PG8_WAIT_L(0); PG8_BAR; PG8_MMA(0, 0, At, B0); PG8_MMA(0, 1, At, B1); PG8_BAR; PG8_SCHED;
            PG8_LDA(At, 1, 1); PG8_STAGE_R(rsB, PG8_SB(1, 0), b3, voffB); PG8_STAGE_R(rsB, PG8_SB(1, 1), b3 + hstep, voffB); PG8_STAGE_R(rsA, PG8_SA(1, 0), a3, voffA);
            PG8_WAIT_V(8); PG8_WAIT_L(0); PG8_BAR; PG8_MMA(1, 0, At, B0); PG8_MMA(1, 1, At, B1); PG8_BAR; PG8_SCHED;
            } else {
            PG8_LDB(B0, 0, 0); PG8_SCHED; PG8_LDA(At, 0, 0); PG8_STAGE_R(rsA, PG8_SA(1, 1), a1 + hstep, voffA);
            PG8_WAIT_L(8); PG8_BAR; PG8_WAIT_L(0); PG8_MMA(0, 0, At, B0); PG8_BAR; PG8_SCHED;
            PG8_LDB(B1, 0, 1); PG8_STAGE_R(rsB, PG8_SB(0, 0), b2, voffB);
            PG8_BAR; PG8_WAIT_L(0); PG8_MMA(0, 1, At, B1); PG8_BAR;
            PG8_LDA(At, 0, 1); PG8_STAGE_R(rsA, PG8_SA(0, 0), a2, voffA);
            PG8_BAR; PG8_WAIT_L(0); PG8_MMA(1, 0, At, B0); PG8_BAR; PG8_SCHED;
            PG8_STAGE_R(rsB, PG8_SB(0, 1), b2 + hstep, voffB);
            PG8_WAIT_V(6); PG8_BAR; PG8_MMA(1, 1, At, B1); PG8_BAR;
            PG8_LDB(B0, 1, 0); PG8_SCHED; PG8_LDA(At, 1, 0); PG8_STAGE_R(rsA, PG8_SA(0, 1), a2 + hstep, voffA);
            PG8_WAIT_L(8); PG8_BAR; PG8_WAIT_L(0); PG8_MMA(0, 0, At, B0); PG8_BAR; PG8_SCHED;
            PG8_LDB(B1, 1, 1); PG8_STAGE_R(rsB, PG8_SB(1, 0), b3, voffB);
            PG8_BAR; PG8_WAIT_L(0); PG8_MMA(0, 1, At, B1); PG8_BAR;
            PG8_LDA(At, 1, 1); PG8_STAGE_R(rsA, PG8_SA(1, 0), a3, voffA);
            PG8_BAR; PG8_WAIT_L(0); PG8_MMA(1, 0, At, B0); PG8_BAR; PG8_SCHED;
            PG8_STAGE_R(rsB, PG8_SB(1, 1), b3 + hstep, voffB);
            PG8_WAIT_V(6); PG8_BAR; PG8_MMA(1, 1, At, B1); PG8_BAR;
            }
        }
        if constexpr (ALIGN_EPI) { if (wr == 0) PG8_BAR; }
        if constexpr (!Epi::AFTER_DRAIN) { E(acc, cur, wr, wc, r32, hi); S.done(cur); }
        if (!has_next) break;
#pragma unroll
        for (int a = 0; a < 2; ++a)
#pragma unroll
            for (int b = 0; b < 2; ++b)
#pragma unroll
                for (int m = 0; m < 2; ++m) acc[a][b][m] = f32x16{};
        cur = nxt; cA = nA; cB = nB; ++ui;
        if constexpr (ALIGN_EPI) { if (wr == 1) PG8_BAR; }
    }
    PG8_WAIT_V(0);
    if constexpr (!ALIGN_EPI) { if (wr == 0) PG8_BAR; }
    PG8_BAR;
    static_assert(!Epi::AFTER_DRAIN, "gemm_phase32: no drained epilogues");
#undef PG8_SA
#undef PG8_SB
#undef PG8_STAGE_R
#undef PG8_LDA
#undef PG8_LDB
#undef PG8_MMA
#undef PG8_WAIT_V
#undef PG8_WAIT_L
#undef PG8_BAR
#undef PG8_SCHED
}
}

namespace sba {
using bf16x8 = __attribute__((ext_vector_type(8))) short;
using s16x4  = __attribute__((ext_vector_type(4))) short;
using f32x16 = __attribute__((ext_vector_type(16))) float;
using u32x4  = __attribute__((ext_vector_type(4))) unsigned;
typedef _Float16 f16x8 __attribute__((ext_vector_type(8)));
#define SBA_LAS __attribute__((address_space(3)))
constexpr int D = 128, NW = 8, QBLK = 32, KVBLK = 64, LDR = 2048, SEQ = 4096, NHEAD = 16, UNIT_ROWS = QBLK * NW;
constexpr int SHM_V = KVBLK * D * 2, SHM_K = KVBLK * D * 2;
constexpr int OFF_V = 0, OFF_K = 2 * SHM_V, OFF_FLAG = 2 * SHM_V + 2 * SHM_K, OFF_OST = OFF_FLAG + 128, LDS_BYTES = OFF_OST + NW * 4096;
constexpr float DEAD = -152.f;
constexpr float NEG = -30000.f;
#define SBA_KSWZ(row, colB) ((row) * 256 + ((colB) ^ (((row) & 7) << 4)))
#define SBA_SBAR() __builtin_amdgcn_sched_barrier(0)
__device__ __forceinline__ int crow(int r, int hi) { return (r & 3) + 8 * (r >> 2) + 4 * hi; }
__device__ __forceinline__ unsigned cvtpk(float lo, float hi) { unsigned r; asm volatile("v_cvt_pk_bf16_f32 %0, %1, %2" : "=v"(r) : "v"(lo), "v"(hi)); return r; }
__device__ __forceinline__ unsigned pkh(float lo, float hi) { return __builtin_bit_cast(unsigned, __builtin_amdgcn_cvt_pkrtz(lo, hi)); }
__device__ __forceinline__ int v_st(int k, int c) { const int kk = (k & ~0xC) | ((k & 4) << 1) | ((k & 8) >> 1); return ((kk >> 3) * 4 + (c >> 5)) * 512 + ((kk & 7) * 32 + (c & 31)) * 2; }
__device__ __forceinline__ int v_rd_base(int lane) { return ((lane & 3) << 3) | (((lane >> 2) & 3) << 6) | (((lane >> 4) & 1) << 5) | (((lane >> 5) & 1) << 8); }
constexpr int v_rd_off(int d0, int ks, int half) { return d0 * 512 + ks * 4096 + half * 2048; }
template <int OFF> __device__ __forceinline__ s16x4 tr_read(int vb) { s16x4 r; asm volatile("ds_read_b64_tr_b16 %0, %1 offset:%2" : "=&v"(r) : "v"(vb), "i"(OFF) : "memory"); return r; }
template <int D0> __device__ __forceinline__ void pv_one(f32x16& od, int vb, bf16x8 pa0, bf16x8 pa1, bf16x8 pa2, bf16x8 pa3) {
  const s16x4 l0 = tr_read<v_rd_off(D0, 0, 0)>(vb), h0 = tr_read<v_rd_off(D0, 0, 1)>(vb), l1 = tr_read<v_rd_off(D0, 1, 0)>(vb), h1 = tr_read<v_rd_off(D0, 1, 1)>(vb);
  const s16x4 l2 = tr_read<v_rd_off(D0, 2, 0)>(vb), h2 = tr_read<v_rd_off(D0, 2, 1)>(vb), l3 = tr_read<v_rd_off(D0, 3, 0)>(vb), h3 = tr_read<v_rd_off(D0, 3, 1)>(vb);
  asm volatile("s_waitcnt lgkmcnt(0)" ::: "memory"); SBA_SBAR();
#define SBA_PK(L, H) (bf16x8){L[0], L[1], L[2], L[3], H[0], H[1], H[2], H[3]}
  od = __builtin_amdgcn_mfma_f32_32x32x16_bf16(pa0, SBA_PK(l0, h0), od, 0, 0, 0);
  od = __builtin_amdgcn_mfma_f32_32x32x16_bf16(pa1, SBA_PK(l1, h1), od, 0, 0, 0);
  od = __builtin_amdgcn_mfma_f32_32x32x16_bf16(pa2, SBA_PK(l2, h2), od, 0, 0, 0);
  od = __builtin_amdgcn_mfma_f32_32x32x16_bf16(pa3, SBA_PK(l3, h3), od, 0, 0, 0);
#undef SBA_PK
}
__device__ __forceinline__ void qkt(f32x16& p0, f32x16& p1, const SBA_LAS char* Ks, const bf16x8* qr, int r32, int hi) {
  p0 = f32x16{}; p1 = f32x16{};
#pragma unroll
  for (int d0 = 0; d0 < 8; ++d0) { const int cb = (d0 * 16 + hi * 8) * 2;
    const bf16x8 b0 = *(const SBA_LAS bf16x8*)(Ks + SBA_KSWZ(r32, cb));
    const bf16x8 b1 = *(const SBA_LAS bf16x8*)(Ks + SBA_KSWZ(32 + r32, cb));
    p0 = __builtin_amdgcn_mfma_f32_32x32x16_bf16(b0, qr[d0], p0, 0, 0, 0);
    p1 = __builtin_amdgcn_mfma_f32_32x32x16_bf16(b1, qr[d0], p1, 0, 0, 0); }
}
__device__ __forceinline__ void sb_elem(float z, float& lb, float& l1) {
  const float e = __builtin_amdgcn_exp2f(-__builtin_fabsf(z));
  const float L = __builtin_amdgcn_logf(1.0f + e);
  lb = __builtin_amdgcn_fmed3f(z, 0.f, -3.0e38f) - L; l1 = lb - z;
}

__device__ __forceinline__ void attn_unit(int b, int h, int qb, const unsigned short* __restrict__ Q, const unsigned short* __restrict__ K, const unsigned short* __restrict__ V,
                                          signed char* __restrict__ O, float oinv, SBA_LAS char* lds) {
  int tid_ = threadIdx.x; asm volatile("" : "+v"(tid_));
  const int tid = tid_, wid = __builtin_amdgcn_readfirstlane(tid >> 6), lane = tid & 63, r32 = lane & 31, hi = lane >> 5;
  SBA_LAS char* V_lds = lds + OFF_V; SBA_LAS char* K_lds = lds + OFF_K; volatile SBA_LAS unsigned* flags = (volatile SBA_LAS unsigned*)(lds + OFF_FLAG);
  const long rowbase = (long)b * SEQ; const int q0 = qb * UNIT_ROWS;
  bf16x8 qr[8];
  { const unsigned short* Qw = Q + (rowbase + q0 + wid * QBLK + r32) * LDR + h * D + hi * 8;
#pragma unroll
    for (int d0 = 0; d0 < 8; ++d0) qr[d0] = *(const bf16x8*)(Qw + d0 * 16); }
  const unsigned short* Kh = K + rowbase * LDR + h * D; const unsigned short* Vh = V + rowbase * LDR + h * D;
  const int sr = tid >> 4, sc = (tid & 15) * 8, vst0 = v_st(sr, sc), vst1 = v_st(32 + sr, sc);
  const int vb0 = (int)(uintptr_t)V_lds + v_rd_base(lane);
  bf16x8 vs0, vs1, ks0, ks1;
#define SBA_SLOAD(k0) do { vs0 = *(const bf16x8*)(Vh + (long)((k0) + sr) * LDR + sc); vs1 = *(const bf16x8*)(Vh + (long)((k0) + 32 + sr) * LDR + sc); \
    ks0 = *(const bf16x8*)(Kh + (long)((k0) + sr) * LDR + sc); ks1 = *(const bf16x8*)(Kh + (long)((k0) + 32 + sr) * LDR + sc); } while (0)
#define SBA_SWRITE(bf) do { *(SBA_LAS bf16x8*)(V_lds + (bf) * SHM_V + vst0) = vs0; *(SBA_LAS bf16x8*)(V_lds + (bf) * SHM_V + vst1) = vs1; const int kc = sc * 2; \
    *(SBA_LAS bf16x8*)(K_lds + (bf) * SHM_K + SBA_KSWZ(sr, kc)) = ks0; *(SBA_LAS bf16x8*)(K_lds + (bf) * SHM_K + SBA_KSWZ(32 + sr, kc)) = ks1; } while (0)
  f16x8 U0, U1, ONES;
  { u32x4 w0, w1;
#pragma unroll
    for (int p = 0; p < 4; ++p) { const int ka = crow(2 * p, hi), kb = crow(2 * p + 1, hi), kc2 = crow(8 + 2 * p, hi), kd = crow(8 + 2 * p + 1, hi);
      w0[p] = (ka > r32 ? 0x3C00u : 0u) | (kb > r32 ? 0x3C000000u : 0u); w1[p] = (kc2 > r32 ? 0x3C00u : 0u) | (kd > r32 ? 0x3C000000u : 0u); }
    U0 = __builtin_bit_cast(f16x8, w0); U1 = __builtin_bit_cast(f16x8, w1);
    const u32x4 wo = {0x3C003C00u, 0x3C003C00u, 0x3C003C00u, 0x3C003C00u}; ONES = __builtin_bit_cast(f16x8, wo); }
  const int kt_top = 4 * qb + 3, my_kt = 4 * qb + (wid >> 1);
  const int ql = r32 + 32 * (wid & 1);
  float carry = 0.f; bool dead = false; f32x16 o[4] = {};
  SBA_SLOAD(kt_top * KVBLK); asm volatile("s_waitcnt vmcnt(0)" ::: "memory"); SBA_SWRITE(0); __syncthreads();
  for (int i = 0;; ++i) {
    const int kt = kt_top - i, cur = i & 1;
    if (kt > 0) SBA_SLOAD((kt - 1) * KVBLK);
    if (kt <= my_kt && !dead) {
      f32x16 p0, p1;
      qkt(p0, p1, K_lds + cur * SHM_K, qr, r32, hi);
      f32x16 lb0, lb1; float l10[16], l11[16];
#pragma unroll
      for (int r = 0; r < 16; ++r) { float a, c; sb_elem(p0[r], a, c); lb0[r] = a; l10[r] = c; sb_elem(p1[r], a, c); lb1[r] = a; l11[r] = c; }
      if (kt == my_kt) {
#pragma unroll
        for (int r = 0; r < 16; ++r) { const int k0 = crow(r, hi); const bool v0 = k0 < ql, v1 = (k0 + 32) < ql;
          l10[r] = v0 ? l10[r] : 0.f; lb0[r] = v0 ? lb0[r] : NEG; l11[r] = v1 ? l11[r] : 0.f; lb1[r] = v1 ? lb1[r] : NEG; }
      }
      const float lbk0 = lb0[0], l1k0 = l10[0];
      f16x8 h00, h01, h10, h11;
      { u32x4 a, c, e, g;
#pragma unroll
        for (int p = 0; p < 4; ++p) { a[p] = pkh(l10[2 * p], l10[2 * p + 1]); c[p] = pkh(l10[8 + 2 * p], l10[8 + 2 * p + 1]); e[p] = pkh(l11[2 * p], l11[2 * p + 1]); g[p] = pkh(l11[8 + 2 * p], l11[8 + 2 * p + 1]); }
        h00 = __builtin_bit_cast(f16x8, a); h01 = __builtin_bit_cast(f16x8, c); h10 = __builtin_bit_cast(f16x8, e); h11 = __builtin_bit_cast(f16x8, g); }
      lb1 = __builtin_amdgcn_mfma_f32_32x32x16_f16(U0, h10, lb1, 0, 0, 0); lb1 = __builtin_amdgcn_mfma_f32_32x32x16_f16(U1, h11, lb1, 0, 0, 0);
      lb0 = __builtin_amdgcn_mfma_f32_32x32x16_f16(U0, h00, lb0, 0, 0, 0); lb0 = __builtin_amdgcn_mfma_f32_32x32x16_f16(U1, h01, lb0, 0, 0, 0);
      lb0 = __builtin_amdgcn_mfma_f32_32x32x16_f16(ONES, h10, lb0, 0, 0, 0); lb0 = __builtin_amdgcn_mfma_f32_32x32x16_f16(ONES, h11, lb0, 0, 0, 0);
      float tot = (hi == 0) ? (lb0[0] - lbk0) + l1k0 : 0.f;
      { auto rr = __builtin_amdgcn_permlane32_swap(__float_as_uint(tot), __float_as_uint(tot), false, false); tot = __uint_as_float(rr[0]) + __uint_as_float(rr[1]); }
#pragma unroll
      for (int r = 0; r < 16; ++r) { lb0[r] = __builtin_amdgcn_exp2f(lb0[r] + carry); lb1[r] = __builtin_amdgcn_exp2f(lb1[r] + carry); }
      carry += tot;
      bf16x8 pa0, pa1, pa2, pa3;
#define SBA_PK4(P, BASE, OUT) do { unsigned a0 = cvtpk(P[BASE + 0], P[BASE + 1]), a1 = cvtpk(P[BASE + 2], P[BASE + 3]);   \
    unsigned b0 = cvtpk(P[BASE + 4], P[BASE + 5]), b1 = cvtpk(P[BASE + 6], P[BASE + 7]);                              \
    auto r0 = __builtin_amdgcn_permlane32_swap(a0, b0, false, false); auto r1 = __builtin_amdgcn_permlane32_swap(a1, b1, false, false); \
    u32x4 w = {r0[0], r1[0], r0[1], r1[1]}; OUT = __builtin_bit_cast(bf16x8, w); } while (0)
      SBA_PK4(lb0, 0, pa0); SBA_PK4(lb0, 8, pa1); SBA_PK4(lb1, 0, pa2); SBA_PK4(lb1, 8, pa3);
#undef SBA_PK4
      SBA_SBAR();
      const int vb = vb0 + cur * SHM_V;
      pv_one<0>(o[0], vb, pa0, pa1, pa2, pa3); pv_one<1>(o[1], vb, pa0, pa1, pa2, pa3); pv_one<2>(o[2], vb, pa0, pa1, pa2, pa3); pv_one<3>(o[3], vb, pa0, pa1, pa2, pa3);
      dead = !__any(carry > DEAD);
    }
    if (lane == 0) flags[cur * 8 + wid] = (kt > my_kt || !dead) ? 1u : 0u;
    if (kt > 0) { asm volatile("s_waitcnt vmcnt(0)" ::: "memory"); SBA_SWRITE(cur ^ 1); }
    __syncthreads();
    if (kt == 0) break;
    unsigned any = 0u;
#pragma unroll
    for (int w = 0; w < 8; ++w) any |= flags[cur * 8 + w];
    if (__builtin_amdgcn_readfirstlane(any) == 0u) break;
  }
  { signed char* Ow = O + (rowbase + q0 + wid * QBLK) * LDR + h * D; SBA_LAS signed char* stg = (SBA_LAS signed char*)(lds + OFF_OST) + wid * 4096;
#pragma unroll
    for (int r = 0; r < 16; ++r) { const int orow = crow(r, hi);
#pragma unroll
      for (int d0 = 0; d0 < 4; ++d0) { int q = __float2int_rn(o[d0][r] * oinv); q = q > 127 ? 127 : (q < -127 ? -127 : q); stg[orow * 128 + d0 * 32 + r32] = (signed char)q; } }
    asm volatile("s_waitcnt lgkmcnt(0)" ::: "memory");
#pragma unroll
    for (int i = 0; i < 4; ++i) { const int row = i * 8 + (lane >> 3), ch = lane & 7; const u32x4 v = *(const SBA_LAS u32x4*)(stg + row * 128 + ch * 16);
      *(u32x4*)(Ow + (long)row * LDR + ch * 16) = v; }
    asm volatile("s_waitcnt lgkmcnt(0)" ::: "memory");
  }
#undef SBA_SLOAD
#undef SBA_SWRITE
}
}
#define GAS __attribute__((address_space(1)))
#define LAS __attribute__((address_space(3)))
typedef unsigned short bf16;
typedef unsigned v4u __attribute__((ext_vector_type(4)));
typedef float f32x4 __attribute__((ext_vector_type(4)));
typedef short bf16x8 __attribute__((ext_vector_type(8)));
typedef GAS unsigned gu32;
typedef GAS unsigned long long gu64;
#define RLX_AGENT __ATOMIC_RELAXED, __HIP_MEMORY_SCOPE_AGENT
#define LDS_WAIT() asm volatile("s_waitcnt lgkmcnt(0)" ::: "memory")
#define VM_WAIT() asm volatile("s_waitcnt vmcnt(0)" ::: "memory")
__device__ __forceinline__ unsigned long long rt() { return __builtin_amdgcn_s_memrealtime(); }
__device__ __forceinline__ unsigned f2bf(float f) { unsigned u = __builtin_bit_cast(unsigned, f); return (u + 0x7fffu + ((u >> 16) & 1u)) >> 16; }
__device__ __forceinline__ unsigned pk2(float lo, float hi) { return f2bf(lo) | (f2bf(hi) << 16); }

#define XB_TMO      128
#define XB_XCNT(j)  (256  + 64 * (j))
#define XB_XSUB(j)  (1280 + 64 * (j))
#define XB_XGEN(j)  (2304 + 64 * (j))
#define XB_TOP      3328
#define XB_TOPGEN   3392
#define XCD_BAR_WORDS 3456
#define XB_SPIN_CAP (1u << 18)

__device__ __forceinline__ unsigned xb_ld(unsigned* p)              { return __hip_atomic_load(p, __ATOMIC_RELAXED, __HIP_MEMORY_SCOPE_AGENT); }
__device__ __forceinline__ unsigned xb_add(unsigned* p, unsigned v) { return __hip_atomic_fetch_add(p, v, __ATOMIC_RELAXED, __HIP_MEMORY_SCOPE_AGENT); }
__device__ __forceinline__ unsigned xb_xcc_id() { return (unsigned)__builtin_amdgcn_s_getreg((3 << 11) | 20) & 0xFu; }
#define XB_SPIN(cond, bar) do { unsigned _sp = 0; while (cond) { __builtin_amdgcn_s_sleep(1); \
    if ((++_sp & 255u) == 0u) { if (xb_ld(&(bar)[XB_TMO])) break; if (_sp > XB_SPIN_CAP) { atomicAdd(&(bar)[XB_TMO], 1u); break; } } } } while (0)

struct XcdBarrier {
    unsigned* bar; unsigned x;
    volatile LAS unsigned* st;
};

__device__ __forceinline__ XcdBarrier xcd_barrier_post(unsigned* bar, volatile LAS unsigned* st) {
    XcdBarrier b; b.bar = bar; b.x = xb_xcc_id(); b.st = st;
    if (threadIdx.x == 0) (void)xb_add(&bar[XB_XCNT(b.x)], 1u);
    return b;
}
__device__ __forceinline__ void xcd_barrier_complete(unsigned* bar, unsigned x, unsigned& nloc, unsigned& nx) {
    const unsigned G = gridDim.x * gridDim.y * gridDim.z;
    unsigned sum, cnt, mine, sp = 0u;
    for (;;) {
        sum = 0u; cnt = 0u; mine = 0u;
#pragma unroll
        for (unsigned j = 0; j < 16; ++j) { const unsigned c = xb_ld(&bar[XB_XCNT(j)]); sum += c; cnt += (c > 0u) ? 1u : 0u; mine = (j == x) ? c : mine; }
        if (sum == G) break;
        __builtin_amdgcn_s_sleep(1);
        if ((++sp & 255u) == 0u) { if (xb_ld(&bar[XB_TMO])) break; if (sp > XB_SPIN_CAP) { atomicAdd(&bar[XB_TMO], 1u); break; } }
    }
    nloc = mine > 0u ? mine : 1u; nx = cnt > 0u ? cnt : 1u;
}

__device__ __forceinline__ void xcd_barrier(const XcdBarrier& b) {
    asm volatile("s_waitcnt vmcnt(0)" ::: "memory");
    __syncthreads();
    if (threadIdx.x == 0) {
        unsigned* bar = b.bar;
        __builtin_amdgcn_s_waitcnt(0);
        unsigned nloc = b.st[0], nx = b.st[1];
        if (nloc == 0u) { xcd_barrier_complete(bar, b.x, nloc, nx); b.st[0] = nloc; b.st[1] = nx; }
        const unsigned old = xb_add(&bar[XB_XSUB(b.x)], 1u);
        const unsigned gen = old / nloc;
        if (old + 1u == (gen + 1u) * nloc) {
            __builtin_amdgcn_fence(__ATOMIC_RELEASE, "agent");
            asm volatile("s_waitcnt vmcnt(0)" ::: "memory");
            const unsigned og = xb_add(&bar[XB_TOP], 1u);
            const unsigned tg = og / nx;
            if (og + 1u == (tg + 1u) * nx) xb_add(&bar[XB_TOPGEN], 1u);
            else XB_SPIN(xb_ld(&bar[XB_TOPGEN]) == tg, bar);
            __builtin_amdgcn_fence(__ATOMIC_ACQUIRE, "agent");
            xb_add(&bar[XB_XGEN(b.x)], 1u);
            asm volatile("s_waitcnt vmcnt(0)" ::: "memory");
        } else {
            XB_SPIN(xb_ld(&bar[XB_XGEN(b.x)]) == gen, bar);
            __builtin_amdgcn_fence(__ATOMIC_ACQUIRE, "agent");
            asm volatile("s_waitcnt vmcnt(0)" ::: "memory");
        }
    }
    __syncthreads();
}

template <unsigned NG = 4u>
__device__ __forceinline__ void grp_barrier(unsigned* cnt, unsigned* mask, volatile LAS unsigned* ep, unsigned* bar, unsigned* nb_cnt = nullptr, unsigned* nb_mask = nullptr) {
    asm volatile("s_waitcnt vmcnt(0)" ::: "memory");
    __syncthreads();
    if (threadIdx.x == 0) {
        __builtin_amdgcn_s_waitcnt(0);
        const unsigned e = ep[0] + 1u; ep[0] = e;
        unsigned st = ep[1];
        if (st == 0u) { const unsigned m = xb_ld(mask); st = (m != 0u && (m & (m - 1u)) == 0u) ? 1u : 2u; ep[1] = st; }
        bool fast = (st == 1u);
        if (fast && nb_mask) fast = (xb_ld(nb_mask) == xb_ld(mask));
        if (!fast) { __builtin_amdgcn_fence(__ATOMIC_RELEASE, "agent"); asm volatile("s_waitcnt vmcnt(0)" ::: "memory"); }
        (void)xb_add(cnt, 1u);
        const unsigned target = NG * e;
        XB_SPIN(xb_ld(cnt) < target, bar);
        if (nb_cnt) XB_SPIN(xb_ld(nb_cnt) < target, bar);
        __builtin_amdgcn_fence(__ATOMIC_ACQUIRE, "agent");
        asm volatile("s_waitcnt vmcnt(0)" ::: "memory");
    }
    __syncthreads();
}

template <unsigned NG = 4u>
__device__ __forceinline__ void prefix_barrier(unsigned* cnt0, unsigned* mask0, int pm, int first, int last, volatile LAS unsigned* ep, unsigned* bar) {
    asm volatile("s_waitcnt vmcnt(0)" ::: "memory");
    __syncthreads();
    if (threadIdx.x < 64) {
        int lane_ = threadIdx.x; asm volatile("" : "+v"(lane_)); const int lane = lane_;
        __builtin_amdgcn_s_waitcnt(0);
        unsigned e = 0u;
        if (lane == 0) { e = ep[0] + 1u; ep[0] = e; }
        e = __builtin_amdgcn_readfirstlane(e);
        const unsigned own = xb_ld(mask0 + 64 * pm);
        const int g = first + lane;
        const unsigned mg = (g > pm && g <= last) ? xb_ld(mask0 + 64 * g) : own;
        const bool fast = (own != 0u) && ((own & (own - 1u)) == 0u) && __all(mg == own);
        if (!fast && lane == 0) { __builtin_amdgcn_fence(__ATOMIC_RELEASE, "agent"); asm volatile("s_waitcnt vmcnt(0)" ::: "memory"); }
        if (lane == 0) (void)xb_add(cnt0 + 64 * pm, 1u);
        const unsigned target = NG * e;
        unsigned sp = 0u;
        for (;;) {
            const unsigned v = (g <= pm) ? xb_ld(cnt0 + 64 * g) : target;
            if (__all(v >= target)) break;
            __builtin_amdgcn_s_sleep(1);
            if ((++sp & 255u) == 0u) { if (xb_ld(&bar[XB_TMO])) break; if (sp > XB_SPIN_CAP) { if (lane == 0) atomicAdd(&bar[XB_TMO], 1u); break; } }
        }
        __builtin_amdgcn_fence(__ATOMIC_ACQUIRE, "agent");
        asm volatile("s_waitcnt vmcnt(0)" ::: "memory");
    }
    __syncthreads();
}

constexpr int NWAVES = 8, NWAVES_ = 8;
constexpr int BATCH = 4, SEQ = 4096, DM = 2048, NH = 16, HD = 128, FF = 8192, DEPTH = 4, NMOD = 6;
constexpr int M = BATCH * SEQ;
constexpr int NMIX = 3 * DM;
constexpr float LN_EPS = 1e-5f;
constexpr float DN_ALPHA = 1.6817928305074290f;
constexpr float QSCALE = 0.088388347648318440f * 1.4426950408889634f;
constexpr float HID_SCALE = 32.0f, W2_SCALE = 128.0f;
constexpr int MODN = NMOD * DM;
constexpr int KSPLIT = 8;
constexpr size_t MiB = 1u << 20;
constexpr size_t WS_CTL = 0, CTL_ZERO_BYTES = 1 * MiB;
constexpr size_t WS_MODTAB = 1 * MiB;
constexpr size_t WS_PART = 2 * MiB;
constexpr size_t WS_W = 16 * MiB, W_LAYER = 96 * MiB, W_MIXIN = 0, W_MIXOUT = 24 * MiB, W_W1 = 32 * MiB, W_W2 = 64 * MiB;
constexpr size_t WS_H = 400 * MiB, WS_Q = 464 * MiB, WS_K = 528 * MiB, WS_V = 592 * MiB, WS_O = 656 * MiB;
constexpr size_t WS_HID = 720 * MiB, WS_END = 976 * MiB;
constexpr size_t WS_K2 = 912 * MiB, WS_V2 = 1040 * MiB, WS_G2 = 1104 * MiB  , WS_NEED = 1168 * MiB;
constexpr size_t WS_G = WS_HID + 128 * MiB;
constexpr size_t WS_Y = WS_Q;
constexpr size_t WS_X16 = 976 * MiB;
constexpr size_t WS_ROWS = 9 * MiB;
constexpr size_t WS_ROWSH = WS_ROWS + 64 * 1024;
constexpr size_t W_MIXOUT_CS = 4 * MiB;
constexpr size_t W_MIXIN_CS = 12 * MiB;
constexpr size_t W_W1_CS = 16 * MiB;
constexpr size_t WS_SCR = 1040 * MiB;
static_assert(WS_PART + (size_t)KSPLIT * DEPTH * BATCH * MODN * 4 <= WS_ROWS && WS_ROWS + (size_t)BATCH * SEQ * 4 <= WS_W && WS_W + DEPTH * W_LAYER <= WS_H && WS_HID + (size_t)M * FF * 2 <= WS_END, "d_ws map");
constexpr int CW_GMASK = 16384;
constexpr int CW_GRP = 8192;
constexpr int CW_A1 = 2048;
constexpr int CW_VMAX = 1024;
constexpr int CW_BAR = 4096;
constexpr int RING_OFF = 0, RING_BYTES = 131072;
constexpr int LDSCTL_OFF = RING_BYTES, MISC_OFF = LDSCTL_OFF + 320;
constexpr int LDS_BYTES = 147456;
static_assert(MISC_OFF + 128 <= LDS_BYTES && sba::LDS_BYTES <= RING_BYTES, "LDS map");

struct Frame {
    LAS unsigned char* lds;
    int tid, lane, wave, vcu, G, vrow;
};
template <int CTRL, int ROWMASK> __device__ __forceinline__ int dpp_i(int v) {
    return __builtin_amdgcn_update_dpp(0, v, CTRL, ROWMASK, 0xF, true);
}
__device__ __forceinline__ float wave_sum(float v) {
#define DPPF(C, R) __builtin_bit_cast(float, dpp_i<C, R>(__builtin_bit_cast(int, v)))
    v += DPPF(0xB1, 0xF); v += DPPF(0x4E, 0xF); v += DPPF(0x141, 0xF); v += DPPF(0x140, 0xF); v += DPPF(0x142, 0xA); v += DPPF(0x143, 0xC);
#undef DPPF
    return __builtin_bit_cast(float, __builtin_amdgcn_readlane(__builtin_bit_cast(int, v), 63));
}
__device__ __forceinline__ unsigned cvtpk_bf16(float lo, float hi) { unsigned r; asm volatile("v_cvt_pk_bf16_f32 %0, %1, %2" : "=v"(r) : "v"(lo), "v"(hi)); return r; }
__host__ __device__ __forceinline__ int conv_in_row(int n0) { if (n0 < DM) return 2 * DM + n0; if (n0 < 2 * DM) { const int j = n0 - DM; return 256 * (j / 128) + (j % 128); } const int j = n0 - 2 * DM; return 256 * (j / 128) + 128 + (j % 128); }
template <bool CONV_IN = false, bool FP8 = false>
__device__ __forceinline__ void p0_transpose_item(const float* W, int K, int N, bf16* WT, LAS float* scr, int item, int lane, int scaled_cols = 0, float scale = 1.f) {
    const int nblk = N / 32, kb = item / nblk, nb = item % nblk, k0 = 64 * kb, n0 = 32 * nb;
#pragma unroll 8
    for (int i = 0; i < 32; ++i) { const int kk = 2 * i + (lane >> 5); scr[kk * 33 + (lane & 31)] = __builtin_nontemporal_load(&W[(size_t)(k0 + kk) * N + n0 + (lane & 31)]); }
    LDS_WAIT(); asm volatile("" ::: "memory");
    const int c = lane & 7; const float sf = (n0 < scaled_cols) ? scale : 1.f;
#pragma unroll
    for (int j = 0; j < 4; ++j) { const int n = (lane >> 3) + 8 * j; const LAS float* s = scr + (8 * c) * 33 + n;
        if constexpr (FP8) { float t[8];
#pragma unroll
            for (int i = 0; i < 8; ++i) t[i] = fminf(fmaxf(s[i * 33] * sf, -448.0f), 448.0f);
            int p0 = 0, p1 = 0; p0 = __builtin_amdgcn_cvt_pk_fp8_f32(t[0], t[1], p0, false); p0 = __builtin_amdgcn_cvt_pk_fp8_f32(t[2], t[3], p0, true);
            p1 = __builtin_amdgcn_cvt_pk_fp8_f32(t[4], t[5], p1, false); p1 = __builtin_amdgcn_cvt_pk_fp8_f32(t[6], t[7], p1, true);
            uint2 o; o.x = (unsigned)p0; o.y = (unsigned)p1; *(uint2*)((unsigned char*)WT + (size_t)(n0 + n) * K + k0 + 8 * c) = o; }
        else {
        v4u o; o.x = cvtpk_bf16(s[0 * 33] * sf, s[1 * 33] * sf); o.y = cvtpk_bf16(s[2 * 33] * sf, s[3 * 33] * sf); o.z = cvtpk_bf16(s[4 * 33] * sf, s[5 * 33] * sf); o.w = cvtpk_bf16(s[6 * 33] * sf, s[7 * 33] * sf);
        *(v4u*)(WT + (size_t)((CONV_IN ? conv_in_row(n0) : n0) + n) * K + k0 + 8 * c) = o; } }
    LDS_WAIT(); asm volatile("" ::: "memory");
}

__device__ __forceinline__ void p0_w1_item(const float* W, int K, int N, signed char* WT8, float* cs, LAS float* scr, LAS float* red  , int item, int wave, int lane, int scaled_cols = 0, float cs_factor = 1.f) {
    const int n0 = 16 * item, c = lane & 15, kq = lane >> 4, kw = (K / NWAVES_) * wave;
    float mx = 0.f;
    for (int i = 0; i < K / NWAVES_ / 4; i += 16) { float t[16];
#pragma unroll
        for (int j = 0; j < 16; ++j) t[j] = W[(size_t)(kw + 4 * (i + j) + kq) * N + n0 + c];
#pragma unroll
        for (int j = 0; j < 16; ++j) mx = fmaxf(mx, fabsf(t[j])); }
    mx = fmaxf(mx, __shfl_xor(mx, 16)); mx = fmaxf(mx, __shfl_xor(mx, 32));
    if (lane < 16) red[wave * 16 + c] = mx;
    __syncthreads();
#pragma unroll
    for (int w = 0; w < NWAVES_; ++w) mx = fmaxf(mx, red[w * 16 + c]);
    const float sc = mx > 0.f ? mx * (1.0f / 127.0f) : 1.0f;
    if (wave == 0 && lane < 16) cs[n0 + c] = (n0 < scaled_cols) ? sc * cs_factor : sc;
    const int n = lane >> 2, kb = lane & 3; const float inv = 1.0f / __shfl(sc, n);
    for (int k0 = kw; k0 < kw + K / NWAVES_; k0 += 64) {
#pragma unroll
        for (int i = 0; i < 16; ++i) { const int kk = 4 * i + kq; scr[kk * 17 + c] = W[(size_t)(k0 + kk) * N + n0 + c]; }
        LDS_WAIT(); asm volatile("" ::: "memory");
        v4u o;
#pragma unroll
        for (int q = 0; q < 4; ++q) { unsigned w = 0;
#pragma unroll
            for (int j = 0; j < 4; ++j) { const int qv = __float2int_rn(scr[(16 * kb + 4 * q + j) * 17 + n] * inv); w |= ((unsigned)qv & 0xffu) << (8 * j); }
            o[q] = w; }
        *(v4u*)(WT8 + (size_t)(n0 + n) * K + k0 + 16 * kb) = o;
        LDS_WAIT(); asm volatile("" ::: "memory");
    }
    __syncthreads();
}
struct Args { const float* in[16]; float* out; unsigned char* ws; int ph_lo, ph_hi; };
constexpr int NPHASE = 2 + 7 * DEPTH;

__device__ __forceinline__ void phase_prologue_a(Frame& F, const Args& a, int lay_lo, int lay_hi, int rank, int nrank, bool with_gemv, int tr_shift = 0) {
    const int gw = rank * NWAVES + F.wave, NGW = nrank * NWAVES;
    LAS float* sil = (LAS float*)(F.lds + 69632);
    if (with_gemv) {
    for (int e = F.tid; e < BATCH * DM; e += NWAVES * 64) { const int b = e / DM, k = e % DM; const float cv = a.in[1][e]; sil[k * 4 + b] = cv / (1.0f + __expf(-cv)); }
    __syncthreads();
    constexpr int MCB = 192, NMCB = MODN / MCB;
    for (int task = gw; task < DEPTH * NMCB * KSPLIT; task += NGW) {
        const int l = task / (NMCB * KSPLIT), rem = task % (NMCB * KSPLIT), cb = rem / KSPLIT, kc = rem % KSPLIT;
        if (F.lane < MCB / 4) {
        const float* W = a.in[2] + (size_t)l * DM * MODN + (size_t)(kc * 256) * MODN + cb * MCB + 4 * F.lane;
        f32x4 acc0 = {0.f, 0.f, 0.f, 0.f}, acc1 = acc0, acc2 = acc0, acc3 = acc0;
        for (int k0 = 0; k0 < 256; k0 += 8) {
            f32x4 w[8];
#pragma unroll
            for (int j = 0; j < 8; ++j) w[j] = __builtin_nontemporal_load((const f32x4*)(W + (size_t)(k0 + j) * MODN));
#pragma unroll
            for (int j = 0; j < 8; ++j) { const f32x4 s = *(const LAS f32x4*)(sil + (kc * 256 + k0 + j) * 4); acc0 += w[j] * s[0]; acc1 += w[j] * s[1]; acc2 += w[j] * s[2]; acc3 += w[j] * s[3]; }
        }
        float* P = (float*)(a.ws + WS_PART) + ((size_t)(kc * DEPTH + l) * BATCH) * MODN + cb * MCB + 4 * F.lane;
        *(f32x4*)(P) = acc0; *(f32x4*)(P + MODN) = acc1; *(f32x4*)(P + 2 * MODN) = acc2; *(f32x4*)(P + 3 * MODN) = acc3;
        }
    }
    }
    LAS float* scr = (LAS float*)(F.lds + F.wave * 8704);
    constexpr int I_IN = (DM / 64) * (NMIX / 32), I_OUT = (DM / 64) * (DM / 32), I_2 = (FF / 64) * (DM / 32), I_LAYER = I_IN + I_OUT + I_2;
    for (int it = lay_lo * I_LAYER + (lay_lo ? tr_shift : 0) + gw; it < lay_hi * I_LAYER + (lay_hi < DEPTH ? tr_shift : 0); it += NGW) {
        const int l = it / I_LAYER; int r = it % I_LAYER; const int j = l >> 1;
        bf16* wl = (bf16*)(a.ws + WS_W + (size_t)l * W_LAYER);
        if (r < I_IN) { if (l & 1) p0_transpose_item<true>(a.in[8] + (size_t)j * DM * NMIX, DM, NMIX, (bf16*)((unsigned char*)wl + W_MIXIN), scr, r, F.lane); continue; }     r -= I_IN;
        if (r < I_OUT) { if (l & 1) p0_transpose_item(a.in[11] + (size_t)j * DM * DM, DM, DM, (bf16*)((unsigned char*)wl + W_MIXOUT), scr, r, F.lane); continue; }     r -= I_OUT;
        p0_transpose_item<false, true>(a.in[14] + (size_t)l * FF * DM, FF, DM, (bf16*)((unsigned char*)wl + W_W2), scr, r, F.lane, DM, W2_SCALE);
    }
    LAS float* red = (LAS float*)(F.lds + 102400);
    for (int it = rank; it < (DEPTH / 2) * (NMIX / 16); it += nrank) { const int ja = it / (NMIX / 16), r = it % (NMIX / 16); if (2 * ja < lay_lo || 2 * ja >= lay_hi) continue; unsigned char* wq = a.ws + WS_W + (size_t)(2 * ja) * W_LAYER + W_MIXIN;
        p0_w1_item(a.in[6] + (size_t)ja * DM * NMIX, DM, NMIX, (signed char*)wq, (float*)(wq + W_MIXIN_CS), scr, red, r, F.wave, F.lane, DM, QSCALE); }
    for (int it = rank; it < (DEPTH / 2) * (DM / 16); it += nrank) { const int ja = it / (DM / 16), r = it % (DM / 16); if (2 * ja < lay_lo || 2 * ja >= lay_hi) continue; unsigned char* wo = a.ws + WS_W + (size_t)(2 * ja) * W_LAYER + W_MIXOUT;
        p0_w1_item(a.in[7] + (size_t)ja * DM * DM, DM, DM, (signed char*)wo, (float*)(wo + W_MIXOUT_CS), scr, red, r, F.wave, F.lane); }
    for (int it = lay_lo * (FF / 16) + rank; it < lay_hi * (FF / 16); it += nrank) { const int l = it / (FF / 16), r = it % (FF / 16); unsigned char* w1 = a.ws + WS_W + (size_t)l * W_LAYER + W_W1;
        p0_w1_item(a.in[12] + (size_t)l * DM * FF, DM, FF, (signed char*)w1, (float*)(w1 + W_W1_CS), scr, red, r, F.wave, F.lane); }
}
typedef unsigned u32x2v __attribute__((ext_vector_type(2)));
__device__ __forceinline__ uint2 ld_nt_u2(const void* p) { const u32x2v v = __builtin_nontemporal_load((const u32x2v*)p); uint2 r; r.x = v[0]; r.y = v[1]; return r; }
__device__ __forceinline__ void st_nt_u2(void* p, const uint2 w) { const u32x2v v = {w.x, w.y}; __builtin_nontemporal_store(v, (u32x2v*)p); }
__device__ __forceinline__ uint2 q16_pack(const f32x4 v, float inv) {
    const int a = __float2int_rn(v[0] * inv), b = __float2int_rn(v[1] * inv), c = __float2int_rn(v[2] * inv), d = __float2int_rn(v[3] * inv);
    uint2 w; w.x = ((unsigned)a & 0xffffu) | ((unsigned)b << 16); w.y = ((unsigned)c & 0xffffu) | ((unsigned)d << 16); return w;
}
__device__ __forceinline__ f32x4 q16_unpack(const uint2 w, float sc) {
    const f32x4 v = {(float)((int)(w.x << 16) >> 16), (float)((int)w.x >> 16), (float)((int)(w.y << 16) >> 16), (float)((int)w.y >> 16)}; return v * sc;
}
__device__ __forceinline__ float wave_max(float v) {
    unsigned u = __builtin_bit_cast(unsigned, v);
#define DPPU(C, R) (unsigned)dpp_i<C, R>((int)u)
    { unsigned t = DPPU(0xB1, 0xF); u = u > t ? u : t; } { unsigned t = DPPU(0x4E, 0xF); u = u > t ? u : t; } { unsigned t = DPPU(0x141, 0xF); u = u > t ? u : t; }
    { unsigned t = DPPU(0x140, 0xF); u = u > t ? u : t; } { unsigned t = DPPU(0x142, 0xA); u = u > t ? u : t; } { unsigned t = DPPU(0x143, 0xC); u = u > t ? u : t; }
#undef DPPU
    return __builtin_bit_cast(float, __builtin_amdgcn_readlane((int)u, 63));
}
__device__ __forceinline__ void phase_prologue_b(Frame& F, const Args& a) {
    const float* part = (const float*)(a.ws + WS_PART); float* modtab = (float*)(a.ws + WS_MODTAB); const float* mod_b = a.in[3];
    for (int e = F.vcu * NWAVES * 64 + F.tid; e < DEPTH * BATCH * MODN; e += F.G * NWAVES * 64) {
        const int l = e / (BATCH * MODN), rem = e % (BATCH * MODN), b = rem / MODN, n = rem % MODN;
        float s = mod_b[l * MODN + n];
#pragma unroll
        for (int kc = 0; kc < KSPLIT; ++kc) s += part[((size_t)(kc * DEPTH + l) * BATCH + b) * MODN + n];
        if ((n / DM) % 3 != 0) s += 1.0f;
        modtab[e] = s;
    }
    const int rows_wg = M / F.G, row0 = F.vrow * rows_wg, b = row0 / SEQ;
    LAS float* ST = (LAS float*)(F.lds);
    for (int c = F.tid; c < 2 * DM; c += NWAVES * 64) {
        float s = mod_b[c];
#pragma unroll
        for (int kc = 0; kc < KSPLIT; ++kc) s += part[((size_t)(kc * DEPTH + 0) * BATCH + b) * MODN + c];
        ST[c] = (c >= DM) ? s + 1.0f : s;
    }
    __syncthreads();
    const int rows_wave = rows_wg / NWAVES;
    f32x4 Sv0[8], Tv0[8];
#pragma unroll
    for (int j = 0; j < 8; ++j) { Tv0[j] = *(const LAS f32x4*)(ST + 4 * F.lane + 256 * j); Sv0[j] = *(const LAS f32x4*)(ST + DM + 4 * F.lane + 256 * j); }
    f32x4 xn[8];
    { const float* x0 = a.in[0] + ((size_t)row0 + F.wave * rows_wave) * DM;
#pragma unroll
      for (int j = 0; j < 8; ++j) xn[j] = __builtin_nontemporal_load((const f32x4*)(x0 + 4 * F.lane + 256 * j)); }
    for (int r = 0; r < rows_wave; ++r) {
        const size_t row = (size_t)row0 + F.wave * rows_wave + r;
        const float* xr = a.in[0] + row * DM; short* qr = (short*)(a.ws + WS_X16) + row * DM; unsigned char* hr = a.ws + WS_H + row * DM;
        f32x4 v[8]; float mx = 0.f;
#pragma unroll
        for (int j = 0; j < 8; ++j) { v[j] = xn[j]; mx = fmaxf(fmaxf(mx, fmaxf(fabsf(v[j][0]), fabsf(v[j][1]))), fmaxf(fabsf(v[j][2]), fabsf(v[j][3]))); }
        if (r + 1 < rows_wave) {
#pragma unroll
            for (int j = 0; j < 8; ++j) xn[j] = __builtin_nontemporal_load((const f32x4*)(xr + DM + 4 * F.lane + 256 * j)); }
        mx = wave_max(mx); const float rs = mx > 0.f ? mx * (1.0f / 32767.0f) : 1.0f, inv = 1.0f / rs;
        if (F.lane == 0) ((float*)(a.ws + WS_ROWS))[row] = rs;
        f32x4 hv[8]; float mh = 0.f;
#pragma unroll
        for (int j = 0; j < 8; ++j) { const int col = 4 * F.lane + 256 * j;
            hv[j] = v[j] * Sv0[j] + Tv0[j];
            mh = fmaxf(fmaxf(mh, fmaxf(fabsf(hv[j][0]), fabsf(hv[j][1]))), fmaxf(fabsf(hv[j][2]), fabsf(hv[j][3])));
            st_nt_u2(qr + col, q16_pack(v[j], inv)); }
        mh = wave_max(mh); const float hs = mh > 0.f ? mh * (1.0f / 127.0f) : 1.0f, hinv = 1.0f / hs;
        if (F.lane == 0) ((float*)(a.ws + WS_ROWSH))[row] = hs;
        signed char* h8 = (signed char*)hr;
#pragma unroll
        for (int j = 0; j < 8; ++j) { const unsigned w = ((unsigned)__float2int_rn(hv[j][0] * hinv) & 0xffu) | (((unsigned)__float2int_rn(hv[j][1] * hinv) & 0xffu) << 8) | (((unsigned)__float2int_rn(hv[j][2] * hinv) & 0xffu) << 16) | ((unsigned)__float2int_rn(hv[j][3] * hinv) << 24);
            *(unsigned*)(h8 + 4 * F.lane + 256 * j) = w; }
    }
}
__device__ __forceinline__ void phase_ln(Frame& F, const Args& a, const bf16* Y, const float* lg, const float* lb, const float* Tn, const float* Sn, bool write_h, long xo_off = 0, long ho_off = 0, long qo_off = 0, bool h_int8 = false) {
    const int rows_wg = M / F.G, row0 = F.vrow * rows_wg, b = row0 / SEQ, rows_wave = rows_wg / NWAVES;
    LAS float* ST = (LAS float*)(F.lds);
    for (int c = F.tid; c < DM; c += NWAVES * 64) { ST[c] = Sn[(size_t)b * MODN + c]; ST[DM + c] = Tn[(size_t)b * MODN + c]; ST[2 * DM + c] = lg[c]; ST[3 * DM + c] = lb[c]; }
    __syncthreads();
    f32x4 Sv[8], Tv[8];
#pragma unroll
    for (int j = 0; j < 8; ++j) { Sv[j] = *(const LAS f32x4*)(ST + 4 * F.lane + 256 * j); Tv[j] = *(const LAS f32x4*)(ST + DM + 4 * F.lane + 256 * j); }
#define g4_(j) (*(const LAS f32x4*)(ST + 2 * DM + 4 * F.lane + 256 * (j)))
#define b4_(j) (*(const LAS f32x4*)(ST + 3 * DM + 4 * F.lane + 256 * (j)))
    uint2 yw[8], xw[8]; float rs_raw;
    { const size_t row = (size_t)row0 + F.wave * rows_wave; const bf16* yr = Y + row * DM; const short* qr = (const short*)(a.ws + WS_X16) + row * DM;
#pragma unroll
      for (int j = 0; j < 8; ++j) { yw[j] = ld_nt_u2((yr + 4 * F.lane + 256 * j)); xw[j] = ld_nt_u2((qr + 4 * F.lane + 256 * j)); }
      rs_raw = ((const float*)(a.ws + WS_ROWS))[row]; }
    for (int r = 0; r < rows_wave; ++r) {
        const size_t row = (size_t)row0 + F.wave * rows_wave + r;
        float* xr = a.out + row * DM; short* qr = (short*)(a.ws + WS_X16) + row * DM; bf16* hr = (bf16*)(a.ws + WS_H) + row * DM;
        float* rsp = (float*)(a.ws + WS_ROWS) + row; const float rs_in = rs_raw * DN_ALPHA;
        f32x4 v[8]; f32x4 sv = {0.f, 0.f, 0.f, 0.f};
#pragma unroll
        for (int j = 0; j < 8; ++j) { const f32x4 yv = {__uint_as_float(yw[j].x << 16), __uint_as_float(yw[j].x & 0xffff0000u), __uint_as_float(yw[j].y << 16), __uint_as_float(yw[j].y & 0xffff0000u)};
            v[j] = q16_unpack(xw[j], rs_in) + yv; sv += v[j]; }
        const float s = (sv[0] + sv[1]) + (sv[2] + sv[3]);
        if (r + 1 < rows_wave) { const bf16* yn = Y + (row + 1) * DM; const short* qn = (const short*)(a.ws + WS_X16) + (row + 1) * DM;
#pragma unroll
            for (int j = 0; j < 8; ++j) { yw[j] = ld_nt_u2((yn + 4 * F.lane + 256 * j)); xw[j] = ld_nt_u2((qn + 4 * F.lane + 256 * j)); }
            rs_raw = ((const float*)(a.ws + WS_ROWS))[row + 1]; }
        const float mean = wave_sum(s) * (1.0f / DM); f32x4 s2v = {0.f, 0.f, 0.f, 0.f};
#pragma unroll
        for (int j = 0; j < 8; ++j) { v[j] = v[j] - mean; s2v = __builtin_elementwise_fma(v[j], v[j], s2v); }
        const float s2 = (s2v[0] + s2v[1]) + (s2v[2] + s2v[3]);
        const float rstd = __builtin_amdgcn_rsqf(wave_sum(s2) * (1.0f / DM) + LN_EPS);
        if (!write_h) {
#pragma unroll
            for (int j = 0; j < 8; ++j) { const int col = 4 * F.lane + 256 * j; __builtin_nontemporal_store((v[j] * rstd) * g4_(j) + b4_(j), (f32x4*)(xr + xo_off + col)); }
        } else {
            float mx = 0.f;
            if (h_int8) {
                float mh = 0.f;
#pragma unroll
                for (int j = 0; j < 8; ++j) { v[j] = (v[j] * rstd) * g4_(j) + b4_(j); const f32x4 hv = v[j] * Sv[j] + Tv[j];
                    mx = fmaxf(fmaxf(mx, fmaxf(fabsf(v[j][0]), fabsf(v[j][1]))), fmaxf(fabsf(v[j][2]), fabsf(v[j][3])));
                    mh = fmaxf(fmaxf(mh, fmaxf(fabsf(hv[0]), fabsf(hv[1]))), fmaxf(fabsf(hv[2]), fabsf(hv[3]))); if (j & 1) asm volatile("" ::: "memory"); }
                mh = wave_max(mh); const float hs = mh > 0.f ? mh * (1.0f / 127.0f) : 1.0f, hinv = __builtin_amdgcn_rcpf(hs);
                if (F.lane == 0 && qo_off == 0) ((float*)(a.ws + WS_ROWSH))[row] = hs;
                signed char* h8 = (signed char*)(a.ws + WS_H) + row * DM + ho_off;
#pragma unroll
                for (int j = 0; j < 8; ++j) { const f32x4 hv = (v[j] * Sv[j] + Tv[j]) * hinv;
                    const unsigned w = ((unsigned)__float2int_rn(hv[0]) & 0xffu) | (((unsigned)__float2int_rn(hv[1]) & 0xffu) << 8) | (((unsigned)__float2int_rn(hv[2]) & 0xffu) << 16) | ((unsigned)__float2int_rn(hv[3]) << 24);
                    *(unsigned*)(h8 + 4 * F.lane + 256 * j) = w; if (j & 1) asm volatile("" ::: "memory"); }
            } else {
#pragma unroll
            for (int j = 0; j < 8; ++j) { v[j] = (v[j] * rstd) * g4_(j) + b4_(j); const f32x4 hv = v[j] * Sv[j] + Tv[j];
                mx = fmaxf(fmaxf(mx, fmaxf(fabsf(v[j][0]), fabsf(v[j][1]))), fmaxf(fabsf(v[j][2]), fabsf(v[j][3])));
                uint2 w; w.x = cvtpk_bf16(hv[0], hv[1]); w.y = cvtpk_bf16(hv[2], hv[3]); *(uint2*)(hr + ho_off + 4 * F.lane + 256 * j) = w; }
            }
            mx = wave_max(mx); const float rs = mx > 0.f ? mx * (1.0f / 32767.0f) : 1.0f, inv = __builtin_amdgcn_rcpf(rs);
            if (F.lane == 0 && qo_off == 0) *rsp = rs;
#pragma unroll
            for (int j = 0; j < 8; ++j) st_nt_u2(qr + qo_off + 4 * F.lane + 256 * j, q16_pack(v[j], inv));
        }
    }
}
#undef g4_
#undef b4_
__device__ __forceinline__ void bf8_to_f32(const bf16x8 v, float (&f)[8]) {
#pragma unroll
    for (int i = 0; i < 8; ++i) f[i] = __uint_as_float(((unsigned)(unsigned short)v[i]) << 16);
}
__device__ __forceinline__ void phase_conv(Frame& F, const Args& a, const float* cw, const float* cb, const bf16* Gg) {
    const bf16* Bg = (const bf16*)(a.ws + WS_Q); bf16* Out = (bf16*)(a.ws + WS_O);
    constexpr int TT = 8; const int rows_wg = M / F.G, ntask = (rows_wg / TT) * (DM / 8);
    for (int task = F.tid; task < ntask; task += NWAVES * 64) {
        const int chunk = task & (DM / 8 - 1), run = F.vrow * (rows_wg / TT) + task / (DM / 8), ch0 = chunk * 8, m0 = run * TT; const bool first = (m0 % SEQ) == 0;
        float w0[8], w1[8], w2[8], bb[8];
#pragma unroll
        for (int i = 0; i < 8; ++i) { w0[i] = cw[ch0 + i]; w1[i] = cw[DM + ch0 + i]; w2[i] = cw[2 * DM + ch0 + i]; bb[i] = cb[ch0 + i]; }
        float g2[8], g1[8];
        if (first) {
#pragma unroll
            for (int i = 0; i < 8; ++i) { g2[i] = 0.f; g1[i] = 0.f; }
        } else { bf8_to_f32(*(const bf16x8*)(Gg + (size_t)(m0 - 2) * DM + ch0), g2); bf8_to_f32(*(const bf16x8*)(Gg + (size_t)(m0 - 1) * DM + ch0), g1); }
        bf16x8 gr[TT], br[TT];
#pragma unroll
        for (int t = 0; t < TT; ++t) { gr[t] = __builtin_nontemporal_load((const bf16x8*)(Gg + (size_t)(m0 + t) * DM + ch0)); br[t] = __builtin_nontemporal_load((const bf16x8*)(Bg + (size_t)(m0 + t) * DM + ch0)); }
#pragma unroll
        for (int t = 0; t < TT; ++t) {
            float bg[8], g0[8], y[8];
            bf8_to_f32(gr[t], g0); bf8_to_f32(br[t], bg);
#pragma unroll
            for (int i = 0; i < 8; ++i) { y[i] = bg[i] * (w0[i] * g2[i] + w1[i] * g1[i] + w2[i] * g0[i] + bb[i]); g2[i] = g1[i]; g1[i] = g0[i]; }
            v4u o; o.x = cvtpk_bf16(y[0], y[1]); o.y = cvtpk_bf16(y[2], y[3]); o.z = cvtpk_bf16(y[4], y[5]); o.w = cvtpk_bf16(y[6], y[7]);
            *(v4u*)(Out + (size_t)(m0 + t) * DM + ch0) = o;
        }
    }
}

#ifndef MK_MF32
#define MK_MF32 0
#endif
#ifndef MK_STAGGER_US
#define MK_STAGGER_US 60
#endif
#ifndef MK_DUP
#define MK_DUP 0
#endif
#define NREP(bit) ((MK_DUP & (bit)) ? 2 : 1)
#ifndef MK_DIS
#define MK_DIS 0
#endif
__global__ void __launch_bounds__(NWAVES * 64, 2) mk_fwd(Args args) {
    extern __shared__ __attribute__((aligned(16))) unsigned char lds[];
    Frame F;
    F.lds = (LAS unsigned char*)lds;
    volatile LAS unsigned* MISC = (volatile LAS unsigned*)(F.lds + MISC_OFF);
    F.tid = threadIdx.x; F.lane = F.tid & 63; F.wave = __builtin_amdgcn_readfirstlane(F.tid >> 6);
    F.G = gridDim.x; { const int bx = blockIdx.x; F.vcu = (F.G % 8 == 0) ? (bx % 8) * (F.G / 8) + bx / 8 : bx; }
    unsigned char* ws = args.ws;
    const bool grp_mode = (F.G == 256);
    { const int bx = blockIdx.x, pm_ = 8 * (bx % 8) + (bx / 8) % 8; F.vrow = grp_mode ? 4 * pm_ + bx / 64 : F.vcu; }
    unsigned* grp_mask = (unsigned*)(ws + WS_CTL) + CW_GMASK + 64 * ((F.vrow >> 2) & 63);
    if (threadIdx.x == 0) (void)__hip_atomic_fetch_or(grp_mask, 1u << xb_xcc_id(), __ATOMIC_RELAXED, __HIP_MEMORY_SCOPE_AGENT);
    unsigned* grp_cnt = (unsigned*)(ws + WS_CTL) + CW_GRP + 64 * ((F.vrow >> 2) & 63);
    for (int u = F.tid; u < (LDS_BYTES - LDSCTL_OFF) / 4; u += NWAVES * 64) ((LAS unsigned*)(F.lds + LDSCTL_OFF))[u] = 0u;
    __syncthreads();
    XcdBarrier bar = xcd_barrier_post((unsigned*)(ws + WS_CTL) + CW_BAR, MISC + 8);
    const int lo = args.ph_lo, hi = args.ph_hi;
#define FRESH() do { int t_ = threadIdx.x; asm volatile("" : "+v"(t_)); F.tid = t_; F.lane = t_ & 63; F.wave = __builtin_amdgcn_readfirstlane(t_ >> 6); } while (0)
#define IN(k) (lo <= (k) && (k) < hi)
#define SEAM(k) do { if ((k) + 1 < hi) { xcd_barrier(bar); if (MK_DUP & 8192) xcd_barrier(bar); } } while (0)
#define CSEAM(k) do { if ((k) + 1 < hi) { if (grp_mode) { const int pm_ = F.vrow >> 2; unsigned* c0_ = (unsigned*)(ws + WS_CTL) + CW_GRP; unsigned* m0_ = (unsigned*)(ws + WS_CTL) + CW_GMASK; \
        grp_barrier(grp_cnt, grp_mask, MISC + 10, bar.bar, (pm_ % (SEQ / 256)) ? c0_ + 64 * (pm_ - 1) : nullptr, ((pm_ + 1) % (SEQ / 256)) ? m0_ + 64 * (pm_ + 1) : nullptr); } else xcd_barrier(bar); } } while (0)
#define ASEAM(k) do { if ((k) + 1 < hi) { if (grp_mode) { const int pm_ = F.vrow >> 2, f_ = pm_ - pm_ % (SEQ / 256); \
        prefix_barrier((unsigned*)(ws + WS_CTL) + CW_GRP, (unsigned*)(ws + WS_CTL) + CW_GMASK, pm_, f_, f_ + SEQ / 256 - 1, MISC + 10, bar.bar); } else xcd_barrier(bar); } } while (0)
#define GSEAM(k) do { if ((k) + 1 < hi) { if (grp_mode) grp_barrier(grp_cnt, grp_mask, MISC + 10, bar.bar); else xcd_barrier(bar); } } while (0)
    float* modtab = (float*)(ws + WS_MODTAB);
    const long scr_off = MK_DUP ? (long)((float*)(ws + WS_SCR) - args.out) : 0, hscr_off = MK_DUP ? (long)((bf16*)(ws + WS_SCR) - (bf16*)(ws + WS_H)) : 0, qscr_off = MK_DUP ? (long)((short*)(ws + WS_SCR + 64 * MiB) - (short*)(ws + WS_X16)) : 0;
    bf16* Hb = (bf16*)(ws + WS_H); bf16* Qb = (bf16*)(ws + WS_Q); bf16* Ob = (bf16*)(ws + WS_O); bf16* HIDb = (bf16*)(ws + WS_HID); bf16* Yb = (bf16*)(ws + WS_Y);

    if (IN(0)) {
#if !(MK_DIS & 1)
        for (int rep = 0; rep < NREP(1); ++rep) { FRESH(); phase_prologue_a(F, args, 0, grp_mode ? DEPTH - 1 : DEPTH, F.vcu, F.G, true, (DM / 64) * (NMIX / 32)); }
#endif
        SEAM(0); }
    if (IN(1)) {
#if !(MK_DIS & 2)
        for (int rep = 0; rep < NREP(2); ++rep) { FRESH(); phase_prologue_b(F, args); }
#endif
        SEAM(1);
        if (grp_mode && (F.vrow >> 2) >= (M / 256) / 2) {
            FRESH(); phase_prologue_a(F, args, DEPTH - 1, DEPTH, F.vrow - (M / 256) * 2, (M / 256) * 2, false, (DM / 64) * (NMIX / 32));
            asm volatile("s_waitcnt vmcnt(0)" ::: "memory"); __syncthreads();
            if (threadIdx.x == 0) { __builtin_amdgcn_fence(__ATOMIC_RELEASE, "agent"); asm volatile("s_waitcnt vmcnt(0)" ::: "memory"); (void)xb_add((unsigned*)(ws + WS_CTL) + CW_A1, 1u); }
        }
        }
    for (int l = 0; l < DEPTH; ++l) {
        const int pb = 2 + 7 * l, j = l >> 1; const bool is_conv = (l & 1) != 0;
        if (grp_mode && l == DEPTH - 1 && IN(pb + 0)) {
            if (threadIdx.x == 0) { unsigned* w_ = (unsigned*)(ws + WS_CTL) + CW_A1; XB_SPIN(xb_ld(w_) < (unsigned)((M / 256) * 2), bar.bar); __builtin_amdgcn_fence(__ATOMIC_ACQUIRE, "agent"); asm volatile("s_waitcnt vmcnt(0)" ::: "memory"); }
            __syncthreads(); }
        bf16* Gb = (bf16*)(ws + ((j & 1) ? WS_G2 : WS_G));
        bf16* Kb = (bf16*)(ws + ((j & 1) ? WS_K2 : WS_K)); bf16* Vb = (bf16*)(ws + ((j & 1) ? WS_V2 : WS_V));
        const unsigned char* wl = ws + WS_W + (size_t)l * W_LAYER;
        const float* mt = modtab + (size_t)l * BATCH * MODN;
        if (IN(pb + 0)) {
            pg8::Gemm g{Hb, (const bf16*)(wl + W_MIXIN), M, NMIX, DM}; pg8::StaticOrder S; S.init(M, NMIX, F.G, (int)blockIdx.x);
            if (is_conv) {
                pg8::EpiConvIn E{Gb, Qb, DM, DM / 128};
#if !(MK_DIS & 4)
                for (int rep = 0; rep < NREP(4); ++rep) pg8::gemm_phase<pg8::EpiConvIn, pg8::StaticOrder, true, true>(F.lds + RING_OFF, g, S, E);
#endif
            } else {
                pg8::EpiI8Bf16Split E{Qb, DM, (const float*)(ws + WS_ROWSH), (const float*)(wl + W_MIXIN + W_MIXIN_CS), DM, Kb, Vb, (unsigned*)(ws + WS_CTL) + CW_VMAX + 64 * j};
#if !(MK_DIS & 4)
                for (int rep = 0; rep < NREP(4); ++rep) pg8::gemm_phase<pg8::EpiI8Bf16Split, pg8::StaticOrder, true, true, 0, 1, true>(F.lds + RING_OFF, g, S, E);
#endif
#if (MK_DUP & 1024)
                { pg8::EpiNull EN; pg8::gemm_phase<pg8::EpiNull, pg8::StaticOrder, true, true, 0, 1, true>(F.lds + RING_OFF, g, S, EN); }
#endif
#if (MK_DUP & 262144)
                { pg8::EpiNull EN; pg8::gemm_phase<pg8::EpiNull, pg8::StaticOrder, true, true, 3>(F.lds + RING_OFF, g, S, EN); }
#endif
#if (MK_DUP & 524288)
                { pg8::EpiNull EN; pg8::gemm_phase<pg8::EpiNull, pg8::StaticOrder, true, true, 4>(F.lds + RING_OFF, g, S, EN); }
#endif
            }
            if (is_conv) CSEAM(pb + 0); else ASEAM(pb + 0);
        }
        if (IN(pb + 1)) {
            if (is_conv) {

#if !(MK_DIS & 16)
                for (int rep = 0; rep < NREP(16); ++rep) { FRESH(); phase_conv(F, args, args.in[9] + (size_t)j * 3 * DM, args.in[10] + (size_t)j * DM, Gb); }
#endif

            } else {

#if !(MK_DIS & 8)
                const int nunits = BATCH * NH * (SEQ / sba::UNIT_ROWS);
                unsigned* vmaxw = (unsigned*)(ws + WS_CTL) + CW_VMAX + 64 * j;
                for (int rep = 0; rep < NREP(8); ++rep) {
                    if (grp_mode) {
                        const int pm_ = F.vrow >> 2, j_ = F.vrow & 3; const float osc = pg8::o_scale_panels(vmaxw, pm_ - pm_ % (SEQ / 256), pm_);
                        for (int i = 0; i < NH / 4; ++i) sba::attn_unit(pm_ / (SEQ / sba::UNIT_ROWS), 4 * j_ + i, pm_ % (SEQ / sba::UNIT_ROWS), Qb, Kb, Vb, (signed char*)Ob, 1.0f / osc, (LAS char*)(F.lds + RING_OFF));
                    } else for (int u = F.vcu; u < nunits; u += F.G) { const int bh = u / (SEQ / sba::UNIT_ROWS), qb = u % (SEQ / sba::UNIT_ROWS);
                        const int pmu = (bh / NH) * (SEQ / 256) + qb; const float osc = pg8::o_scale_panels(vmaxw, pmu - qb, pmu); sba::attn_unit(bh / NH, bh % NH, qb, Qb, Kb, Vb, (signed char*)Ob, 1.0f / osc, (LAS char*)(F.lds + RING_OFF)); } }
#endif

            }
            GSEAM(pb + 1);
        }
        if (IN(pb + 2)) {
            pg8::Gemm g{Ob, (const bf16*)(wl + W_MIXOUT), M, DM, DM}; pg8::StaticOrder S; S.init(M, DM, F.G, (int)blockIdx.x);
#if !(MK_DIS & 32)
            if (is_conv) {
                pg8::EpiGateBf16<false> E{Yb, DM, nullptr, mt + 2 * DM, MODN, SEQ, 1.0f};
                for (int rep = 0; rep < NREP(32); ++rep) pg8::gemm_phase<pg8::EpiGateBf16<false>, pg8::StaticOrder, true, true>(F.lds + RING_OFF, g, S, E);
            } else {
                pg8::EpiI8GateBf16 E{Yb, DM, mt + 2 * DM, MODN, SEQ, (const float*)(wl + W_MIXOUT + W_MIXOUT_CS), (unsigned*)(ws + WS_CTL) + CW_VMAX + 64 * j};
                for (int rep = 0; rep < NREP(32); ++rep) pg8::gemm_phase<pg8::EpiI8GateBf16, pg8::StaticOrder, true, true, 0, 1, true>(F.lds + RING_OFF, g, S, E);
            }
            GSEAM(pb + 2);
#endif

        }
        if (IN(pb + 3)) {
#if !(MK_DIS & 64)
            for (int rep = 0; rep < NREP(64); ++rep) { const bool x_ = rep + 1 < NREP(64); FRESH(); phase_ln(F, args, Yb, args.in[4] + (size_t)(l * 2 + 0) * DM, args.in[5] + (size_t)(l * 2 + 0) * DM, mt + 3 * DM, mt + 4 * DM, true, x_ ? scr_off : 0, x_ ? hscr_off : 0, x_ ? qscr_off : 0, true); }
#endif
            GSEAM(pb + 3); }
        if (IN(pb + 4)) {
            pg8::Gemm g{Hb, (const bf16*)(wl + W_W1), M, FF, DM}; pg8::StaticOrder S; S.init(M, FF, F.G, (int)blockIdx.x);
            pg8::EpiI8Fp8Relu2 E{(unsigned char*)HIDb, FF, args.in[13] + (size_t)l * FF, (const float*)(ws + WS_ROWSH), (const float*)(wl + W_W1 + W_W1_CS), HID_SCALE};
#if !(MK_DIS & 128)
            for (int rep = 0; rep < NREP(128); ++rep) pg8::gemm_phase<pg8::EpiI8Fp8Relu2, pg8::StaticOrder, true, true, 0, 1, true>(F.lds + RING_OFF, g, S, E);
#endif

            GSEAM(pb + 4);
        }
        if (IN(pb + 5)) {
            pg8::Gemm g{HIDb, (const bf16*)(wl + W_W2), M, DM, FF}; pg8::StaticOrder S; S.init(M, DM, F.G, (int)blockIdx.x);
            pg8::EpiGateBf16<true, true> E{Yb, DM, args.in[15] + (size_t)l * DM, mt + 5 * DM, MODN, SEQ, 1.0f / (HID_SCALE * W2_SCALE)};
#if !(MK_DIS & 256)
#if (MK_DUP & 2048)
            { pg8::EpiNull EN; pg8::gemm_phase<pg8::EpiNull, pg8::StaticOrder, true, true, 0, 1>(F.lds + RING_OFF, g, S, EN); }
#endif
            for (int rep = 0; rep < NREP(256); ++rep) pg8::gemm_phase<pg8::EpiGateBf16<true, true>, pg8::StaticOrder, true, true, 0, 1>(F.lds + RING_OFF, g, S, E);
            GSEAM(pb + 5);
#endif

        }
        if (IN(pb + 6)) { const int nl = (l + 1 < DEPTH) ? l + 1 : l; const float* mtn = modtab + (size_t)nl * BATCH * MODN;

#if !(MK_DIS & 512)
            for (int rep = 0; rep < NREP(512); ++rep) { const bool x_ = rep + 1 < NREP(512); FRESH(); phase_ln(F, args, Yb, args.in[4] + (size_t)(l * 2 + 1) * DM, args.in[5] + (size_t)(l * 2 + 1) * DM, mtn + 0 * DM, mtn + 1 * DM, l + 1 < DEPTH, x_ ? scr_off : 0, x_ ? hscr_off : 0, x_ ? qscr_off : 0, ((l + 1) & 1) == 0); }
#endif
            GSEAM(pb + 6); }
    }
#undef IN
#undef SEAM
#undef GSEAM
#undef ASEAM
#undef CSEAM
}

extern "C" void kernel_launch(void* const* d_in, const int* in_sizes, int n_in, void* d_out, int out_size, void* d_ws, size_t ws_size, hipStream_t stream) {
    static int grid = 0;
    if (grid == 0) {
        if (n_in != 16 || in_sizes[0] != M * DM || out_size != M * DM || ws_size < WS_NEED + (MK_DUP ? 128 * MiB : 0)) { fprintf(stderr, "kernel_launch: unexpected shapes (n_in %d, in0 %d, out %d, ws %zu); nothing launched\n", n_in, n_in > 0 ? in_sizes[0] : -1, out_size, ws_size); grid = -1; return; }
        int dev = 0, cus = 0, per_cu = 0;
        if (hipGetDevice(&dev) != hipSuccess || hipDeviceGetAttribute(&cus, hipDeviceAttributeMultiprocessorCount, dev) != hipSuccess) { fprintf(stderr, "kernel_launch: device query failed\n"); grid = -1; return; }
        if (hipFuncSetAttribute((const void*)mk_fwd, hipFuncAttributeMaxDynamicSharedMemorySize, LDS_BYTES) != hipSuccess) { fprintf(stderr, "kernel_launch: hipFuncSetAttribute failed\n"); grid = -1; return; }
        if (hipOccupancyMaxActiveBlocksPerMultiprocessor(&per_cu, (const void*)mk_fwd, NWAVES * 64, LDS_BYTES) != hipSuccess || per_cu < 1) { fprintf(stderr, "kernel_launch: occupancy query reports %d workgroups per CU\n", per_cu); }
        (void)hipGetLastError();
        grid = cus;
        if (grid > 256) grid = 256;
        if (grid != 256 && grid != 128 && grid != 64) { fprintf(stderr, "kernel_launch: %d CUs: this kernel deals rows in M/grid blocks and needs 64, 128 or 256 workgroups; nothing launched\n", grid); grid = -1; return; }
    }
    if (grid < 0) return;
    if (hipMemsetAsync((char*)d_ws + WS_CTL, 0, CTL_ZERO_BYTES, stream) != hipSuccess) { fprintf(stderr, "kernel_launch: memset failed\n"); return; }
    Args a{};
    for (int i = 0; i < 16; ++i) a.in[i] = (const float*)d_in[i];
    a.out = (float*)d_out; a.ws = (unsigned char*)d_ws;
    a.ph_lo = 0; a.ph_hi = NPHASE;
    hipLaunchKernelGGL(mk_fwd, dim3(grid), dim3(NWAVES * 64), LDS_BYTES, stream, a);
    const hipError_t le = hipPeekAtLastError();
    if (le != hipSuccess) fprintf(stderr, "kernel_launch: launch failed: %s\n", hipGetErrorName(le));
}
```

```cpp
#include <hip/hip_runtime.h>
#include <hip/hip_bf16.h>
#include <cstdio>
#include <cstdint>
namespace pg8 {
#define PG8_LAS __attribute__((address_space(3)))
typedef unsigned short bf16_t;
typedef short bf16x8 __attribute__((ext_vector_type(8)));
typedef float f32x4 __attribute__((ext_vector_type(4)));
typedef unsigned u32x4 __attribute__((ext_vector_type(4)));
constexpr int BM = 256, BK = 64, HALF = 128, HTB = HALF * BK * 2  , STAGE_BYTES = 8 * HTB, NXCD = 8, WGM = 8;

__host__ __device__ __forceinline__ int lds_byte(int r, int c) { const int st = (r >> 4) * 2 + (c >> 5), rr = r & 15, cc = c & 31, ob = rr * 64 + cc * 2; return st * 1024 + (ob ^ (((ob >> 9) & 1) << 5)); }
__host__ __device__ __forceinline__ void stage_rc(int b, int& R, int& C) { const int st = b / 1024, sb = b % 1024, swz = sb ^ (((sb >> 9) & 1) << 5); R = (st >> 1) * 16 + swz / 64; C = (st & 1) * 32 + (swz % 64) / 2; }
__host__ __device__ __forceinline__ int perm32(int rho) { const int n = rho >> 4, i = rho & 15; return 8 * (i >> 2) + 4 * n + (i & 3); }

typedef float f32x16 __attribute__((ext_vector_type(16)));
__host__ __device__ __forceinline__ int lds_byte2(int r, int c) { const int rb = r >> 4, rr = r & 15, h = c >> 5, ch = (c & 31) >> 3; return (rb * 2 + h) * 1024 + rr * 64 + ((ch ^ ((rr >> 2) & 3)) << 4) + (c & 7) * 2; }
__host__ __device__ __forceinline__ void stage_rc2(int b, int& R, int& C) { const int p = b / 1024, l = (b % 1024) / 16, rr = l >> 2, cs = l & 3, ch = cs ^ ((rr >> 2) & 3); R = (p >> 1) * 16 + rr; C = (p & 1) * 32 + ch * 8; }
__host__ __device__ __forceinline__ int perm32b(int rho) { return (rho & 3) | (((rho >> 3) & 1) << 2) | (((rho >> 2) & 1) << 3) | (rho & 16); }

__host__ __device__ __forceinline__ int adj16_row(int bj, int R) { return 64 * (R >> 5) + 16 * ((R & 15) >> 2) + 8 * bj + 4 * ((R >> 4) & 1) + (R & 3); }
typedef int i32x8 __attribute__((ext_vector_type(8)));
typedef int i32x4 __attribute__((ext_vector_type(4)));
__device__ __forceinline__ i32x8 frag32(bf16x8 lo, bf16x8 hi) { const i32x4 a = __builtin_bit_cast(i32x4, lo), b = __builtin_bit_cast(i32x4, hi); return __builtin_shufflevector(a, b, 0, 1, 2, 3, 4, 5, 6, 7); }
__device__ __forceinline__ void mfma_fp8_tied(f32x4& acc, const i32x8 a, const i32x8 b, const int scl) {
    asm volatile("v_mfma_scale_f32_16x16x128_f8f6f4 %0, %1, %2, %0, %3, %3 op_sel_hi:[0,0,0]" : "+v"(acc) : "v"(a), "v"(b), "v"(scl));
}
struct Unit { int pm, pn; };
struct Gemm { const bf16_t* A; const bf16_t* Bt; int M, N, K; };

struct StaticOrder {
    int nM, nN, nwg, G, c;
    __host__ __device__ void init(int M, int N, int G_, int c_) { nM = M / BM; nN = N / BM; nwg = nM * nN; G = G_; c = c_; }
    __host__ __device__ bool next(int i, Unit& u) const {
        const long L = (long)i * G + c; if (L >= nwg) return false;
        int wgid = (int)L; { const int q = nwg / NXCD, r = nwg % NXCD, xcd = wgid % NXCD, off = wgid / NXCD; wgid = (xcd < r ? xcd * (q + 1) : r * (q + 1) + (xcd - r) * q) + off; }
        const int nig = WGM * nN, gid = wgid / nig, fm = gid * WGM, gsz = (nM - fm) < WGM ? (nM - fm) : WGM;
        u.pm = fm + ((wgid % nig) % gsz); u.pn = (wgid % nig) / gsz; return true;
    }
    __device__ __forceinline__ void a_ready(const Unit&) const {}
    __device__ __forceinline__ void done(const Unit&) const {}
};

__device__ __forceinline__ unsigned cvt_pk_bf16(float lo, float hi) { unsigned r; asm volatile("v_cvt_pk_bf16_f32 %0, %1, %2" : "=v"(r) : "v"(lo), "v"(hi)); return r; }
typedef float f32x2 __attribute__((ext_vector_type(2)));
#ifndef MK_WT
#define MK_WT 0
#endif
__device__ __forceinline__ void store16_wt(void* p, u32x4 v) {
#if MK_WT
    asm volatile("global_store_dwordx4 %0, %1, off sc1" :: "v"(p), "v"(v) : "memory");
#else
    *(u32x4*)p = v;
#endif
}

template <int ACT, bool HAS_BIAS> struct EpiBf16 {
    static constexpr bool PERM = true, AFTER_DRAIN = false; static constexpr int BPERM = 1; static_assert(ACT == 0 || ACT == 3, "EpiBf16: ACT is 0 (none) or 3 (squared relu)");
    int row_mask;
    bf16_t* O; int ldc; const float* bias; int split_cols; size_t split_stride;
    __device__ __forceinline__ void operator()(const f32x4 (&acc)[2][2][4][2], const Unit& u, int wr, int wc, int fr, int fq) const {
        const int row0 = (u.pm * BM + wr * 64 + fr) & row_mask; int colt = u.pn * BM; bf16_t* base = O;
        if (split_cols) { const int t = colt / split_cols; base += (size_t)t * split_stride; colt -= t * split_cols; }
        const int col0 = colt + wc * 32 + 8 * fq, bcol0 = u.pn * BM + wc * 32 + 8 * fq;
        f32x4 bv[2][2];
        if constexpr (HAS_BIAS) { int bcolv = bcol0; asm volatile("" : "+v"(bcolv));
#pragma unroll
            for (int bj = 0; bj < 2; ++bj)
#pragma unroll
                for (int n = 0; n < 2; ++n) bv[bj][n] = *(const f32x4*)(bias + bcolv + bj * HALF + 4 * n);
        }
#pragma unroll
        for (int ai = 0; ai < 2; ++ai)
#pragma unroll
            for (int m = 0; m < 4; ++m) { bf16_t* rowp = base + (size_t)(row0 + ai * HALF + m * 16) * ldc + col0;
#pragma unroll
                for (int bj = 0; bj < 2; ++bj) { f32x4 v0 = acc[ai][bj][m][0], v1 = acc[ai][bj][m][1];
                    if constexpr (HAS_BIAS) { v0 = v0 + bv[bj][0]; v1 = v1 + bv[bj][1]; }
                    if (ACT == 3) {
#pragma unroll
                        for (int j = 0; j < 4; ++j) { const float a = fmaxf(v0[j], 0.f), b = fmaxf(v1[j], 0.f); v0[j] = a * a; v1[j] = b * b; } }
                    u32x4 w; w.x = cvt_pk_bf16(v0[0], v0[1]); w.y = cvt_pk_bf16(v0[2], v0[3]); w.z = cvt_pk_bf16(v1[0], v1[1]); w.w = cvt_pk_bf16(v1[2], v1[3]);
                    store16_wt(rowp + bj * HALF, w); } }
    }
};
struct EpiResid {
    static constexpr bool PERM = false, AFTER_DRAIN = false; static constexpr int BPERM = 0;
    float* X; int ldc; const float* bias; const float* gate; int gate_bstride; int rows_per_batch; float alpha; long out_off;
    __device__ __forceinline__ void operator()(const f32x4 (&acc)[2][2][4][2], const Unit& u, int wr, int wc, int fr, int fq) const {
        const int row0 = u.pm * BM + wr * 64 + fr, col0 = u.pn * BM + wc * 32 + 4 * fq;
        const float* gp = gate + (size_t)((u.pm * BM) / rows_per_batch) * gate_bstride;
        f32x4 bv[2][2], gv[2][2];
#pragma unroll
        for (int bj = 0; bj < 2; ++bj)
#pragma unroll
            for (int n = 0; n < 2; ++n) { bv[bj][n] = bias ? *(const f32x4*)(bias + col0 + bj * HALF + n * 16) : (f32x4){0.f, 0.f, 0.f, 0.f}; gv[bj][n] = *(const f32x4*)(gp + col0 + bj * HALF + n * 16); }
#pragma unroll
        for (int ai = 0; ai < 2; ++ai)
#pragma unroll
            for (int m = 0; m < 4; ++m) { float* rowp = X + (size_t)(row0 + ai * HALF + m * 16) * ldc + col0;
#pragma unroll
                for (int bj = 0; bj < 2; ++bj)
#pragma unroll
                    for (int n = 0; n < 2; ++n) { const f32x4 xo = *(const f32x4*)(rowp + bj * HALF + n * 16); *(f32x4*)(rowp + out_off + bj * HALF + n * 16) = xo * alpha + gv[bj][n] * (acc[ai][bj][m][n] + bv[bj][n]); }
                if (m & 1) asm volatile("" ::: "memory"); }
    }
};


template <bool HAS_BIAS, bool SCALED = false> struct EpiGateBf16 {
    static constexpr bool PERM = true, AFTER_DRAIN = false; static constexpr int BPERM = 1;
    bf16_t* O; int ldc; const float* bias; const float* gate; int gate_bstride; int rows_per_batch; float ascale;
    __device__ __forceinline__ void operator()(const f32x4 (&acc)[2][2][4][2], const Unit& u, int wr, int wc, int fr, int fq) const {
        const int row0 = u.pm * BM + wr * 64 + fr, col0 = u.pn * BM + wc * 32 + 8 * fq;
        const float* gp = gate + (size_t)((u.pm * BM) / rows_per_batch) * gate_bstride;
        int colv = col0; asm volatile("" : "+v"(colv));
        f32x4 bv[2][2], gv[2][2];
#pragma unroll
        for (int bj = 0; bj < 2; ++bj)
#pragma unroll
            for (int n = 0; n < 2; ++n) { if constexpr (HAS_BIAS) bv[bj][n] = *(const f32x4*)(bias + colv + bj * HALF + 4 * n); gv[bj][n] = *(const f32x4*)(gp + colv + bj * HALF + 4 * n); }
#pragma unroll
        for (int ai = 0; ai < 2; ++ai)
#pragma unroll
            for (int m = 0; m < 4; ++m) { bf16_t* rowp = O + (size_t)(row0 + ai * HALF + m * 16) * ldc + col0;
#pragma unroll
                for (int bj = 0; bj < 2; ++bj) { f32x4 v0 = acc[ai][bj][m][0], v1 = acc[ai][bj][m][1]; if constexpr (SCALED) { v0 = v0 * ascale; v1 = v1 * ascale; } if constexpr (HAS_BIAS) { v0 = v0 + bv[bj][0]; v1 = v1 + bv[bj][1]; } v0 = v0 * gv[bj][0]; v1 = v1 * gv[bj][1];
                    u32x4 w; w.x = cvt_pk_bf16(v0[0], v0[1]); w.y = cvt_pk_bf16(v0[2], v0[3]); w.z = cvt_pk_bf16(v1[0], v1[1]); w.w = cvt_pk_bf16(v1[2], v1[3]);
                    store16_wt(rowp + bj * HALF, w); } }
    }
};

struct EpiConvIn {
    static constexpr bool PERM = true, AFTER_DRAIN = false; static constexpr int BPERM = 1;
    bf16_t* Gt; bf16_t* Bg; int ldc; int CT;
    __device__ __forceinline__ void operator()(const f32x4 (&acc)[2][2][4][2], const Unit& u, int wr, int wc, int fr, int fq) const {
        const int row0 = u.pm * BM + wr * 64 + fr;
        if (u.pn < CT) {
            const int col0 = u.pn * HALF + wc * 32 + 8 * fq;
#pragma unroll
            for (int ai = 0; ai < 2; ++ai)
#pragma unroll
                for (int m = 0; m < 4; ++m) { const f32x4 v0 = acc[ai][0][m][0] * acc[ai][1][m][0], v1 = acc[ai][0][m][1] * acc[ai][1][m][1];
                    u32x4 w; w.x = cvt_pk_bf16(v0[0], v0[1]); w.y = cvt_pk_bf16(v0[2], v0[3]); w.z = cvt_pk_bf16(v1[0], v1[1]); w.w = cvt_pk_bf16(v1[2], v1[3]);
                    store16_wt(Gt + (size_t)(row0 + ai * HALF + m * 16) * ldc + col0, w); }
        } else {
            const int col0 = (u.pn - CT) * BM + wc * 32 + 8 * fq;
#pragma unroll
            for (int ai = 0; ai < 2; ++ai)
#pragma unroll
                for (int m = 0; m < 4; ++m) { bf16_t* rowp = Bg + (size_t)(row0 + ai * HALF + m * 16) * ldc + col0;
#pragma unroll
                    for (int bj = 0; bj < 2; ++bj) { const f32x4 v0 = acc[ai][bj][m][0], v1 = acc[ai][bj][m][1];
                        u32x4 w; w.x = cvt_pk_bf16(v0[0], v0[1]); w.y = cvt_pk_bf16(v0[2], v0[3]); w.z = cvt_pk_bf16(v1[0], v1[1]); w.w = cvt_pk_bf16(v1[2], v1[3]);
                        store16_wt(rowp + bj * HALF, w); } }
        }
    }
};

struct EpiFp8Relu2 {
    static constexpr bool PERM = true, AFTER_DRAIN = false; static constexpr int BPERM = 2;
    unsigned char* O8; int ldc; const float* bias; float oscale;
    __device__ __forceinline__ void operator()(const f32x4 (&acc)[2][2][4][2], const Unit& u, int wr, int wc, int fr, int fq) const {
        const int row0 = u.pm * BM + wr * 64 + fr, col0 = u.pn * BM + wc * 64 + 16 * fq;
        int colv = col0; asm volatile("" : "+v"(colv));
        f32x4 bv[2][2];
#pragma unroll
        for (int bj = 0; bj < 2; ++bj)
#pragma unroll
            for (int n = 0; n < 2; ++n) bv[bj][n] = *(const f32x4*)(bias + colv + 8 * bj + 4 * n);
#pragma unroll
        for (int ai = 0; ai < 2; ++ai)
#pragma unroll
            for (int m = 0; m < 4; ++m) { u32x4 w;
#pragma unroll
                for (int bj = 0; bj < 2; ++bj)
#pragma unroll
                    for (int n = 0; n < 2; ++n) { f32x4 v = acc[ai][bj][m][n] + bv[bj][n];
#pragma unroll
                        for (int j = 0; j < 4; ++j) { const float a = fmaxf(v[j], 0.f); v[j] = fminf(a * a * oscale, 448.0f); }
                        int p = 0; p = __builtin_amdgcn_cvt_pk_fp8_f32(v[0], v[1], p, false); p = __builtin_amdgcn_cvt_pk_fp8_f32(v[2], v[3], p, true); w[2 * bj + n] = (unsigned)p; }
                *(u32x4*)(O8 + (size_t)(row0 + ai * HALF + m * 16) * ldc + col0) = w; }
    }
};

struct EpiI8Fp8Relu2 {
    static constexpr bool PERM = true, AFTER_DRAIN = false; static constexpr int BPERM = 2;
    unsigned char* O8; int ldc; const float* bias; const float* rowscale; const float* colscale; float oscale;
    __device__ __forceinline__ void operator()(const f32x4 (&acc)[2][2][4][2], const Unit& u, int wr, int wc, int fr, int fq) const {
        const int row0 = u.pm * BM + wr * 64 + fr, col0 = u.pn * BM + wc * 64 + 16 * fq;
        int colv = col0; asm volatile("" : "+v"(colv));
        const float sq = sqrtf(oscale);
        f32x4 bv[2][2], cv[2][2];
#pragma unroll
        for (int bj = 0; bj < 2; ++bj)
#pragma unroll
            for (int n = 0; n < 2; ++n) { bv[bj][n] = *(const f32x4*)(bias + colv + 8 * bj + 4 * n); cv[bj][n] = *(const f32x4*)(colscale + colv + 8 * bj + 4 * n); }
        float rsv[2][4];
#pragma unroll
        for (int ai = 0; ai < 2; ++ai)
#pragma unroll
            for (int m = 0; m < 4; ++m) rsv[ai][m] = rowscale[row0 + ai * HALF + m * 16];
        __builtin_amdgcn_sched_barrier(0);
#pragma unroll
        for (int bj = 0; bj < 2; ++bj)
#pragma unroll
            for (int n = 0; n < 2; ++n) { bv[bj][n] = bv[bj][n] * sq; cv[bj][n] = cv[bj][n] * sq; }
#pragma unroll
        for (int ai = 0; ai < 2; ++ai)
#pragma unroll
            for (int m = 0; m < 4; ++m) { const int row = row0 + ai * HALF + m * 16; const float rs = rsv[ai][m]; u32x4 w;
#pragma unroll
                for (int bj = 0; bj < 2; ++bj)
#pragma unroll
                    for (int n = 0; n < 2; ++n) { const i32x4 ia = __builtin_bit_cast(i32x4, acc[ai][bj][m][n]); const f32x4 rc = cv[bj][n] * rs;
                        f32x4 a = __builtin_elementwise_fma(__builtin_convertvector(ia, f32x4), rc, bv[bj][n]);
#pragma unroll
                        for (int j = 0; j < 4; ++j) a[j] = __builtin_amdgcn_fmed3f(a[j], 0.f, 21.166010f);
                        const f32x4 v = a * a;
                        int p = 0; p = __builtin_amdgcn_cvt_pk_fp8_f32(v[0], v[1], p, false); p = __builtin_amdgcn_cvt_pk_fp8_f32(v[2], v[3], p, true); w[2 * bj + n] = (unsigned)p; }
                *(u32x4*)(O8 + (size_t)row * ldc + col0) = w; }
    }
};

struct EpiI8Bf16Split {
    static constexpr bool PERM = true, AFTER_DRAIN = false; static constexpr int BPERM = 1;
    bf16_t* O; int ldc; const float* rowscale; const float* colscale; int split_cols; bf16_t* O1; bf16_t* O2; unsigned* vmax;
    __device__ __forceinline__ void operator()(const f32x4 (&acc)[2][2][4][2], const Unit& u, int wr, int wc, int fr, int fq) const {
        const int row0 = u.pm * BM + wr * 64 + fr; int colt = u.pn * BM; bf16_t* base = O;
        const int t = colt / split_cols; base = (t == 0) ? O : (t == 1) ? O1 : O2; colt -= t * split_cols; f32x4 vm4 = {0.f, 0.f, 0.f, 0.f};
        const int col0 = colt + wc * 32 + 8 * fq; int ccol = u.pn * BM + wc * 32 + 8 * fq; asm volatile("" : "+v"(ccol));
        f32x4 cv[2][2];
#pragma unroll
        for (int bj = 0; bj < 2; ++bj)
#pragma unroll
            for (int n = 0; n < 2; ++n) cv[bj][n] = *(const f32x4*)(colscale + ccol + bj * HALF + 4 * n);
        float rsv[2][4];
#pragma unroll
        for (int ai = 0; ai < 2; ++ai)
#pragma unroll
            for (int m = 0; m < 4; ++m) rsv[ai][m] = rowscale[row0 + ai * HALF + m * 16];
        __builtin_amdgcn_sched_barrier(0);
#pragma unroll
        for (int ai = 0; ai < 2; ++ai)
#pragma unroll
            for (int m = 0; m < 4; ++m) { const int row = row0 + ai * HALF + m * 16; const float rs = rsv[ai][m]; const size_t rowo = (size_t)row * ldc + col0;
#pragma unroll
                for (int bj = 0; bj < 2; ++bj) { const i32x4 i0 = __builtin_bit_cast(i32x4, acc[ai][bj][m][0]), i1 = __builtin_bit_cast(i32x4, acc[ai][bj][m][1]);
                    const f32x4 v0 = __builtin_convertvector(i0, f32x4) * (cv[bj][0] * rs), v1 = __builtin_convertvector(i1, f32x4) * (cv[bj][1] * rs);
                    if (t == 2) {
#pragma unroll
                        for (int j = 0; j < 4; ++j) vm4[j] = fmaxf(vm4[j], fmaxf(fabsf(v0[j]), fabsf(v1[j]))); }
                    u32x4 w; w.x = cvt_pk_bf16(v0[0], v0[1]); w.y = cvt_pk_bf16(v0[2], v0[3]); w.z = cvt_pk_bf16(v1[0], v1[1]); w.w = cvt_pk_bf16(v1[2], v1[3]);
                    *(u32x4*)(base + rowo + bj * HALF) = w; } }
        if (t == 2) { float vm = fmaxf(fmaxf(vm4[0], vm4[1]), fmaxf(vm4[2], vm4[3]));
#pragma unroll
            for (int o = 1; o < 64; o <<= 1) vm = fmaxf(vm, __shfl_xor(vm, o));
            if ((fr | fq) == 0) __hip_atomic_fetch_max(vmax + u.pm, __float_as_uint(vm), __ATOMIC_RELAXED, __HIP_MEMORY_SCOPE_AGENT); }
    }
};

__device__ __forceinline__ float o_scale_panels(unsigned* w, int first, int pm) {
    float t[16];
#pragma unroll
    for (int i = 0; i < 16; ++i) t[i] = __uint_as_float(__hip_atomic_load(w + first + i, __ATOMIC_RELAXED, __HIP_MEMORY_SCOPE_AGENT));
    float vm = 0.f;
#pragma unroll
    for (int i = 0; i < 16; ++i) vm = fmaxf(vm, (first + i <= pm) ? t[i] : 0.f);
    return vm > 0.f ? vm * (1.01f / 127.0f) : 1.0f;
}
struct EpiI8GateBf16 {
    static constexpr bool PERM = true, AFTER_DRAIN = false; static constexpr int BPERM = 1;
    bf16_t* O; int ldc; const float* gate; int gate_bstride; int rows_per_batch; const float* colscale; unsigned* vmax;
    __device__ __forceinline__ void operator()(const f32x4 (&acc)[2][2][4][2], const Unit& u, int wr, int wc, int fr, int fq) const {
        const int row0 = u.pm * BM + wr * 64 + fr, col0 = u.pn * BM + wc * 32 + 8 * fq;
        const float* gp = gate + (size_t)((u.pm * BM) / rows_per_batch) * gate_bstride;
        const float rs = o_scale_panels(vmax, u.pm - u.pm % (rows_per_batch / BM), u.pm);
        int colv = col0; asm volatile("" : "+v"(colv));
        f32x4 gv[2][2];
#pragma unroll
        for (int bj = 0; bj < 2; ++bj)
#pragma unroll
            for (int n = 0; n < 2; ++n) gv[bj][n] = *(const f32x4*)(gp + colv + bj * HALF + 4 * n) * *(const f32x4*)(colscale + colv + bj * HALF + 4 * n) * rs;
#pragma unroll
        for (int ai = 0; ai < 2; ++ai)
#pragma unroll
            for (int m = 0; m < 4; ++m) { bf16_t* rowp = O + (size_t)(row0 + ai * HALF + m * 16) * ldc + col0;
#pragma unroll
                for (int bj = 0; bj < 2; ++bj) { const i32x4 i0 = __builtin_bit_cast(i32x4, acc[ai][bj][m][0]), i1 = __builtin_bit_cast(i32x4, acc[ai][bj][m][1]);
                    const f32x4 v0 = __builtin_convertvector(i0, f32x4) * gv[bj][0], v1 = __builtin_convertvector(i1, f32x4) * gv[bj][1];
                    u32x4 w; w.x = cvt_pk_bf16(v0[0], v0[1]); w.y = cvt_pk_bf16(v0[2], v0[3]); w.z = cvt_pk_bf16(v1[0], v1[1]); w.w = cvt_pk_bf16(v1[2], v1[3]);
                    *(u32x4*)(rowp + bj * HALF) = w; } }
    }
};

struct EpiNull { static constexpr bool PERM = false, AFTER_DRAIN = false; static constexpr int BPERM = 0;
    __device__ __forceinline__ void operator()(const f32x4 (&acc)[2][2][4][2], const Unit& u, int wr, int wc, int fr, int fq) const {
#pragma unroll
        for (int ai = 0; ai < 2; ++ai)
#pragma unroll
            for (int m = 0; m < 4; ++m) asm volatile("" :: "v"(acc[ai][0][m][0]), "v"(acc[ai][0][m][1]), "v"(acc[ai][1][m][0]), "v"(acc[ai][1][m][1])); }
};

struct FixedOrder { int n;
    __device__ __forceinline__ bool next(int i, Unit& u) const { if (i >= n) return false; u.pm = 0; u.pn = 0; return true; }
    __device__ __forceinline__ void a_ready(const Unit&) const {}
    __device__ __forceinline__ void done(const Unit&) const {}
};
template <class Epi, class Sched, bool ALIGN_EPI = false, bool SP2 = false, int SKEL = 0, int ES = 2  , bool I8 = false    >
__device__ __forceinline__ void gemm_phase(PG8_LAS unsigned char* lds, const Gemm g, const Sched& S, const Epi& E) {
    typedef double f64x2v __attribute__((ext_vector_type(2)));
    int tid_ = threadIdx.x; asm volatile("" : "+v"(tid_));
    const int tid = tid_, wid = __builtin_amdgcn_readfirstlane(tid >> 6), lane = tid & 63, wr = wid >> 2, wc = wid & 3, fr = lane & 15, fq = lane >> 4;
    const int K = g.K, KB = K * ES  , nt = KB / (BK * 2);
    unsigned voffA[2], voffB[2], voffB1[2];
#pragma unroll
    for (int i = 0; i < 2; ++i) { int R, C; stage_rc(tid * 16 + i * 8192, R, C);
        voffA[i] = (unsigned)(R * KB + C * 2);
        if constexpr (Epi::BPERM == 2) { voffB[i] = (unsigned)(adj16_row(0, R) * KB + C * 2); voffB1[i] = (unsigned)(adj16_row(1, R) * KB + C * 2); }
        else { const int Rb = Epi::PERM ? ((R & ~31) + perm32(R & 31)) : R; voffB[i] = (unsigned)(Rb * KB + C * 2); voffB1[i] = voffB[i]; } }
    const unsigned bh1 = (Epi::BPERM == 2) ? 0u : (unsigned)HALF * (unsigned)KB;
    const unsigned kstep = (unsigned)(BK * 2);
    const unsigned hstep = (unsigned)HALF * (unsigned)KB;
    const unsigned tstep = 2u * hstep;
    const unsigned ldsw = (unsigned)wid * 1024u;
    const int aoff = lds_byte(wr * 64 + fr, fq * 8), boff = lds_byte(wc * 32 + fr, fq * 8);
#define PG8_SA(b, h) (((b) * 2 + (h)) * HTB)
#define PG8_SB(b, h) ((4 + (b) * 2 + (h)) * HTB)
#define PG8_STAGE_R(rsrc, bufoff, soff, voff) do { if constexpr (SKEL != 2 && SKEL != 3) { _Pragma("unroll") for (int _i = 0; _i < 2; ++_i) \
        __builtin_amdgcn_raw_ptr_buffer_load_lds(rsrc, (PG8_LAS void*)(lds + (bufoff) + ldsw + _i * 8192), 16, (int)(voff)[_i], (int)(soff), 0, 0); } } while (0)
#define PG8_LDA(dst, b, h) do { if constexpr (SKEL != 2 && SKEL != 4) { _Pragma("unroll") for (int m = 0; m < 4; ++m) _Pragma("unroll") for (int k = 0; k < 2; ++k) dst[m][k] = *(const PG8_LAS bf16x8*)(lds + PG8_SA(b, h) + aoff + m * 2048 + k * 1024); } } while (0)
#define PG8_LDB(dst, b, h) do { if constexpr (SKEL != 2 && SKEL != 4) { _Pragma("unroll") for (int n = 0; n < 2; ++n) _Pragma("unroll") for (int k = 0; k < 2; ++k) dst[n][k] = *(const PG8_LAS bf16x8*)(lds + PG8_SB(b, h) + boff + n * 2048 + k * 1024); } } while (0)
#define PG8_MMA(ai, bj, At, Bt) do { __builtin_amdgcn_s_setprio(1); if constexpr (ES == 2) { _Pragma("unroll") for (int m = 0; m < 4; ++m) _Pragma("unroll") for (int n = 0; n < 2; ++n) _Pragma("unroll") for (int k = 0; k < 2; ++k) \
        { if constexpr (SKEL != 1) acc[ai][bj][m][n] = __builtin_amdgcn_mfma_f32_16x16x32_bf16(Bt[n][k], At[m][k], acc[ai][bj][m][n], 0, 0, 0); else asm volatile("" :: "v"(Bt[n][k]), "v"(At[m][k])); } } \
      else if constexpr (I8) { _Pragma("unroll") for (int m = 0; m < 4; ++m) _Pragma("unroll") for (int n = 0; n < 2; ++n) _Pragma("unroll") for (int k = 0; k < 2; ++k) \
        acc[ai][bj][m][n] = __builtin_bit_cast(f32x4, __builtin_amdgcn_mfma_i32_16x16x64_i8(__builtin_bit_cast(i32x4, Bt[n][k]), __builtin_bit_cast(i32x4, At[m][k]), __builtin_bit_cast(i32x4, acc[ai][bj][m][n]), 0, 0, 0)); } \
      else { _Pragma("unroll") for (int m = 0; m < 4; ++m) _Pragma("unroll") for (int n = 0; n < 2; ++n) \
        mfma_fp8_tied(acc[ai][bj][m][n], frag32(Bt[n][0], Bt[n][1]), frag32(At[m][0], At[m][1]), scl1); } \
      __builtin_amdgcn_s_setprio(0); } while (0)
#define PG8_WAIT_V(n) asm volatile("s_waitcnt vmcnt(" #n ")" ::: "memory")
#define PG8_WAIT_L(n) asm volatile("s_waitcnt lgkmcnt(" #n ")" ::: "memory")
#define PG8_BAR __builtin_amdgcn_s_barrier()
#define PG8_SCHED __builtin_amdgcn_sched_barrier(0)
    int scl1 = 0x7F7F7F7F; if constexpr (ES == 1 && !I8) asm volatile("" : "+v"(scl1));
    Unit cur, nxt; int ui = 0;
    if (!S.next(0, cur)) return;
    f32x4 acc[2][2][4][2];
#pragma unroll
    for (int a = 0; a < 2; ++a)
#pragma unroll
        for (int b = 0; b < 2; ++b)
#pragma unroll
            for (int m = 0; m < 4; ++m)
#pragma unroll
                for (int n = 0; n < 2; ++n) acc[a][b][m][n] = (f32x4){0.f, 0.f, 0.f, 0.f};
    bf16x8 At[4][2], B0[2][2], B1[2][2];
    if constexpr (SKEL == 2 || SKEL == 4) {
#pragma unroll
        for (int m = 0; m < 4; ++m)
#pragma unroll
            for (int k = 0; k < 2; ++k) asm volatile("" : "=v"(At[m][k]));
#pragma unroll
        for (int n = 0; n < 2; ++n)
#pragma unroll
            for (int k = 0; k < 2; ++k) { asm volatile("" : "=v"(B0[n][k])); asm volatile("" : "=v"(B1[n][k])); } }
    unsigned cA = (unsigned)cur.pm * tstep, cB = (unsigned)cur.pn * tstep;
    const __amdgpu_buffer_rsrc_t rsA = __builtin_amdgcn_make_buffer_rsrc((void*)g.A, 0, (int)((unsigned)g.M * (unsigned)KB), 0x00020000), rsB = __builtin_amdgcn_make_buffer_rsrc((void*)g.Bt, 0, (int)((unsigned)g.N * (unsigned)KB), 0x00020000);
    __builtin_amdgcn_s_waitcnt(0x0F70);
    S.a_ready(cur);
    if constexpr (SP2) {
        PG8_STAGE_R(rsB, PG8_SB(0, 0), cB, voffB); PG8_STAGE_R(rsB, PG8_SB(0, 1), cB + bh1, voffB1); PG8_STAGE_R(rsA, PG8_SA(0, 0), cA, voffA); PG8_STAGE_R(rsA, PG8_SA(0, 1), cA + hstep, voffA);
        if (wr == 1) PG8_BAR;
        PG8_WAIT_V(2); PG8_BAR;
        PG8_STAGE_R(rsB, PG8_SB(1, 0), cB + kstep, voffB); PG8_STAGE_R(rsA, PG8_SA(1, 0), cA + kstep, voffA); PG8_STAGE_R(rsB, PG8_SB(1, 1), cB + bh1 + kstep, voffB1);
        PG8_WAIT_V(6); PG8_BAR;
    } else {
        PG8_STAGE_R(rsB, PG8_SB(0, 0), cB, voffB); PG8_STAGE_R(rsA, PG8_SA(0, 0), cA, voffA); PG8_STAGE_R(rsB, PG8_SB(0, 1), cB + bh1, voffB1); PG8_STAGE_R(rsA, PG8_SA(0, 1), cA + hstep, voffA);
        if (wr == 1) PG8_BAR;
        PG8_WAIT_V(4); PG8_BAR;
        PG8_STAGE_R(rsB, PG8_SB(1, 0), cB + kstep, voffB); PG8_STAGE_R(rsA, PG8_SA(1, 0), cA + kstep, voffA); PG8_STAGE_R(rsB, PG8_SB(1, 1), cB + bh1 + kstep, voffB1);
        PG8_WAIT_V(6); PG8_BAR;
    }
    for (;;) {
        const bool has_next = S.next(ui + 1, nxt);
        const unsigned nA = has_next ? (unsigned)nxt.pm * tstep : cA, nB = has_next ? (unsigned)nxt.pn * tstep : cB;
        for (int t = 0; t < nt; t += 2) {
            const bool last = (t == nt - 2);
            const unsigned a1 = cA + (unsigned)(t + 1) * kstep;
            const unsigned a2 = last ? nA : cA + (unsigned)(t + 2) * kstep, b2 = last ? nB : cB + (unsigned)(t + 2) * kstep;
            const unsigned a3 = a2 + kstep, b3 = b2 + kstep;
            if (last && has_next) S.a_ready(nxt);
            if constexpr (SP2) {
            PG8_LDB(B0, 0, 0); PG8_LDB(B1, 0, 1); PG8_SCHED; PG8_LDA(At, 0, 0); PG8_STAGE_R(rsA, PG8_SA(1, 1), a1 + hstep, voffA);
            PG8_WAIT_V(8); PG8_WAIT_L(0); PG8_BAR; PG8_MMA(0, 0, At, B0); PG8_MMA(0, 1, At, B1); PG8_BAR; PG8_SCHED;
            PG8_LDA(At, 0, 1); PG8_STAGE_R(rsB, PG8_SB(0, 0), b2, voffB); PG8_STAGE_R(rsB, PG8_SB(0, 1), b2 + bh1, voffB1); PG8_STAGE_R(rsA, PG8_SA(0, 0), a2, voffA);
            PG8_WAIT_V(8); PG8_WAIT_L(0); PG8_BAR; PG8_MMA(1, 0, At, B0); PG8_MMA(1, 1, At, B1); PG8_BAR; PG8_SCHED;
            PG8_LDB(B0, 1, 0); PG8_LDB(B1, 1, 1); PG8_SCHED; PG8_LDA(At, 1, 0); PG8_STAGE_R(rsA, PG8_SA(0, 1), a2 + hstep, voffA);
            PG8_WAIT_V(8); PG8_WAIT_L(0); PG8_BAR; PG8_MMA(0, 0, At, B0); PG8_MMA(0, 1, At, B1); PG8_BAR; PG8_SCHED;
            PG8_LDA(At, 1, 1); PG8_STAGE_R(rsB, PG8_SB(1, 0), b3, voffB); PG8_STAGE_R(rsB, PG8_SB(1, 1), b3 + bh1, voffB1); PG8_STAGE_R(rsA, PG8_SA(1, 0), a3, voffA);
            PG8_WAIT_V(8); PG8_WAIT_L(0); PG8_BAR; PG8_MMA(1, 0, At, B0); PG8_MMA(1, 1, At, B1); PG8_BAR; PG8_SCHED;
            } else {
            PG8_LDB(B0, 0, 0); PG8_SCHED; PG8_LDA(At, 0, 0); PG8_STAGE_R(rsA, PG8_SA(1, 1), a1 + hstep, voffA);
            PG8_WAIT_L(8); PG8_BAR; PG8_WAIT_L(0); PG8_MMA(0, 0, At, B0); PG8_BAR; PG8_SCHED;
            PG8_LDB(B1, 0, 1); PG8_STAGE_R(rsB, PG8_SB(0, 0), b2, voffB);
            PG8_BAR; PG8_WAIT_L(0); PG8_MMA(0, 1, At, B1); PG8_BAR;
            PG8_LDA(At, 0, 1); PG8_STAGE_R(rsA, PG8_SA(0, 0), a2, voffA);
            PG8_BAR; PG8_WAIT_L(0); PG8_MMA(1, 0, At, B0); PG8_BAR; PG8_SCHED;
            PG8_STAGE_R(rsB, PG8_SB(0, 1), b2 + bh1, voffB1);
            PG8_WAIT_V(6); PG8_BAR; PG8_MMA(1, 1, At, B1); PG8_BAR;
            PG8_LDB(B0, 1, 0); PG8_SCHED; PG8_LDA(At, 1, 0); PG8_STAGE_R(rsA, PG8_SA(0, 1), a2 + hstep, voffA);
            PG8_WAIT_L(8); PG8_BAR; PG8_WAIT_L(0); PG8_MMA(0, 0, At, B0); PG8_BAR; PG8_SCHED;
            PG8_LDB(B1, 1, 1); PG8_STAGE_R(rsB, PG8_SB(1, 0), b3, voffB);
            PG8_BAR; PG8_WAIT_L(0); PG8_MMA(0, 1, At, B1); PG8_BAR;
            PG8_LDA(At, 1, 1); PG8_STAGE_R(rsA, PG8_SA(1, 0), a3, voffA);
            PG8_BAR; PG8_WAIT_L(0); PG8_MMA(1, 0, At, B0); PG8_BAR; PG8_SCHED;
            PG8_STAGE_R(rsB, PG8_SB(1, 1), b3 + bh1, voffB1);
            PG8_WAIT_V(6); PG8_BAR; PG8_MMA(1, 1, At, B1); PG8_BAR;
            }
        }
        if constexpr (ALIGN_EPI) { if (wr == 0) PG8_BAR; }
        if constexpr (ES == 1 && !I8) asm volatile("s_nop 15\n\ts_nop 15" ::: "memory");
        if constexpr (!Epi::AFTER_DRAIN) { E(acc, cur, wr, wc, fr, fq); S.done(cur); }
        if (!has_next) break;
#pragma unroll
        for (int a = 0; a < 2; ++a)
#pragma unroll
            for (int b = 0; b < 2; ++b)
#pragma unroll
                for (int m = 0; m < 4; ++m)
#pragma unroll
                    for (int n = 0; n < 2; ++n) { double z0, z1; asm volatile("v_mov_b64 %0, 0\n\tv_mov_b64 %1, 0" : "=v"(z0), "=v"(z1)); const f64x2v zz = {z0, z1}; acc[a][b][m][n] = __builtin_bit_cast(f32x4, zz); }
        cur = nxt; cA = nA; cB = nB; ++ui;
        if constexpr (ALIGN_EPI) { if (wr == 1) PG8_BAR; }
    }
    PG8_WAIT_V(0);
    if constexpr (!ALIGN_EPI) { if (wr == 0) PG8_BAR; }
    PG8_BAR;
    if constexpr (Epi::AFTER_DRAIN) { E.fused(acc, cur, wr, wc, fr, fq, lds, wid, lane); S.done(cur); }
#undef PG8_SA
#undef PG8_SB
#undef PG8_STAGE_R
#undef PG8_LDA
#undef PG8_LDB
#undef PG8_MMA
#undef PG8_WAIT_V
#undef PG8_WAIT_L
#undef PG8_BAR
#undef PG8_SCHED
}


template <int ACT, bool HAS_BIAS> struct Epi32Bf16 {
    static constexpr bool PERM = true, AFTER_DRAIN = false; static_assert(ACT == 0 || ACT == 3, "Epi32Bf16: ACT is 0 (none) or 3 (squared relu)");
    bf16_t* O; int ldc; const float* bias; int split_cols; size_t split_stride;
    __device__ __forceinline__ void operator()(const f32x16 (&acc)[2][2][2], const Unit& u, int wr, int wc, int r32, int hi) const {
        const int row0 = u.pm * BM + wr * 64 + r32; int colt = u.pn * BM; bf16_t* base = O;
        if (split_cols) { const int t = colt / split_cols; base += (size_t)t * split_stride; colt -= t * split_cols; }
        const int col0 = colt + wc * 32 + 8 * hi, bcol0 = u.pn * BM + wc * 32 + 8 * hi;
        f32x4 bv[2][4];
        if constexpr (HAS_BIAS) {
#pragma unroll
            for (int bj = 0; bj < 2; ++bj)
#pragma unroll
                for (int q = 0; q < 4; ++q) bv[bj][q] = *(const f32x4*)(bias + bcol0 + bj * HALF + (q >> 1) * 16 + (q & 1) * 4);
        }
#pragma unroll
        for (int ai = 0; ai < 2; ++ai)
#pragma unroll
            for (int mb = 0; mb < 2; ++mb) { bf16_t* rowp = base + (size_t)(row0 + ai * HALF + mb * 32) * ldc + col0;
#pragma unroll
                for (int bj = 0; bj < 2; ++bj)
#pragma unroll
                    for (int t = 0; t < 2; ++t) { float v[8];
#pragma unroll
                        for (int j = 0; j < 8; ++j) { v[j] = acc[ai][bj][mb][8 * t + j]; if constexpr (HAS_BIAS) v[j] += bv[bj][2 * t + (j >> 2)][j & 3]; if (ACT == 3) { const float a = fmaxf(v[j], 0.f); v[j] = a * a; } }
                        u32x4 w; w.x = cvt_pk_bf16(v[0], v[1]); w.y = cvt_pk_bf16(v[2], v[3]); w.z = cvt_pk_bf16(v[4], v[5]); w.w = cvt_pk_bf16(v[6], v[7]);
                        store16_wt(rowp + bj * HALF + 16 * t, w); } }
    }
};
template <bool HAS_BIAS> struct Epi32GateBf16 {
    static constexpr bool PERM = true, AFTER_DRAIN = false;
    bf16_t* O; int ldc; const float* bias; const float* gate; int gate_bstride; int rows_per_batch;
    __device__ __forceinline__ void operator()(const f32x16 (&acc)[2][2][2], const Unit& u, int wr, int wc, int r32, int hi) const {
        const int row0 = u.pm * BM + wr * 64 + r32, col0 = u.pn * BM + wc * 32 + 8 * hi;
        const float* gp = gate + (size_t)((u.pm * BM) / rows_per_batch) * gate_bstride;
        f32x4 bv[2][4], gv[2][4];
#pragma unroll
        for (int bj = 0; bj < 2; ++bj)
#pragma unroll
            for (int q = 0; q < 4; ++q) { const int c = col0 + bj * HALF + (q >> 1) * 16 + (q & 1) * 4; if constexpr (HAS_BIAS) bv[bj][q] = *(const f32x4*)(bias + c); gv[bj][q] = *(const f32x4*)(gp + c); }
#pragma unroll
        for (int ai = 0; ai < 2; ++ai)
#pragma unroll
            for (int mb = 0; mb < 2; ++mb) { bf16_t* rowp = O + (size_t)(row0 + ai * HALF + mb * 32) * ldc + col0;
#pragma unroll
                for (int bj = 0; bj < 2; ++bj)
#pragma unroll
                    for (int t = 0; t < 2; ++t) { float v[8];
#pragma unroll
                        for (int j = 0; j < 8; ++j) { v[j] = acc[ai][bj][mb][8 * t + j]; if constexpr (HAS_BIAS) v[j] += bv[bj][2 * t + (j >> 2)][j & 3]; v[j] *= gv[bj][2 * t + (j >> 2)][j & 3]; }
                        u32x4 w; w.x = cvt_pk_bf16(v[0], v[1]); w.y = cvt_pk_bf16(v[2], v[3]); w.z = cvt_pk_bf16(v[4], v[5]); w.w = cvt_pk_bf16(v[6], v[7]);
                        store16_wt(rowp + bj * HALF + 16 * t, w); } }
    }
};
struct Epi32Null { static constexpr bool PERM = true, AFTER_DRAIN = false;
    __device__ __forceinline__ void operator()(const f32x16 (&acc)[2][2][2], const Unit& u, int wr, int wc, int r32, int hi) const {
#pragma unroll
        for (int ai = 0; ai < 2; ++ai)
#pragma unroll
            for (int bj = 0; bj < 2; ++bj) asm volatile("" :: "v"(acc[ai][bj][0]), "v"(acc[ai][bj][1])); }
};
template <class Epi, class Sched, bool ALIGN_EPI = false, bool SP2 = false, int SKEL = 0  >
__device__ __forceinline__ void gemm_phase32(PG8_LAS unsigned char* lds, const Gemm g, const Sched& S, const Epi& E) {
    int tid_ = threadIdx.x; asm volatile("" : "+v"(tid_));
    const int tid = tid_, wid = __builtin_amdgcn_readfirstlane(tid >> 6), lane = tid & 63, wr = wid >> 2, wc = wid & 3, r32 = lane & 31, hi = lane >> 5;
    const int K = g.K, nt = K / BK;
    unsigned voffA[2], voffB[2];
#pragma unroll
    for (int i = 0; i < 2; ++i) { int R, C; stage_rc2(tid * 16 + i * 8192, R, C); const int Rb = (R & ~31) + perm32b(R & 31);
        voffA[i] = (unsigned)(R * K + C) * 2u; voffB[i] = (unsigned)(Rb * K + C) * 2u; }
    const unsigned kstep = (unsigned)(BK * 2);
    const unsigned hstep = (unsigned)HALF * (unsigned)K * 2u;
    const unsigned tstep = 2u * hstep;
    const unsigned ldsw = (unsigned)wid * 1024u;
    const int aoff0 = lds_byte2(wr * 64 + r32, hi * 8), boff0 = lds_byte2(wc * 32 + r32, hi * 8); const int aoffs[2] = {aoff0, aoff0 ^ 32}, boffs[2] = {boff0, boff0 ^ 32};
#define PG8_SA(b, h) (((b) * 2 + (h)) * HTB)
#define PG8_SB(b, h) ((4 + (b) * 2 + (h)) * HTB)
#define PG8_STAGE_R(rsrc, bufoff, soff, voff) do { if constexpr (SKEL != 2) { _Pragma("unroll") for (int _i = 0; _i < 2; ++_i) \
        __builtin_amdgcn_raw_ptr_buffer_load_lds(rsrc, (PG8_LAS void*)(lds + (bufoff) + ldsw + _i * 8192), 16, (int)(voff)[_i], (int)(soff), 0, 0); } } while (0)
#define PG8_LDA(dst, b, h) do { if constexpr (SKEL != 2) { _Pragma("unroll") for (int m = 0; m < 2; ++m) _Pragma("unroll") for (int k = 0; k < 4; ++k) dst[m][k] = *(const PG8_LAS bf16x8*)(lds + PG8_SA(b, h) + aoffs[k & 1] + m * 4096 + (k >> 1) * 1024); } } while (0)
#define PG8_LDB(dst, b, h) do { if constexpr (SKEL != 2) { _Pragma("unroll") for (int k = 0; k < 4; ++k) dst[k] = *(const PG8_LAS bf16x8*)(lds + PG8_SB(b, h) + boffs[k & 1] + (k >> 1) * 1024); } } while (0)
#define PG8_MMA(ai, bj, At, Bt) do { __builtin_amdgcn_s_setprio(1); _Pragma("unroll") for (int k = 0; k < 4; ++k) _Pragma("unroll") for (int m = 0; m < 2; ++m) \
        { if constexpr (SKEL != 1) acc[ai][bj][m] = __builtin_amdgcn_mfma_f32_32x32x16_bf16(Bt[k], At[m][k], acc[ai][bj][m], 0, 0, 0); else asm volatile("" :: "v"(Bt[k]), "v"(At[m][k])); } __builtin_amdgcn_s_setprio(0); } while (0)
#define PG8_WAIT_V(n) asm volatile("s_waitcnt vmcnt(" #n ")" ::: "memory")
#define PG8_WAIT_L(n) asm volatile("s_waitcnt lgkmcnt(" #n ")" ::: "memory")
#define PG8_BAR __builtin_amdgcn_s_barrier()
#define PG8_SCHED __builtin_amdgcn_sched_barrier(0)
    Unit cur, nxt; int ui = 0;
    if (!S.next(0, cur)) return;
    f32x16 acc[2][2][2];
#pragma unroll
    for (int a = 0; a < 2; ++a)
#pragma unroll
        for (int b = 0; b < 2; ++b)
#pragma unroll
            for (int m = 0; m < 2; ++m) acc[a][b][m] = f32x16{};
    bf16x8 At[2][4], B0[4], B1[4];
    if constexpr (SKEL == 2) {
#pragma unroll
        for (int m = 0; m < 2; ++m)
#pragma unroll
            for (int k = 0; k < 4; ++k) asm volatile("" : "=v"(At[m][k]));
#pragma unroll
        for (int k = 0; k < 4; ++k) { asm volatile("" : "=v"(B0[k])); asm volatile("" : "=v"(B1[k])); } }
    unsigned cA = (unsigned)cur.pm * tstep, cB = (unsigned)cur.pn * tstep;
    const __amdgpu_buffer_rsrc_t rsA = __builtin_amdgcn_make_buffer_rsrc((void*)g.A, 0, (int)((unsigned)g.M * (unsigned)K * 2u), 0x00020000), rsB = __builtin_amdgcn_make_buffer_rsrc((void*)g.Bt, 0, (int)((unsigned)g.N * (unsigned)K * 2u), 0x00020000);
    S.a_ready(cur);
    if constexpr (SP2) {
        PG8_STAGE_R(rsB, PG8_SB(0, 0), cB, voffB); PG8_STAGE_R(rsB, PG8_SB(0, 1), cB + hstep, voffB); PG8_STAGE_R(rsA, PG8_SA(0, 0), cA, voffA); PG8_STAGE_R(rsA, PG8_SA(0, 1), cA + hstep, voffA);
        if (wr == 1) PG8_BAR;
        PG8_WAIT_V(2); PG8_BAR;
        PG8_STAGE_R(rsB, PG8_SB(1, 0), cB + kstep, voffB); PG8_STAGE_R(rsA, PG8_SA(1, 0), cA + kstep, voffA); PG8_STAGE_R(rsB, PG8_SB(1, 1), cB + hstep + kstep, voffB);
        PG8_WAIT_V(6); PG8_BAR;
    } else {
        PG8_STAGE_R(rsB, PG8_SB(0, 0), cB, voffB); PG8_STAGE_R(rsA, PG8_SA(0, 0), cA, voffA); PG8_STAGE_R(rsB, PG8_SB(0, 1), cB + hstep, voffB); PG8_STAGE_R(rsA, PG8_SA(0, 1), cA + hstep, voffA);
        if (wr == 1) PG8_BAR;
        PG8_WAIT_V(4); PG8_BAR;
        PG8_STAGE_R(rsB, PG8_SB(1, 0), cB + kstep, voffB); PG8_STAGE_R(rsA, PG8_SA(1, 0), cA + kstep, voffA); PG8_STAGE_R(rsB, PG8_SB(1, 1), cB + hstep + kstep, voffB);
        PG8_WAIT_V(6); PG8_BAR;
    }
    for (;;) {
        const bool has_next = S.next(ui + 1, nxt);
        const unsigned nA = has_next ? (unsigned)nxt.pm * tstep : cA, nB = has_next ? (unsigned)nxt.pn * tstep : cB;
        for (int t = 0; t < nt; t += 2) {
            const bool last = (t == nt - 2);
            const unsigned a1 = cA + (unsigned)(t + 1) * kstep;
            const unsigned a2 = last ? nA : cA + (unsigned)(t + 2) * kstep, b2 = last ? nB : cB + (unsigned)(t + 2) * kstep;
            const unsigned a3 = a2 + kstep, b3 = b2 + kstep;
            if (last && has_next) S.a_ready(nxt);
            if constexpr (SP2) {
            PG8_LDB(B0, 0, 0); PG8_LDB(B1, 0, 1); PG8_SCHED; PG8_LDA(At, 0, 0); PG8_STAGE_R(rsA, PG8_SA(1, 1), a1 + hstep, voffA);
            PG8_WAIT_V(8); PG8_WAIT_L(0); PG8_BAR; PG8_MMA(0, 0, At, B0); PG8_MMA(0, 1, At, B1); PG8_BAR; PG8_SCHED;
            PG8_LDA(At, 0, 1); PG8_STAGE_R(rsB, PG8_SB(0, 0), b2, voffB); PG8_STAGE_R(rsB, PG8_SB(0, 1), b2 + hstep, voffB); PG8_STAGE_R(rsA, PG8_SA(0, 0), a2, voffA);
            PG8_WAIT_V(8); PG8_WAIT_L(0); PG8_BAR; PG8_MMA(1, 0, At, B0); PG8_MMA(1, 1, At, B1); PG8_BAR; PG8_SCHED;
            PG8_LDB(B0, 1, 0); PG8_LDB(B1, 1, 1); PG8_SCHED; PG8_LDA(At, 1, 0); PG8_STAGE_R(rsA, PG8_SA(0, 1), a2 + hstep, voffA);
            PG8_WAIT_V(8); PG8_WAIT_L(0); PG8_BAR; PG8_MMA(0, 0, At, B0); PG8_MMA(0, 1, At, B1); PG8_BAR; PG8_SCHED;
            PG8_LDA(At, 1, 1); PG8_STAGE_R(rsB, PG8_SB(1, 0), b3, voffB); PG8_STAGE_R(rsB, PG8_SB(1, 1), b3 + hstep, voffB); PG8_STAGE_R(rsA, PG8_SA(1, 0), a3, voffA);
            PG8_WAIT_V(8); PG8_WAIT_L(0); PG8_BAR; PG8_MMA(1, 0, At, B0); PG8_MMA(1, 1, At, B1); PG8_BAR; PG8_SCHED;
            } else {
            PG8_LDB(B0, 0, 0); PG8_SCHED; PG8_LDA(At, 0, 0); PG8_STAGE_R(rsA, PG8_SA(1, 1), a1 + hstep, voffA);
            PG8_WAIT_L(8); PG8_BAR; PG8_WAIT_L(0); PG8_MMA(0, 0, At, B0); PG8_BAR; PG8_SCHED;
            PG8_LDB(B1, 0, 1); PG8_STAGE_R(rsB, PG8_SB(0, 0), b2, voffB);
            PG8_BAR; PG8_WAIT_L(0); PG8_MMA(0, 1, At, B1); PG8_BAR;
            PG8_LDA(At, 0, 1); PG8_STAGE_R(rsA, PG8_SA(0, 0), a2, voffA);
            PG8_BAR; PG8_WAIT_L(0); PG8_MMA(1, 0, At, B0); PG8_BAR; PG8_SCHED;
            PG8_STAGE_R(rsB, PG8_SB(0, 1), b2 + hstep, voffB);
            PG8_WAIT_V(6); PG8_BAR; PG8_MMA(1, 1, At, B1); PG8_BAR;
            PG8_LDB(B0, 1, 0); PG8_SCHED; PG8_LDA(At, 1, 0); PG8_STAGE_R(rsA, PG8_SA(0, 1), a2 + hstep, voffA);
            PG8_WAIT_L(8); PG8_BAR; PG8_WAIT_L(0); PG8_MMA(0, 0, At, B0); PG8_BAR; PG8_SCHED;
            PG8_LDB(B1, 1, 1); PG8_STAGE_R(rsB, PG8_SB(1, 0), b3, voffB);
            PG8_BAR; PG8_WAIT_L(0); PG8_MMA(0, 1, At, B1); PG8_BAR;
            PG8_LDA(At, 1, 1); PG8_STAGE_R(rsA, PG8_SA(1, 0), a3, voffA);
            PG8_BAR; PG8_WAIT_L(0); PG8_MMA(1, 0, At, B0); PG8_BAR; PG8_SCHED;
            PG8_STAGE_R(rsB, PG8_SB(1, 1), b3 + hstep, voffB);
            PG8_WAIT_V(6); PG8_BAR; PG8_MMA(1, 1, At, B1); PG8_BAR;
            }
        }
        if constexpr (ALIGN_EPI) { if (wr == 0) PG8_BAR; }
        if constexpr (!Epi::AFTER_DRAIN) { E(acc, cur, wr, wc, r32, hi); S.done(cur); }
        if (!has_next) break;
#pragma unroll
        for (int a = 0; a < 2; ++a)
#pragma unroll
            for (int b = 0; b < 2; ++b)
#pragma unroll
                for (int m = 0; m < 2; ++m) acc[a][b][m] = f32x16{};
        cur = nxt; cA = nA; cB = nB; ++ui;
        if constexpr (ALIGN_EPI) { if (wr == 1) PG8_BAR; }
    }
    PG8_WAIT_V(0);
    if constexpr (!ALIGN_EPI) { if (wr == 0) PG8_BAR; }
    PG8_BAR;
    static_assert(!Epi::AFTER_DRAIN, "gemm_phase32: no drained epilogues");
#undef PG8_SA
#undef PG8_SB
#undef PG8_STAGE_R
#undef PG8_LDA
#undef PG8_LDB
#undef PG8_MMA
#undef PG8_WAIT_V
#undef PG8_WAIT_L
#undef PG8_BAR
#undef PG8_SCHED
}
}

namespace sba {
using bf16x8 = __attribute__((ext_vector_type(8))) short;
using s16x4  = __attribute__((ext_vector_type(4))) short;
using f32x16 = __attribute__((ext_vector_type(16))) float;
using u32x4  = __attribute__((ext_vector_type(4))) unsigned;
typedef _Float16 f16x8 __attribute__((ext_vector_type(8)));
#define SBA_LAS __attribute__((address_space(3)))
constexpr int D = 128, NW = 8, QBLK = 32, KVBLK = 64, LDR = 2048, SEQ = 4096, NHEAD = 16, UNIT_ROWS = QBLK * NW;
constexpr int SHM_V = KVBLK * D * 2, SHM_K = KVBLK * D * 2;
constexpr int OFF_V = 0, OFF_K = 2 * SHM_V, OFF_FLAG = 2 * SHM_V + 2 * SHM_K, OFF_OST = OFF_FLAG + 128, LDS_BYTES = OFF_OST + NW * 4096;
constexpr float DEAD = -152.f;
constexpr float NEG = -30000.f;
#define SBA_KSWZ(row, colB) ((row) * 256 + ((colB) ^ (((row) & 7) << 4)))
#define SBA_SBAR() __builtin_amdgcn_sched_barrier(0)
__device__ __forceinline__ int crow(int r, int hi) { return (r & 3) + 8 * (r >> 2) + 4 * hi; }
__device__ __forceinline__ unsigned cvtpk(float lo, float hi) { unsigned r; asm volatile("v_cvt_pk_bf16_f32 %0, %1, %2" : "=v"(r) : "v"(lo), "v"(hi)); return r; }
__device__ __forceinline__ unsigned pkh(float lo, float hi) { return __builtin_bit_cast(unsigned, __builtin_amdgcn_cvt_pkrtz(lo, hi)); }
__device__ __forceinline__ int v_st(int k, int c) { const int kk = (k & ~0xC) | ((k & 4) << 1) | ((k & 8) >> 1); return ((kk >> 3) * 4 + (c >> 5)) * 512 + ((kk & 7) * 32 + (c & 31)) * 2; }
__device__ __forceinline__ int v_rd_base(int lane) { return ((lane & 3) << 3) | (((lane >> 2) & 3) << 6) | (((lane >> 4) & 1) << 5) | (((lane >> 5) & 1) << 8); }
constexpr int v_rd_off(int d0, int ks, int half) { return d0 * 512 + ks * 4096 + half * 2048; }
template <int OFF> __device__ __forceinline__ s16x4 tr_read(int vb) { s16x4 r; asm volatile("ds_read_b64_tr_b16 %0, %1 offset:%2" : "=&v"(r) : "v"(vb), "i"(OFF) : "memory"); return r; }
template <int D0> __device__ __forceinline__ void pv_one(f32x16& od, int vb, bf16x8 pa0, bf16x8 pa1, bf16x8 pa2, bf16x8 pa3) {
  const s16x4 l0 = tr_read<v_rd_off(D0, 0, 0)>(vb), h0 = tr_read<v_rd_off(D0, 0, 1)>(vb), l1 = tr_read<v_rd_off(D0, 1, 0)>(vb), h1 = tr_read<v_rd_off(D0, 1, 1)>(vb);
  const s16x4 l2 = tr_read<v_rd_off(D0, 2, 0)>(vb), h2 = tr_read<v_rd_off(D0, 2, 1)>(vb), l3 = tr_read<v_rd_off(D0, 3, 0)>(vb), h3 = tr_read<v_rd_off(D0, 3, 1)>(vb);
  asm volatile("s_waitcnt lgkmcnt(0)" ::: "memory"); SBA_SBAR();
#define SBA_PK(L, H) (bf16x8){L[0], L[1], L[2], L[3], H[0], H[1], H[2], H[3]}
  od = __builtin_amdgcn_mfma_f32_32x32x16_bf16(pa0, SBA_PK(l0, h0), od, 0, 0, 0);
  od = __builtin_amdgcn_mfma_f32_32x32x16_bf16(pa1, SBA_PK(l1, h1), od, 0, 0, 0);
  od = __builtin_amdgcn_mfma_f32_32x32x16_bf16(pa2, SBA_PK(l2, h2), od, 0, 0, 0);
  od = __builtin_amdgcn_mfma_f32_32x32x16_bf16(pa3, SBA_PK(l3, h3), od, 0, 0, 0);
#undef SBA_PK
}
__device__ __forceinline__ void qkt(f32x16& p0, f32x16& p1, const SBA_LAS char* Ks, const bf16x8* qr, int r32, int hi) {
  p0 = f32x16{}; p1 = f32x16{};
#pragma unroll
  for (int d0 = 0; d0 < 8; ++d0) { const int cb = (d0 * 16 + hi * 8) * 2;
    const bf16x8 b0 = *(const SBA_LAS bf16x8*)(Ks + SBA_KSWZ(r32, cb));
    const bf16x8 b1 = *(const SBA_LAS bf16x8*)(Ks + SBA_KSWZ(32 + r32, cb));
    p0 = __builtin_amdgcn_mfma_f32_32x32x16_bf16(b0, qr[d0], p0, 0, 0, 0);
    p1 = __builtin_amdgcn_mfma_f32_32x32x16_bf16(b1, qr[d0], p1, 0, 0, 0); }
}
__device__ __forceinline__ void sb_elem(float z, float& lb, float& l1) {
  const float e = __builtin_amdgcn_exp2f(-__builtin_fabsf(z));
  const float L = __builtin_amdgcn_logf(1.0f + e);
  lb = __builtin_amdgcn_fmed3f(z, 0.f, -3.0e38f) - L; l1 = lb - z;
}

__device__ __forceinline__ void attn_unit(int b, int h, int qb, const unsigned short* __restrict__ Q, const unsigned short* __restrict__ K, const unsigned short* __restrict__ V,
                                          signed char* __restrict__ O, float oinv, SBA_LAS char* lds) {
  int tid_ = threadIdx.x; asm volatile("" : "+v"(tid_));
  const int tid = tid_, wid = __builtin_amdgcn_readfirstlane(tid >> 6), lane = tid & 63, r32 = lane & 31, hi = lane >> 5;
  SBA_LAS char* V_lds = lds + OFF_V; SBA_LAS char* K_lds = lds + OFF_K; volatile SBA_LAS unsigned* flags = (volatile SBA_LAS unsigned*)(lds + OFF_FLAG);
  const long rowbase = (long)b * SEQ; const int q0 = qb * UNIT_ROWS;
  bf16x8 qr[8];
  { const unsigned short* Qw = Q + (rowbase + q0 + wid * QBLK + r32) * LDR + h * D + hi * 8;
#pragma unroll
    for (int d0 = 0; d0 < 8; ++d0) qr[d0] = *(const bf16x8*)(Qw + d0 * 16); }
  const unsigned short* Kh = K + rowbase * LDR + h * D; const unsigned short* Vh = V + rowbase * LDR + h * D;
  const int sr = tid >> 4, sc = (tid & 15) * 8, vst0 = v_st(sr, sc), vst1 = v_st(32 + sr, sc);
  const int vb0 = (int)(uintptr_t)V_lds + v_rd_base(lane);
  bf16x8 vs0, vs1, ks0, ks1;
#define SBA_SLOAD(k0) do { vs0 = *(const bf16x8*)(Vh + (long)((k0) + sr) * LDR + sc); vs1 = *(const bf16x8*)(Vh + (long)((k0) + 32 + sr) * LDR + sc); \
    ks0 = *(const bf16x8*)(Kh + (long)((k0) + sr) * LDR + sc); ks1 = *(const bf16x8*)(Kh + (long)((k0) + 32 + sr) * LDR + sc); } while (0)
#define SBA_SWRITE(bf) do { *(SBA_LAS bf16x8*)(V_lds + (bf) * SHM_V + vst0) = vs0; *(SBA_LAS bf16x8*)(V_lds + (bf) * SHM_V + vst1) = vs1; const int kc = sc * 2; \
    *(SBA_LAS bf16x8*)(K_lds + (bf) * SHM_K + SBA_KSWZ(sr, kc)) = ks0; *(SBA_LAS bf16x8*)(K_lds + (bf) * SHM_K + SBA_KSWZ(32 + sr, kc)) = ks1; } while (0)
  f16x8 U0, U1, ONES;
  { u32x4 w0, w1;
#pragma unroll
    for (int p = 0; p < 4; ++p) { const int ka = crow(2 * p, hi), kb = crow(2 * p + 1, hi), kc2 = crow(8 + 2 * p, hi), kd = crow(8 + 2 * p + 1, hi);
      w0[p] = (ka > r32 ? 0x3C00u : 0u) | (kb > r32 ? 0x3C000000u : 0u); w1[p] = (kc2 > r32 ? 0x3C00u : 0u) | (kd > r32 ? 0x3C000000u : 0u); }
    U0 = __builtin_bit_cast(f16x8, w0); U1 = __builtin_bit_cast(f16x8, w1);
    const u32x4 wo = {0x3C003C00u, 0x3C003C00u, 0x3C003C00u, 0x3C003C00u}; ONES = __builtin_bit_cast(f16x8, wo); }
  const int kt_top = 4 * qb + 3, my_kt = 4 * qb + (wid >> 1);
  const int ql = r32 + 32 * (wid & 1);
  float carry = 0.f; bool dead = false; f32x16 o[4] = {};
  SBA_SLOAD(kt_top * KVBLK); asm volatile("s_waitcnt vmcnt(0)" ::: "memory"); SBA_SWRITE(0); __syncthreads();
  for (int i = 0;; ++i) {
    const int kt = kt_top - i, cur = i & 1;
    if (kt > 0) SBA_SLOAD((kt - 1) * KVBLK);
    if (kt <= my_kt && !dead) {
      f32x16 p0, p1;
      qkt(p0, p1, K_lds + cur * SHM_K, qr, r32, hi);
      f32x16 lb0, lb1; float l10[16], l11[16];
#pragma unroll
      for (int r = 0; r < 16; ++r) { float a, c; sb_elem(p0[r], a, c); lb0[r] = a; l10[r] = c; sb_elem(p1[r], a, c); lb1[r] = a; l11[r] = c; }
      if (kt == my_kt) {
#pragma unroll
        for (int r = 0; r < 16; ++r) { const int k0 = crow(r, hi); const bool v0 = k0 < ql, v1 = (k0 + 32) < ql;
          l10[r] = v0 ? l10[r] : 0.f; lb0[r] = v0 ? lb0[r] : NEG; l11[r] = v1 ? l11[r] : 0.f; lb1[r] = v1 ? lb1[r] : NEG; }
      }
      const float lbk0 = lb0[0], l1k0 = l10[0];
      f16x8 h00, h01, h10, h11;
      { u32x4 a, c, e, g;
#pragma unroll
        for (int p = 0; p < 4; ++p) { a[p] = pkh(l10[2 * p], l10[2 * p + 1]); c[p] = pkh(l10[8 + 2 * p], l10[8 + 2 * p + 1]); e[p] = pkh(l11[2 * p], l11[2 * p + 1]); g[p] = pkh(l11[8 + 2 * p], l11[8 + 2 * p + 1]); }
        h00 = __builtin_bit_cast(f16x8, a); h01 = __builtin_bit_cast(f16x8, c); h10 = __builtin_bit_cast(f16x8, e); h11 = __builtin_bit_cast(f16x8, g); }
      lb1 = __builtin_amdgcn_mfma_f32_32x32x16_f16(U0, h10, lb1, 0, 0, 0); lb1 = __builtin_amdgcn_mfma_f32_32x32x16_f16(U1, h11, lb1, 0, 0, 0);
      lb0 = __builtin_amdgcn_mfma_f32_32x32x16_f16(U0, h00, lb0, 0, 0, 0); lb0 = __builtin_amdgcn_mfma_f32_32x32x16_f16(U1, h01, lb0, 0, 0, 0);
      lb0 = __builtin_amdgcn_mfma_f32_32x32x16_f16(ONES, h10, lb0, 0, 0, 0); lb0 = __builtin_amdgcn_mfma_f32_32x32x16_f16(ONES, h11, lb0, 0, 0, 0);
      float tot = (hi == 0) ? (lb0[0] - lbk0) + l1k0 : 0.f;
      { auto rr = __builtin_amdgcn_permlane32_swap(__float_as_uint(tot), __float_as_uint(tot), false, false); tot = __uint_as_float(rr[0]) + __uint_as_float(rr[1]); }
#pragma unroll
      for (int r = 0; r < 16; ++r) { lb0[r] = __builtin_amdgcn_exp2f(lb0[r] + carry); lb1[r] = __builtin_amdgcn_exp2f(lb1[r] + carry); }
      carry += tot;
      bf16x8 pa0, pa1, pa2, pa3;
#define SBA_PK4(P, BASE, OUT) do { unsigned a0 = cvtpk(P[BASE + 0], P[BASE + 1]), a1 = cvtpk(P[BASE + 2], P[BASE + 3]);   \
    unsigned b0 = cvtpk(P[BASE + 4], P[BASE + 5]), b1 = cvtpk(P[BASE + 6], P[BASE + 7]);                              \
    auto r0 = __builtin_amdgcn_permlane32_swap(a0, b0, false, false); auto r1 = __builtin_amdgcn_permlane32_swap(a1, b1, false, false); \
    u32x4 w = {r0[0], r1[0], r0[1], r1[1]}; OUT = __builtin_bit_cast(bf16x8, w); } while (0)
      SBA_PK4(lb0, 0, pa0); SBA_PK4(lb0, 8, pa1); SBA_PK4(lb1, 0, pa2); SBA_PK4(lb1, 8, pa3);
#undef SBA_PK4
      SBA_SBAR();
      const int vb = vb0 + cur * SHM_V;
      pv_one<0>(o[0], vb, pa0, pa1, pa2, pa3); pv_one<1>(o[1], vb, pa0, pa1, pa2, pa3); pv_one<2>(o[2], vb, pa0, pa1, pa2, pa3); pv_one<3>(o[3], vb, pa0, pa1, pa2, pa3);
      dead = !__any(carry > DEAD);
    }
    if (lane == 0) flags[cur * 8 + wid] = (kt > my_kt || !dead) ? 1u : 0u;
    if (kt > 0) { asm volatile("s_waitcnt vmcnt(0)" ::: "memory"); SBA_SWRITE(cur ^ 1); }
    __syncthreads();
    if (kt == 0) break;
    unsigned any = 0u;
#pragma unroll
    for (int w = 0; w < 8; ++w) any |= flags[cur * 8 + w];
    if (__builtin_amdgcn_readfirstlane(any) == 0u) break;
  }
  { signed char* Ow = O + (rowbase + q0 + wid * QBLK) * LDR + h * D; SBA_LAS signed char* stg = (SBA_LAS signed char*)(lds + OFF_OST) + wid * 4096;
#pragma unroll
    for (int r = 0; r < 16; ++r) { const int orow = crow(r, hi);
#pragma unroll
      for (int d0 = 0; d0 < 4; ++d0) { int q = __float2int_rn(o[d0][r] * oinv); q = q > 127 ? 127 : (q < -127 ? -127 : q); stg[orow * 128 + d0 * 32 + r32] = (signed char)q; } }
    asm volatile("s_waitcnt lgkmcnt(0)" ::: "memory");
#pragma unroll
    for (int i = 0; i < 4; ++i) { const int row = i * 8 + (lane >> 3), ch = lane & 7; const u32x4 v = *(const SBA_LAS u32x4*)(stg + row * 128 + ch * 16);
      *(u32x4*)(Ow + (long)row * LDR + ch * 16) = v; }
    asm volatile("s_waitcnt lgkmcnt(0)" ::: "memory");
  }
#undef SBA_SLOAD
#undef SBA_SWRITE
}
}
#define GAS __attribute__((address_space(1)))
#define LAS __attribute__((address_space(3)))
typedef unsigned short bf16;
typedef unsigned v4u __attribute__((ext_vector_type(4)));
typedef float f32x4 __attribute__((ext_vector_type(4)));
typedef short bf16x8 __attribute__((ext_vector_type(8)));
typedef GAS unsigned gu32;
typedef GAS unsigned long long gu64;
#define RLX_AGENT __ATOMIC_RELAXED, __HIP_MEMORY_SCOPE_AGENT
#define LDS_WAIT() asm volatile("s_waitcnt lgkmcnt(0)" ::: "memory")
#define VM_WAIT() asm volatile("s_waitcnt vmcnt(0)" ::: "memory")
__device__ __forceinline__ unsigned long long rt() { return __builtin_amdgcn_s_memrealtime(); }
__device__ __forceinline__ unsigned f2bf(float f) { unsigned u = __builtin_bit_cast(unsigned, f); return (u + 0x7fffu + ((u >> 16) & 1u)) >> 16; }
__device__ __forceinline__ unsigned pk2(float lo, float hi) { return f2bf(lo) | (f2bf(hi) << 16); }

#define XB_TMO      128
#define XB_XCNT(j)  (256  + 64 * (j))
#define XB_XSUB(j)  (1280 + 64 * (j))
#define XB_XGEN(j)  (2304 + 64 * (j))
#define XB_TOP      3328
#define XB_TOPGEN   3392
#define XCD_BAR_WORDS 3456
#define XB_SPIN_CAP (1u << 18)

__device__ __forceinline__ unsigned xb_ld(unsigned* p)              { return __hip_atomic_load(p, __ATOMIC_RELAXED, __HIP_MEMORY_SCOPE_AGENT); }
__device__ __forceinline__ unsigned xb_add(unsigned* p, unsigned v) { return __hip_atomic_fetch_add(p, v, __ATOMIC_RELAXED, __HIP_MEMORY_SCOPE_AGENT); }
__device__ __forceinline__ unsigned xb_xcc_id() { return (unsigned)__builtin_amdgcn_s_getreg((3 << 11) | 20) & 0xFu; }
#define XB_SPIN(cond, bar) do { unsigned _sp = 0; while (cond) { __builtin_amdgcn_s_sleep(1); \
    if ((++_sp & 255u) == 0u) { if (xb_ld(&(bar)[XB_TMO])) break; if (_sp > XB_SPIN_CAP) { atomicAdd(&(bar)[XB_TMO], 1u); break; } } } } while (0)

struct XcdBarrier {
    unsigned* bar; unsigned x;
    volatile LAS unsigned* st;
};

__device__ __forceinline__ XcdBarrier xcd_barrier_post(unsigned* bar, volatile LAS unsigned* st) {
    XcdBarrier b; b.bar = bar; b.x = xb_xcc_id(); b.st = st;
    if (threadIdx.x == 0) (void)xb_add(&bar[XB_XCNT(b.x)], 1u);
    return b;
}
__device__ __forceinline__ void xcd_barrier_complete(unsigned* bar, unsigned x, unsigned& nloc, unsigned& nx) {
    const unsigned G = gridDim.x * gridDim.y * gridDim.z;
    unsigned sum, cnt, mine, sp = 0u;
    for (;;) {
        sum = 0u; cnt = 0u; mine = 0u;
#pragma unroll
        for (unsigned j = 0; j < 16; ++j) { const unsigned c = xb_ld(&bar[XB_XCNT(j)]); sum += c; cnt += (c > 0u) ? 1u : 0u; mine = (j == x) ? c : mine; }
        if (sum == G) break;
        __builtin_amdgcn_s_sleep(1);
        if ((++sp & 255u) == 0u) { if (xb_ld(&bar[XB_TMO])) break; if (sp > XB_SPIN_CAP) { atomicAdd(&bar[XB_TMO], 1u); break; } }
    }
    nloc = mine > 0u ? mine : 1u; nx = cnt > 0u ? cnt : 1u;
}

__device__ __forceinline__ void xcd_barrier(const XcdBarrier& b) {
    asm volatile("s_waitcnt vmcnt(0)" ::: "memory");
    __syncthreads();
    if (threadIdx.x == 0) {
        unsigned* bar = b.bar;
        __builtin_amdgcn_s_waitcnt(0);
        unsigned nloc = b.st[0], nx = b.st[1];
        if (nloc == 0u) { xcd_barrier_complete(bar, b.x, nloc, nx); b.st[0] = nloc; b.st[1] = nx; }
        const unsigned old = xb_add(&bar[XB_XSUB(b.x)], 1u);
        const unsigned gen = old / nloc;
        if (old + 1u == (gen + 1u) * nloc) {
            __builtin_amdgcn_fence(__ATOMIC_RELEASE, "agent");
            asm volatile("s_waitcnt vmcnt(0)" ::: "memory");
            const unsigned og = xb_add(&bar[XB_TOP], 1u);
            const unsigned tg = og / nx;
            if (og + 1u == (tg + 1u) * nx) xb_add(&bar[XB_TOPGEN], 1u);
            else XB_SPIN(xb_ld(&bar[XB_TOPGEN]) == tg, bar);
            __builtin_amdgcn_fence(__ATOMIC_ACQUIRE, "agent");
            xb_add(&bar[XB_XGEN(b.x)], 1u);
            asm volatile("s_waitcnt vmcnt(0)" ::: "memory");
        } else {
            XB_SPIN(xb_ld(&bar[XB_XGEN(b.x)]) == gen, bar);
            __builtin_amdgcn_fence(__ATOMIC_ACQUIRE, "agent");
            asm volatile("s_waitcnt vmcnt(0)" ::: "memory");
        }
    }
    __syncthreads();
}

template <unsigned NG = 4u>
__device__ __forceinline__ void grp_barrier(unsigned* cnt, unsigned* mask, volatile LAS unsigned* ep, unsigned* bar, unsigned* nb_cnt = nullptr, unsigned* nb_mask = nullptr) {
    asm volatile("s_waitcnt vmcnt(0)" ::: "memory");
    __syncthreads();
    if (threadIdx.x == 0) {
        __builtin_amdgcn_s_waitcnt(0);
        const unsigned e = ep[0] + 1u; ep[0] = e;
        unsigned st = ep[1];
        if (st == 0u) { const unsigned m = xb_ld(mask); st = (m != 0u && (m & (m - 1u)) == 0u) ? 1u : 2u; ep[1] = st; }
        bool fast = (st == 1u);
        if (fast && nb_mask) fast = (xb_ld(nb_mask) == xb_ld(mask));
        if (!fast) { __builtin_amdgcn_fence(__ATOMIC_RELEASE, "agent"); asm volatile("s_waitcnt vmcnt(0)" ::: "memory"); }
        (void)xb_add(cnt, 1u);
        const unsigned target = NG * e;
        XB_SPIN(xb_ld(cnt) < target, bar);
        if (nb_cnt) XB_SPIN(xb_ld(nb_cnt) < target, bar);
        __builtin_amdgcn_fence(__ATOMIC_ACQUIRE, "agent");
        asm volatile("s_waitcnt vmcnt(0)" ::: "memory");
    }
    __syncthreads();
}

template <unsigned NG = 4u>
__device__ __forceinline__ void prefix_barrier(unsigned* cnt0, unsigned* mask0, int pm, int first, int last, volatile LAS unsigned* ep, unsigned* bar) {
    asm volatile("s_waitcnt vmcnt(0)" ::: "memory");
    __syncthreads();
    if (threadIdx.x < 64) {
        int lane_ = threadIdx.x; asm volatile("" : "+v"(lane_)); const int lane = lane_;
        __builtin_amdgcn_s_waitcnt(0);
        unsigned e = 0u;
        if (lane == 0) { e = ep[0] + 1u; ep[0] = e; }
        e = __builtin_amdgcn_readfirstlane(e);
        const unsigned own = xb_ld(mask0 + 64 * pm);
        const int g = first + lane;
        const unsigned mg = (g > pm && g <= last) ? xb_ld(mask0 + 64 * g) : own;
        const bool fast = (own != 0u) && ((own & (own - 1u)) == 0u) && __all(mg == own);
        if (!fast && lane == 0) { __builtin_amdgcn_fence(__ATOMIC_RELEASE, "agent"); asm volatile("s_waitcnt vmcnt(0)" ::: "memory"); }
        if (lane == 0) (void)xb_add(cnt0 + 64 * pm, 1u);
        const unsigned target = NG * e;
        unsigned sp = 0u;
        for (;;) {
            const unsigned v = (g <= pm) ? xb_ld(cnt0 + 64 * g) : target;
            if (__all(v >= target)) break;
            __builtin_amdgcn_s_sleep(1);
            if ((++sp & 255u) == 0u) { if (xb_ld(&bar[XB_TMO])) break; if (sp > XB_SPIN_CAP) { if (lane == 0) atomicAdd(&bar[XB_TMO], 1u); break; } }
        }
        __builtin_amdgcn_fence(__ATOMIC_ACQUIRE, "agent");
        asm volatile("s_waitcnt vmcnt(0)" ::: "memory");
    }
    __syncthreads();
}

constexpr int NWAVES = 8, NWAVES_ = 8;
constexpr int BATCH = 4, SEQ = 4096, DM = 2048, NH = 16, HD = 128, FF = 8192, DEPTH = 4, NMOD = 6;
constexpr int M = BATCH * SEQ;
constexpr int NMIX = 3 * DM;
constexpr float LN_EPS = 1e-5f;
constexpr float DN_ALPHA = 1.6817928305074290f;
constexpr float QSCALE = 0.088388347648318440f * 1.4426950408889634f;
constexpr float HID_SCALE = 32.0f, W2_SCALE = 128.0f;
constexpr int MODN = NMOD * DM;
constexpr int KSPLIT = 8;
constexpr size_t MiB = 1u << 20;
constexpr size_t WS_CTL = 0, CTL_ZERO_BYTES = 1 * MiB;
constexpr size_t WS_MODTAB = 1 * MiB;
constexpr size_t WS_PART = 2 * MiB;
constexpr size_t WS_W = 16 * MiB, W_LAYER = 96 * MiB, W_MIXIN = 0, W_MIXOUT = 24 * MiB, W_W1 = 32 * MiB, W_W2 = 64 * MiB;
constexpr size_t WS_H = 400 * MiB, WS_Q = 464 * MiB, WS_K = 528 * MiB, WS_V = 592 * MiB, WS_O = 656 * MiB;
constexpr size_t WS_HID = 720 * MiB, WS_END = 976 * MiB;
constexpr size_t WS_K2 = 912 * MiB, WS_V2 = 1040 * MiB, WS_G2 = 1104 * MiB  , WS_NEED = 1168 * MiB;
constexpr size_t WS_G = WS_HID + 128 * MiB;
constexpr size_t WS_Y = WS_Q;
constexpr size_t WS_X16 = 976 * MiB;
constexpr size_t WS_ROWS = 9 * MiB;
constexpr size_t WS_ROWSH = WS_ROWS + 64 * 1024;
constexpr size_t W_MIXOUT_CS = 4 * MiB;
constexpr size_t W_MIXIN_CS = 12 * MiB;
constexpr size_t W_W1_CS = 16 * MiB;
constexpr size_t WS_SCR = 1040 * MiB;
static_assert(WS_PART + (size_t)KSPLIT * DEPTH * BATCH * MODN * 4 <= WS_ROWS && WS_ROWS + (size_t)BATCH * SEQ * 4 <= WS_W && WS_W + DEPTH * W_LAYER <= WS_H && WS_HID + (size_t)M * FF * 2 <= WS_END, "d_ws map");
constexpr int CW_GMASK = 16384;
constexpr int CW_GRP = 8192;
constexpr int CW_A1 = 2048;
constexpr int CW_VMAX = 1024;
constexpr int CW_BAR = 4096;
constexpr int RING_OFF = 0, RING_BYTES = 131072;
constexpr int LDSCTL_OFF = RING_BYTES, MISC_OFF = LDSCTL_OFF + 320;
constexpr int LDS_BYTES = 147456;
static_assert(MISC_OFF + 128 <= LDS_BYTES && sba::LDS_BYTES <= RING_BYTES, "LDS map");

struct Frame {
    LAS unsigned char* lds;
    int tid, lane, wave, vcu, G, vrow;
};
template <int CTRL, int ROWMASK> __device__ __forceinline__ int dpp_i(int v) {
    return __builtin_amdgcn_update_dpp(0, v, CTRL, ROWMASK, 0xF, true);
}
__device__ __forceinline__ float wave_sum(float v) {
#define DPPF(C, R) __builtin_bit_cast(float, dpp_i<C, R>(__builtin_bit_cast(int, v)))
    v += DPPF(0xB1, 0xF); v += DPPF(0x4E, 0xF); v += DPPF(0x141, 0xF); v += DPPF(0x140, 0xF); v += DPPF(0x142, 0xA); v += DPPF(0x143, 0xC);
#undef DPPF
    return __builtin_bit_cast(float, __builtin_amdgcn_readlane(__builtin_bit_cast(int, v), 63));
}
__device__ __forceinline__ unsigned cvtpk_bf16(float lo, float hi) { unsigned r; asm volatile("v_cvt_pk_bf16_f32 %0, %1, %2" : "=v"(r) : "v"(lo), "v"(hi)); return r; }
__host__ __device__ __forceinline__ int conv_in_row(int n0) { if (n0 < DM) return 2 * DM + n0; if (n0 < 2 * DM) { const int j = n0 - DM; return 256 * (j / 128) + (j % 128); } const int j = n0 - 2 * DM; return 256 * (j / 128) + 128 + (j % 128); }
template <bool CONV_IN = false, bool FP8 = false>
__device__ __forceinline__ void p0_transpose_item(const float* W, int K, int N, bf16* WT, LAS float* scr, int item, int lane, int scaled_cols = 0, float scale = 1.f) {
    const int nblk = N / 32, kb = item / nblk, nb = item % nblk, k0 = 64 * kb, n0 = 32 * nb;
#pragma unroll 8
    for (int i = 0; i < 32; ++i) { const int kk = 2 * i + (lane >> 5); scr[kk * 33 + (lane & 31)] = __builtin_nontemporal_load(&W[(size_t)(k0 + kk) * N + n0 + (lane & 31)]); }
    LDS_WAIT(); asm volatile("" ::: "memory");
    const int c = lane & 7; const float sf = (n0 < scaled_cols) ? scale : 1.f;
#pragma unroll
    for (int j = 0; j < 4; ++j) { const int n = (lane >> 3) + 8 * j; const LAS float* s = scr + (8 * c) * 33 + n;
        if constexpr (FP8) { float t[8];
#pragma unroll
            for (int i = 0; i < 8; ++i) t[i] = fminf(fmaxf(s[i * 33] * sf, -448.0f), 448.0f);
            int p0 = 0, p1 = 0; p0 = __builtin_amdgcn_cvt_pk_fp8_f32(t[0], t[1], p0, false); p0 = __builtin_amdgcn_cvt_pk_fp8_f32(t[2], t[3], p0, true);
            p1 = __builtin_amdgcn_cvt_pk_fp8_f32(t[4], t[5], p1, false); p1 = __builtin_amdgcn_cvt_pk_fp8_f32(t[6], t[7], p1, true);
            uint2 o; o.x = (unsigned)p0; o.y = (unsigned)p1; *(uint2*)((unsigned char*)WT + (size_t)(n0 + n) * K + k0 + 8 * c) = o; }
        else {
        v4u o; o.x = cvtpk_bf16(s[0 * 33] * sf, s[1 * 33] * sf); o.y = cvtpk_bf16(s[2 * 33] * sf, s[3 * 33] * sf); o.z = cvtpk_bf16(s[4 * 33] * sf, s[5 * 33] * sf); o.w = cvtpk_bf16(s[6 * 33] * sf, s[7 * 33] * sf);
        *(v4u*)(WT + (size_t)((CONV_IN ? conv_in_row(n0) : n0) + n) * K + k0 + 8 * c) = o; } }
    LDS_WAIT(); asm volatile("" ::: "memory");
}

__device__ __forceinline__ void p0_w1_item(const float* W, int K, int N, signed char* WT8, float* cs, LAS float* scr, LAS float* red  , int item, int wave, int lane, int scaled_cols = 0, float cs_factor = 1.f) {
    const int n0 = 16 * item, c = lane & 15, kq = lane >> 4, kw = (K / NWAVES_) * wave;
    float mx = 0.f;
    for (int i = 0; i < K / NWAVES_ / 4; i += 16) { float t[16];
#pragma unroll
        for (int j = 0; j < 16; ++j) t[j] = W[(size_t)(kw + 4 * (i + j) + kq) * N + n0 + c];
#pragma unroll
        for (int j = 0; j < 16; ++j) mx = fmaxf(mx, fabsf(t[j])); }
    mx = fmaxf(mx, __shfl_xor(mx, 16)); mx = fmaxf(mx, __shfl_xor(mx, 32));
    if (lane < 16) red[wave * 16 + c] = mx;
    __syncthreads();
#pragma unroll
    for (int w = 0; w < NWAVES_; ++w) mx = fmaxf(mx, red[w * 16 + c]);
    const float sc = mx > 0.f ? mx * (1.0f / 127.0f) : 1.0f;
    if (wave == 0 && lane < 16) cs[n0 + c] = (n0 < scaled_cols) ? sc * cs_factor : sc;
    const int n = lane >> 2, kb = lane & 3; const float inv = 1.0f / __shfl(sc, n);
    for (int k0 = kw; k0 < kw + K / NWAVES_; k0 += 64) {
#pragma unroll
        for (int i = 0; i < 16; ++i) { const int kk = 4 * i + kq; scr[kk * 17 + c] = W[(size_t)(k0 + kk) * N + n0 + c]; }
        LDS_WAIT(); asm volatile("" ::: "memory");
        v4u o;
#pragma unroll
        for (int q = 0; q < 4; ++q) { unsigned w = 0;
#pragma unroll
            for (int j = 0; j < 4; ++j) { const int qv = __float2int_rn(scr[(16 * kb + 4 * q + j) * 17 + n] * inv); w |= ((unsigned)qv & 0xffu) << (8 * j); }
            o[q] = w; }
        *(v4u*)(WT8 + (size_t)(n0 + n) * K + k0 + 16 * kb) = o;
        LDS_WAIT(); asm volatile("" ::: "memory");
    }
    __syncthreads();
}
struct Args { const float* in[16]; float* out; unsigned char* ws; int ph_lo, ph_hi; };
constexpr int NPHASE = 2 + 7 * DEPTH;

__device__ __forceinline__ void phase_prologue_a(Frame& F, const Args& a, int lay_lo, int lay_hi, int rank, int nrank, bool with_gemv, int tr_shift = 0) {
    const int gw = rank * NWAVES + F.wave, NGW = nrank * NWAVES;
    LAS float* sil = (LAS float*)(F.lds + 69632);
    if (with_gemv) {
    for (int e = F.tid; e < BATCH * DM; e += NWAVES * 64) { const int b = e / DM, k = e % DM; const float cv = a.in[1][e]; sil[k * 4 + b] = cv / (1.0f + __expf(-cv)); }
    __syncthreads();
    constexpr int MCB = 192, NMCB = MODN / MCB;
    for (int task = gw; task < DEPTH * NMCB * KSPLIT; task += NGW) {
        const int l = task / (NMCB * KSPLIT), rem = task % (NMCB * KSPLIT), cb = rem / KSPLIT, kc = rem % KSPLIT;
        if (F.lane < MCB / 4) {
        const float* W = a.in[2] + (size_t)l * DM * MODN + (size_t)(kc * 256) * MODN + cb * MCB + 4 * F.lane;
        f32x4 acc0 = {0.f, 0.f, 0.f, 0.f}, acc1 = acc0, acc2 = acc0, acc3 = acc0;
        for (int k0 = 0; k0 < 256; k0 += 8) {
            f32x4 w[8];
#pragma unroll
            for (int j = 0; j < 8; ++j) w[j] = __builtin_nontemporal_load((const f32x4*)(W + (size_t)(k0 + j) * MODN));
#pragma unroll
            for (int j = 0; j < 8; ++j) { const f32x4 s = *(const LAS f32x4*)(sil + (kc * 256 + k0 + j) * 4); acc0 += w[j] * s[0]; acc1 += w[j] * s[1]; acc2 += w[j] * s[2]; acc3 += w[j] * s[3]; }
        }
        float* P = (float*)(a.ws + WS_PART) + ((size_t)(kc * DEPTH + l) * BATCH) * MODN + cb * MCB + 4 * F.lane;
        *(f32x4*)(P) = acc0; *(f32x4*)(P + MODN) = acc1; *(f32x4*)(P + 2 * MODN) = acc2; *(f32x4*)(P + 3 * MODN) = acc3;
        }
    }
    }
    LAS float* scr = (LAS float*)(F.lds + F.wave * 8704);
    constexpr int I_IN = (DM / 64) * (NMIX / 32), I_OUT = (DM / 64) * (DM / 32), I_2 = (FF / 64) * (DM / 32), I_LAYER = I_IN + I_OUT + I_2;
    for (int it = lay_lo * I_LAYER + (lay_lo ? tr_shift : 0) + gw; it < lay_hi * I_LAYER + (lay_hi < DEPTH ? tr_shift : 0); it += NGW) {
        const int l = it / I_LAYER; int r = it % I_LAYER; const int j = l >> 1;
        bf16* wl = (bf16*)(a.ws + WS_W + (size_t)l * W_LAYER);
        if (r < I_IN) { if (l & 1) p0_transpose_item<true>(a.in[8] + (size_t)j * DM * NMIX, DM, NMIX, (bf16*)((unsigned char*)wl + W_MIXIN), scr, r, F.lane); continue; }     r -= I_IN;
        if (r < I_OUT) { if (l & 1) p0_transpose_item(a.in[11] + (size_t)j * DM * DM, DM, DM, (bf16*)((unsigned char*)wl + W_MIXOUT), scr, r, F.lane); continue; }     r -= I_OUT;
        p0_transpose_item<false, true>(a.in[14] + (size_t)l * FF * DM, FF, DM, (bf16*)((unsigned char*)wl + W_W2), scr, r, F.lane, DM, W2_SCALE);
    }
    LAS float* red = (LAS float*)(F.lds + 102400);
    for (int it = rank; it < (DEPTH / 2) * (NMIX / 16); it += nrank) { const int ja = it / (NMIX / 16), r = it % (NMIX / 16); if (2 * ja < lay_lo || 2 * ja >= lay_hi) continue; unsigned char* wq = a.ws + WS_W + (size_t)(2 * ja) * W_LAYER + W_MIXIN;
        p0_w1_item(a.in[6] + (size_t)ja * DM * NMIX, DM, NMIX, (signed char*)wq, (float*)(wq + W_MIXIN_CS), scr, red, r, F.wave, F.lane, DM, QSCALE); }
    for (int it = rank; it < (DEPTH / 2) * (DM / 16); it += nrank) { const int ja = it / (DM / 16), r = it % (DM / 16); if (2 * ja < lay_lo || 2 * ja >= lay_hi) continue; unsigned char* wo = a.ws + WS_W + (size_t)(2 * ja) * W_LAYER + W_MIXOUT;
        p0_w1_item(a.in[7] + (size_t)ja * DM * DM, DM, DM, (signed char*)wo, (float*)(wo + W_MIXOUT_CS), scr, red, r, F.wave, F.lane); }
    for (int it = lay_lo * (FF / 16) + rank; it < lay_hi * (FF / 16); it += nrank) { const int l = it / (FF / 16), r = it % (FF / 16); unsigned char* w1 = a.ws + WS_W + (size_t)l * W_LAYER + W_W1;
        p0_w1_item(a.in[12] + (size_t)l * DM * FF, DM, FF, (signed char*)w1, (float*)(w1 + W_W1_CS), scr, red, r, F.wave, F.lane); }
}
typedef unsigned u32x2v __attribute__((ext_vector_type(2)));
__device__ __forceinline__ uint2 ld_nt_u2(const void* p) { const u32x2v v = __builtin_nontemporal_load((const u32x2v*)p); uint2 r; r.x = v[0]; r.y = v[1]; return r; }
__device__ __forceinline__ void st_nt_u2(void* p, const uint2 w) { const u32x2v v = {w.x, w.y}; __builtin_nontemporal_store(v, (u32x2v*)p); }
constexpr float QMAGIC = 12582912.0f;
__device__ __forceinline__ unsigned lo16x2(float z0, float z1) { return (__float_as_uint(z0) & 0xffffu) | (__float_as_uint(z1) << 16); }
__device__ __forceinline__ unsigned lo8x4(const f32x4 z) { const float z0 = z.x, z1 = z.y, z2 = z.z, z3 = z.w;
    return (__float_as_uint(z0) & 0xffu) | ((__float_as_uint(z1) & 0xffu) << 8) | ((__float_as_uint(z2) & 0xffu) << 16) | (__float_as_uint(z3) << 24); }
__device__ __forceinline__ uint2 q16_pack(const f32x4 v, float inv) {
    const f32x4 iv = {inv, inv, inv, inv}, mg = {QMAGIC, QMAGIC, QMAGIC, QMAGIC}; const f32x4 z = __builtin_elementwise_fma(v, iv, mg);
    const float z0 = z.x, z1 = z.y, z2 = z.z, z3 = z.w; uint2 w; w.x = lo16x2(z0, z1); w.y = lo16x2(z2, z3); return w;
}
__device__ __forceinline__ f32x4 q16_unpack(const uint2 w, float sc) {
    const f32x4 v = {(float)((int)(w.x << 16) >> 16), (float)((int)w.x >> 16), (float)((int)(w.y << 16) >> 16), (float)((int)w.y >> 16)}; return v * sc;
}
__device__ __forceinline__ float wave_max(float v) {
    unsigned u = __builtin_bit_cast(unsigned, v);
#define DPPU(C, R) (unsigned)dpp_i<C, R>((int)u)
    { unsigned t = DPPU(0xB1, 0xF); u = u > t ? u : t; } { unsigned t = DPPU(0x4E, 0xF); u = u > t ? u : t; } { unsigned t = DPPU(0x141, 0xF); u = u > t ? u : t; }
    { unsigned t = DPPU(0x140, 0xF); u = u > t ? u : t; } { unsigned t = DPPU(0x142, 0xA); u = u > t ? u : t; } { unsigned t = DPPU(0x143, 0xC); u = u > t ? u : t; }
#undef DPPU
    return __builtin_bit_cast(float, __builtin_amdgcn_readlane((int)u, 63));
}
__device__ __forceinline__ void phase_prologue_b(Frame& F, const Args& a) {
    const float* part = (const float*)(a.ws + WS_PART); float* modtab = (float*)(a.ws + WS_MODTAB); const float* mod_b = a.in[3];
    for (int e = F.vcu * NWAVES * 64 + F.tid; e < DEPTH * BATCH * MODN; e += F.G * NWAVES * 64) {
        const int l = e / (BATCH * MODN), rem = e % (BATCH * MODN), b = rem / MODN, n = rem % MODN;
        float s = mod_b[l * MODN + n];
#pragma unroll
        for (int kc = 0; kc < KSPLIT; ++kc) s += part[((size_t)(kc * DEPTH + l) * BATCH + b) * MODN + n];
        if ((n / DM) % 3 != 0) s += 1.0f;
        modtab[e] = s;
    }
    const int rows_wg = M / F.G, row0 = F.vrow * rows_wg, b = row0 / SEQ;
    LAS float* ST = (LAS float*)(F.lds);
    for (int c = F.tid; c < 2 * DM; c += NWAVES * 64) {
        float s = mod_b[c];
#pragma unroll
        for (int kc = 0; kc < KSPLIT; ++kc) s += part[((size_t)(kc * DEPTH + 0) * BATCH + b) * MODN + c];
        ST[c] = (c >= DM) ? s + 1.0f : s;
    }
    __syncthreads();
    const int rows_wave = rows_wg / NWAVES;
    f32x4 Sv0[8], Tv0[8];
#pragma unroll
    for (int j = 0; j < 8; ++j) { Tv0[j] = *(const LAS f32x4*)(ST + 4 * F.lane + 256 * j); Sv0[j] = *(const LAS f32x4*)(ST + DM + 4 * F.lane + 256 * j); }
    f32x4 xn[8];
    { const float* x0 = a.in[0] + ((size_t)row0 + F.wave * rows_wave) * DM;
#pragma unroll
      for (int j = 0; j < 8; ++j) xn[j] = __builtin_nontemporal_load((const f32x4*)(x0 + 4 * F.lane + 256 * j)); }
    for (int r = 0; r < rows_wave; ++r) {
        const size_t row = (size_t)row0 + F.wave * rows_wave + r;
        const float* xr = a.in[0] + row * DM; short* qr = (short*)(a.ws + WS_X16) + row * DM; unsigned char* hr = a.ws + WS_H + row * DM;
        f32x4 v[8]; float mx = 0.f;
#pragma unroll
        for (int j = 0; j < 8; ++j) { v[j] = xn[j]; mx = fmaxf(fmaxf(mx, fmaxf(fabsf(v[j][0]), fabsf(v[j][1]))), fmaxf(fabsf(v[j][2]), fabsf(v[j][3]))); }
        if (r + 1 < rows_wave) {
#pragma unroll
            for (int j = 0; j < 8; ++j) xn[j] = __builtin_nontemporal_load((const f32x4*)(xr + DM + 4 * F.lane + 256 * j)); }
        mx = wave_max(mx); const float rs = mx > 0.f ? mx * (1.0f / 32767.0f) : 1.0f, inv = 1.0f / rs;
        if (F.lane == 0) ((float*)(a.ws + WS_ROWS))[row] = rs;
        f32x4 hv[8]; float mh = 0.f;
#pragma unroll
        for (int j = 0; j < 8; ++j) { const int col = 4 * F.lane + 256 * j;
            hv[j] = v[j] * Sv0[j] + Tv0[j];
            mh = fmaxf(fmaxf(mh, fmaxf(fabsf(hv[j][0]), fabsf(hv[j][1]))), fmaxf(fabsf(hv[j][2]), fabsf(hv[j][3])));
            st_nt_u2(qr + col, q16_pack(v[j], inv)); }
        mh = wave_max(mh); const float hs = mh > 0.f ? mh * (1.0f / 127.0f) : 1.0f, hinv = 1.0f / hs;
        if (F.lane == 0) ((float*)(a.ws + WS_ROWSH))[row] = hs;
        signed char* h8 = (signed char*)hr;
#pragma unroll
        for (int j = 0; j < 8; ++j) { const f32x4 iv = {hinv, hinv, hinv, hinv}, mg = {QMAGIC, QMAGIC, QMAGIC, QMAGIC}; const unsigned w = lo8x4(__builtin_elementwise_fma(hv[j], iv, mg));
            *(unsigned*)(h8 + 4 * F.lane + 256 * j) = w; }
    }
}
__device__ __forceinline__ void phase_ln(Frame& F, const Args& a, const bf16* Y, const float* lg, const float* lb, const float* Tn, const float* Sn, bool write_h, long xo_off = 0, long ho_off = 0, long qo_off = 0, bool h_int8 = false) {
    const int rows_wg = M / F.G, row0 = F.vrow * rows_wg, b = row0 / SEQ, rows_wave = rows_wg / NWAVES;
    LAS float* ST = (LAS float*)(F.lds);
    for (int c = F.tid; c < DM; c += NWAVES * 64) { ST[c] = Sn[(size_t)b * MODN + c]; ST[DM + c] = Tn[(size_t)b * MODN + c]; ST[2 * DM + c] = lg[c]; ST[3 * DM + c] = lb[c]; }
    __syncthreads();
    f32x4 Sv[8], Tv[8];
#pragma unroll
    for (int j = 0; j < 8; ++j) { Sv[j] = *(const LAS f32x4*)(ST + 4 * F.lane + 256 * j); Tv[j] = *(const LAS f32x4*)(ST + DM + 4 * F.lane + 256 * j); }
#define g4_(j) (*(const LAS f32x4*)(ST + 2 * DM + 4 * F.lane + 256 * (j)))
#define b4_(j) (*(const LAS f32x4*)(ST + 3 * DM + 4 * F.lane + 256 * (j)))
    uint2 yw[8], xw[8]; float rs_raw;
    { const size_t row = (size_t)row0 + F.wave * rows_wave; const bf16* yr = Y + row * DM; const short* qr = (const short*)(a.ws + WS_X16) + row * DM;
#pragma unroll
      for (int j = 0; j < 8; ++j) { yw[j] = ld_nt_u2((yr + 4 * F.lane + 256 * j)); xw[j] = ld_nt_u2((qr + 4 * F.lane + 256 * j)); }
      rs_raw = ((const float*)(a.ws + WS_ROWS))[row]; }
    for (int r = 0; r < rows_wave; ++r) {
        const size_t row = (size_t)row0 + F.wave * rows_wave + r;
        float* xr = a.out + row * DM; short* qr = (short*)(a.ws + WS_X16) + row * DM; bf16* hr = (bf16*)(a.ws + WS_H) + row * DM;
        float* rsp = (float*)(a.ws + WS_ROWS) + row; const float rs_in = rs_raw * DN_ALPHA;
        f32x4 v[8]; f32x4 sv = {0.f, 0.f, 0.f, 0.f};
#pragma unroll
        for (int j = 0; j < 8; ++j) { const f32x4 yv = {__uint_as_float(yw[j].x << 16), __uint_as_float(yw[j].x & 0xffff0000u), __uint_as_float(yw[j].y << 16), __uint_as_float(yw[j].y & 0xffff0000u)};
            v[j] = q16_unpack(xw[j], rs_in) + yv; sv += v[j]; }
        const float s = (sv[0] + sv[1]) + (sv[2] + sv[3]);
        if (r + 1 < rows_wave) { const bf16* yn = Y + (row + 1) * DM; const short* qn = (const short*)(a.ws + WS_X16) + (row + 1) * DM;
#pragma unroll
            for (int j = 0; j < 8; ++j) { yw[j] = ld_nt_u2((yn + 4 * F.lane + 256 * j)); xw[j] = ld_nt_u2((qn + 4 * F.lane + 256 * j)); }
            rs_raw = ((const float*)(a.ws + WS_ROWS))[row + 1]; }
        const float mean = wave_sum(s) * (1.0f / DM); f32x4 s2v = {0.f, 0.f, 0.f, 0.f};
#pragma unroll
        for (int j = 0; j < 8; ++j) { v[j] = v[j] - mean; s2v = __builtin_elementwise_fma(v[j], v[j], s2v); }
        const float s2 = (s2v[0] + s2v[1]) + (s2v[2] + s2v[3]);
        const float rstd = __builtin_amdgcn_rsqf(wave_sum(s2) * (1.0f / DM) + LN_EPS);
        if (!write_h) {
#pragma unroll
            for (int j = 0; j < 8; ++j) { const int col = 4 * F.lane + 256 * j; __builtin_nontemporal_store((v[j] * rstd) * g4_(j) + b4_(j), (f32x4*)(xr + xo_off + col)); }
        } else {
            float mx = 0.f;
            if (h_int8) {
                float mh = 0.f;
#pragma unroll
                for (int j = 0; j < 8; ++j) { v[j] = (v[j] * rstd) * g4_(j) + b4_(j); const f32x4 hv = v[j] * Sv[j] + Tv[j];
                    mx = fmaxf(fmaxf(mx, fmaxf(fabsf(v[j][0]), fabsf(v[j][1]))), fmaxf(fabsf(v[j][2]), fabsf(v[j][3])));
                    mh = fmaxf(fmaxf(mh, fmaxf(fabsf(hv[0]), fabsf(hv[1]))), fmaxf(fabsf(hv[2]), fabsf(hv[3]))); if (j & 1) asm volatile("" ::: "memory"); }
                mh = wave_max(mh); const float hs = mh > 0.f ? mh * (1.0f / 127.0f) : 1.0f, hinv = __builtin_amdgcn_rcpf(hs);
                if (F.lane == 0 && qo_off == 0) ((float*)(a.ws + WS_ROWSH))[row] = hs;
                signed char* h8 = (signed char*)(a.ws + WS_H) + row * DM + ho_off;
#pragma unroll
                for (int j = 0; j < 8; ++j) { const f32x4 iv = {hinv, hinv, hinv, hinv}, mg = {QMAGIC, QMAGIC, QMAGIC, QMAGIC}; const f32x4 hq = __builtin_elementwise_fma(v[j] * Sv[j] + Tv[j], iv, mg);
                    const unsigned w = lo8x4(hq);
                    *(unsigned*)(h8 + 4 * F.lane + 256 * j) = w; if (j & 1) asm volatile("" ::: "memory"); }
            } else {
#pragma unroll
            for (int j = 0; j < 8; ++j) { v[j] = (v[j] * rstd) * g4_(j) + b4_(j); const f32x4 hv = v[j] * Sv[j] + Tv[j];
                mx = fmaxf(fmaxf(mx, fmaxf(fabsf(v[j][0]), fabsf(v[j][1]))), fmaxf(fabsf(v[j][2]), fabsf(v[j][3])));
                uint2 w; w.x = cvtpk_bf16(hv[0], hv[1]); w.y = cvtpk_bf16(hv[2], hv[3]); *(uint2*)(hr + ho_off + 4 * F.lane + 256 * j) = w; }
            }
            mx = wave_max(mx); const float rs = mx > 0.f ? mx * (1.0f / 32767.0f) : 1.0f, inv = __builtin_amdgcn_rcpf(rs);
            if (F.lane == 0 && qo_off == 0) *rsp = rs;
#pragma unroll
            for (int j = 0; j < 8; ++j) st_nt_u2(qr + qo_off + 4 * F.lane + 256 * j, q16_pack(v[j], inv));
        }
    }
}
#undef g4_
#undef b4_
__device__ __forceinline__ void bf8_to_f32(const bf16x8 v, float (&f)[8]) {
#pragma unroll
    for (int i = 0; i < 8; ++i) f[i] = __uint_as_float(((unsigned)(unsigned short)v[i]) << 16);
}
__device__ __forceinline__ void phase_conv(Frame& F, const Args& a, const float* cw, const float* cb, const bf16* Gg) {
    const bf16* Bg = (const bf16*)(a.ws + WS_Q); bf16* Out = (bf16*)(a.ws + WS_O);
    constexpr int TT = 8; const int rows_wg = M / F.G, ntask = (rows_wg / TT) * (DM / 8);
    for (int task = F.tid; task < ntask; task += NWAVES * 64) {
        const int chunk = task & (DM / 8 - 1), run = F.vrow * (rows_wg / TT) + task / (DM / 8), ch0 = chunk * 8, m0 = run * TT; const bool first = (m0 % SEQ) == 0;
        float w0[8], w1[8], w2[8], bb[8];
#pragma unroll
        for (int i = 0; i < 8; ++i) { w0[i] = cw[ch0 + i]; w1[i] = cw[DM + ch0 + i]; w2[i] = cw[2 * DM + ch0 + i]; bb[i] = cb[ch0 + i]; }
        float g2[8], g1[8];
        if (first) {
#pragma unroll
            for (int i = 0; i < 8; ++i) { g2[i] = 0.f; g1[i] = 0.f; }
        } else { bf8_to_f32(*(const bf16x8*)(Gg + (size_t)(m0 - 2) * DM + ch0), g2); bf8_to_f32(*(const bf16x8*)(Gg + (size_t)(m0 - 1) * DM + ch0), g1); }
        bf16x8 gr[TT], br[TT];
#pragma unroll
        for (int t = 0; t < TT; ++t) { gr[t] = __builtin_nontemporal_load((const bf16x8*)(Gg + (size_t)(m0 + t) * DM + ch0)); br[t] = __builtin_nontemporal_load((const bf16x8*)(Bg + (size_t)(m0 + t) * DM + ch0)); }
#pragma unroll
        for (int t = 0; t < TT; ++t) {
            float bg[8], g0[8], y[8];
            bf8_to_f32(gr[t], g0); bf8_to_f32(br[t], bg);
#pragma unroll
            for (int i = 0; i < 8; ++i) { y[i] = bg[i] * (w0[i] * g2[i] + w1[i] * g1[i] + w2[i] * g0[i] + bb[i]); g2[i] = g1[i]; g1[i] = g0[i]; }
            v4u o; o.x = cvtpk_bf16(y[0], y[1]); o.y = cvtpk_bf16(y[2], y[3]); o.z = cvtpk_bf16(y[4], y[5]); o.w = cvtpk_bf16(y[6], y[7]);
            *(v4u*)(Out + (size_t)(m0 + t) * DM + ch0) = o;
        }
    }
}

#ifndef MK_MF32
#define MK_MF32 0
#endif
#ifndef MK_STAGGER_US
#define MK_STAGGER_US 60
#endif
#ifndef MK_DUP
#define MK_DUP 0
#endif
#define NREP(bit) ((MK_DUP & (bit)) ? 2 : 1)
#ifndef MK_DIS
#define MK_DIS 0
#endif
__global__ void __launch_bounds__(NWAVES * 64, 2) mk_fwd(Args args) {
    extern __shared__ __attribute__((aligned(16))) unsigned char lds[];
    Frame F;
    F.lds = (LAS unsigned char*)lds;
    volatile LAS unsigned* MISC = (volatile LAS unsigned*)(F.lds + MISC_OFF);
    F.tid = threadIdx.x; F.lane = F.tid & 63; F.wave = __builtin_amdgcn_readfirstlane(F.tid >> 6);
    F.G = gridDim.x; { const int bx = blockIdx.x; F.vcu = (F.G % 8 == 0) ? (bx % 8) * (F.G / 8) + bx / 8 : bx; }
    unsigned char* ws = args.ws;
    const bool grp_mode = (F.G == 256);
    { const int bx = blockIdx.x, pm_ = 8 * (bx % 8) + (bx / 8) % 8; F.vrow = grp_mode ? 4 * pm_ + bx / 64 : F.vcu; }
    unsigned* grp_mask = (unsigned*)(ws + WS_CTL) + CW_GMASK + 64 * ((F.vrow >> 2) & 63);
    if (threadIdx.x == 0) (void)__hip_atomic_fetch_or(grp_mask, 1u << xb_xcc_id(), __ATOMIC_RELAXED, __HIP_MEMORY_SCOPE_AGENT);
    unsigned* grp_cnt = (unsigned*)(ws + WS_CTL) + CW_GRP + 64 * ((F.vrow >> 2) & 63);
    for (int u = F.tid; u < (LDS_BYTES - LDSCTL_OFF) / 4; u += NWAVES * 64) ((LAS unsigned*)(F.lds + LDSCTL_OFF))[u] = 0u;
    __syncthreads();
    XcdBarrier bar = xcd_barrier_post((unsigned*)(ws + WS_CTL) + CW_BAR, MISC + 8);
    const int lo = args.ph_lo, hi = args.ph_hi;
#define FRESH() do { int t_ = threadIdx.x; asm volatile("" : "+v"(t_)); F.tid = t_; F.lane = t_ & 63; F.wave = __builtin_amdgcn_readfirstlane(t_ >> 6); } while (0)
#define IN(k) (lo <= (k) && (k) < hi)
#define SEAM(k) do { if ((k) + 1 < hi) { xcd_barrier(bar); if (MK_DUP & 8192) xcd_barrier(bar); } } while (0)
#define CSEAM(k) do { if ((k) + 1 < hi) { if (grp_mode) { const int pm_ = F.vrow >> 2; unsigned* c0_ = (unsigned*)(ws + WS_CTL) + CW_GRP; unsigned* m0_ = (unsigned*)(ws + WS_CTL) + CW_GMASK; \
        grp_barrier(grp_cnt, grp_mask, MISC + 10, bar.bar, (pm_ % (SEQ / 256)) ? c0_ + 64 * (pm_ - 1) : nullptr, ((pm_ + 1) % (SEQ / 256)) ? m0_ + 64 * (pm_ + 1) : nullptr); } else xcd_barrier(bar); } } while (0)
#define ASEAM(k) do { if ((k) + 1 < hi) { if (grp_mode) { const int pm_ = F.vrow >> 2, f_ = pm_ - pm_ % (SEQ / 256); \
        prefix_barrier((unsigned*)(ws + WS_CTL) + CW_GRP, (unsigned*)(ws + WS_CTL) + CW_GMASK, pm_, f_, f_ + SEQ / 256 - 1, MISC + 10, bar.bar); } else xcd_barrier(bar); } } while (0)
#define GSEAM(k) do { if ((k) + 1 < hi) { if (grp_mode) grp_barrier(grp_cnt, grp_mask, MISC + 10, bar.bar); else xcd_barrier(bar); } } while (0)
    float* modtab = (float*)(ws + WS_MODTAB);
    const long scr_off = MK_DUP ? (long)((float*)(ws + WS_SCR) - args.out) : 0, hscr_off = MK_DUP ? (long)((bf16*)(ws + WS_SCR) - (bf16*)(ws + WS_H)) : 0, qscr_off = MK_DUP ? (long)((short*)(ws + WS_SCR + 64 * MiB) - (short*)(ws + WS_X16)) : 0;
    bf16* Hb = (bf16*)(ws + WS_H); bf16* Qb = (bf16*)(ws + WS_Q); bf16* Ob = (bf16*)(ws + WS_O); bf16* HIDb = (bf16*)(ws + WS_HID); bf16* Yb = (bf16*)(ws + WS_Y);

    if (IN(0)) {
#if !(MK_DIS & 1)
        for (int rep = 0; rep < NREP(1); ++rep) { FRESH(); phase_prologue_a(F, args, 0, grp_mode ? DEPTH - 1 : DEPTH, F.vcu, F.G, true, (DM / 64) * (NMIX / 32)); }
#endif
        SEAM(0); }
    if (IN(1)) {
#if !(MK_DIS & 2)
        for (int rep = 0; rep < NREP(2); ++rep) { FRESH(); phase_prologue_b(F, args); }
#endif
        SEAM(1);
        if (grp_mode && (F.vrow >> 2) >= (M / 256) / 2) {
            FRESH(); phase_prologue_a(F, args, DEPTH - 1, DEPTH, F.vrow - (M / 256) * 2, (M / 256) * 2, false, (DM / 64) * (NMIX / 32));
            asm volatile("s_waitcnt vmcnt(0)" ::: "memory"); __syncthreads();
            if (threadIdx.x == 0) { __builtin_amdgcn_fence(__ATOMIC_RELEASE, "agent"); asm volatile("s_waitcnt vmcnt(0)" ::: "memory"); (void)xb_add((unsigned*)(ws + WS_CTL) + CW_A1, 1u); }
        }
        }
    for (int l = 0; l < DEPTH; ++l) {
        const int pb = 2 + 7 * l, j = l >> 1; const bool is_conv = (l & 1) != 0;
        if (grp_mode && l == DEPTH - 1 && IN(pb + 0)) {
            if (threadIdx.x == 0) { unsigned* w_ = (unsigned*)(ws + WS_CTL) + CW_A1; XB_SPIN(xb_ld(w_) < (unsigned)((M / 256) * 2), bar.bar); __builtin_amdgcn_fence(__ATOMIC_ACQUIRE, "agent"); asm volatile("s_waitcnt vmcnt(0)" ::: "memory"); }
            __syncthreads(); }
        bf16* Gb = (bf16*)(ws + ((j & 1) ? WS_G2 : WS_G));
        bf16* Kb = (bf16*)(ws + ((j & 1) ? WS_K2 : WS_K)); bf16* Vb = (bf16*)(ws + ((j & 1) ? WS_V2 : WS_V));
        const unsigned char* wl = ws + WS_W + (size_t)l * W_LAYER;
        const float* mt = modtab + (size_t)l * BATCH * MODN;
        if (IN(pb + 0)) {
            pg8::Gemm g{Hb, (const bf16*)(wl + W_MIXIN), M, NMIX, DM}; pg8::StaticOrder S; S.init(M, NMIX, F.G, (int)blockIdx.x);
            if (is_conv) {
                pg8::EpiConvIn E{Gb, Qb, DM, DM / 128};
#if !(MK_DIS & 4)
                for (int rep = 0; rep < NREP(4); ++rep) pg8::gemm_phase<pg8::EpiConvIn, pg8::StaticOrder, true, true>(F.lds + RING_OFF, g, S, E);
#endif
            } else {
                pg8::EpiI8Bf16Split E{Qb, DM, (const float*)(ws + WS_ROWSH), (const float*)(wl + W_MIXIN + W_MIXIN_CS), DM, Kb, Vb, (unsigned*)(ws + WS_CTL) + CW_VMAX + 64 * j};
#if !(MK_DIS & 4)
                for (int rep = 0; rep < NREP(4); ++rep) pg8::gemm_phase<pg8::EpiI8Bf16Split, pg8::StaticOrder, true, true, 0, 1, true>(F.lds + RING_OFF, g, S, E);
#endif
#if (MK_DUP & 1024)
                { pg8::EpiNull EN; pg8::gemm_phase<pg8::EpiNull, pg8::StaticOrder, true, true, 0, 1, true>(F.lds + RING_OFF, g, S, EN); }
#endif
#if (MK_DUP & 262144)
                { pg8::EpiNull EN; pg8::gemm_phase<pg8::EpiNull, pg8::StaticOrder, true, true, 3>(F.lds + RING_OFF, g, S, EN); }
#endif
#if (MK_DUP & 524288)
                { pg8::EpiNull EN; pg8::gemm_phase<pg8::EpiNull, pg8::StaticOrder, true, true, 4>(F.lds + RING_OFF, g, S, EN); }
#endif
            }
            if (is_conv) CSEAM(pb + 0); else ASEAM(pb + 0);
        }
        if (IN(pb + 1)) {
            if (is_conv) {

#if !(MK_DIS & 16)
                for (int rep = 0; rep < NREP(16); ++rep) { FRESH(); phase_conv(F, args, args.in[9] + (size_t)j * 3 * DM, args.in[10] + (size_t)j * DM, Gb); }
#endif

            } else {

#if !(MK_DIS & 8)
                const int nunits = BATCH * NH * (SEQ / sba::UNIT_ROWS);
                unsigned* vmaxw = (unsigned*)(ws + WS_CTL) + CW_VMAX + 64 * j;
                for (int rep = 0; rep < NREP(8); ++rep) {
                    if (grp_mode) {
                        const int pm_ = F.vrow >> 2, j_ = F.vrow & 3; const float osc = pg8::o_scale_panels(vmaxw, pm_ - pm_ % (SEQ / 256), pm_);
                        for (int i = 0; i < NH / 4; ++i) sba::attn_unit(pm_ / (SEQ / sba::UNIT_ROWS), 4 * j_ + i, pm_ % (SEQ / sba::UNIT_ROWS), Qb, Kb, Vb, (signed char*)Ob, 1.0f / osc, (LAS char*)(F.lds + RING_OFF));
                    } else for (int u = F.vcu; u < nunits; u += F.G) { const int bh = u / (SEQ / sba::UNIT_ROWS), qb = u % (SEQ / sba::UNIT_ROWS);
                        const int pmu = (bh / NH) * (SEQ / 256) + qb; const float osc = pg8::o_scale_panels(vmaxw, pmu - qb, pmu); sba::attn_unit(bh / NH, bh % NH, qb, Qb, Kb, Vb, (signed char*)Ob, 1.0f / osc, (LAS char*)(F.lds + RING_OFF)); } }
#endif

            }
            GSEAM(pb + 1);
        }
        if (IN(pb + 2)) {
            pg8::Gemm g{Ob, (const bf16*)(wl + W_MIXOUT), M, DM, DM}; pg8::StaticOrder S; S.init(M, DM, F.G, (int)blockIdx.x);
#if !(MK_DIS & 32)
            if (is_conv) {
                pg8::EpiGateBf16<false> E{Yb, DM, nullptr, mt + 2 * DM, MODN, SEQ, 1.0f};
                for (int rep = 0; rep < NREP(32); ++rep) pg8::gemm_phase<pg8::EpiGateBf16<false>, pg8::StaticOrder, true, true>(F.lds + RING_OFF, g, S, E);
            } else {
                pg8::EpiI8GateBf16 E{Yb, DM, mt + 2 * DM, MODN, SEQ, (const float*)(wl + W_MIXOUT + W_MIXOUT_CS), (unsigned*)(ws + WS_CTL) + CW_VMAX + 64 * j};
                for (int rep = 0; rep < NREP(32); ++rep) pg8::gemm_phase<pg8::EpiI8GateBf16, pg8::StaticOrder, true, true, 0, 1, true>(F.lds + RING_OFF, g, S, E);
            }
            GSEAM(pb + 2);
#endif

        }
        if (IN(pb + 3)) {
#if !(MK_DIS & 64)
            for (int rep = 0; rep < NREP(64); ++rep) { const bool x_ = rep + 1 < NREP(64); FRESH(); phase_ln(F, args, Yb, args.in[4] + (size_t)(l * 2 + 0) * DM, args.in[5] + (size_t)(l * 2 + 0) * DM, mt + 3 * DM, mt + 4 * DM, true, x_ ? scr_off : 0, x_ ? hscr_off : 0, x_ ? qscr_off : 0, true); }
#endif
            GSEAM(pb + 3); }
        if (IN(pb + 4)) {
            pg8::Gemm g{Hb, (const bf16*)(wl + W_W1), M, FF, DM}; pg8::StaticOrder S; S.init(M, FF, F.G, (int)blockIdx.x);
            pg8::EpiI8Fp8Relu2 E{(unsigned char*)HIDb, FF, args.in[13] + (size_t)l * FF, (const float*)(ws + WS_ROWSH), (const float*)(wl + W_W1 + W_W1_CS), HID_SCALE};
#if !(MK_DIS & 128)
            for (int rep = 0; rep < NREP(128); ++rep) pg8::gemm_phase<pg8::EpiI8Fp8Relu2, pg8::StaticOrder, true, true, 0, 1, true>(F.lds + RING_OFF, g, S, E);
#endif

            GSEAM(pb + 4);
        }
        if (IN(pb + 5)) {
            pg8::Gemm g{HIDb, (const bf16*)(wl + W_W2), M, DM, FF}; pg8::StaticOrder S; S.init(M, DM, F.G, (int)blockIdx.x);
            pg8::EpiGateBf16<true, true> E{Yb, DM, args.in[15] + (size_t)l * DM, mt + 5 * DM, MODN, SEQ, 1.0f / (HID_SCALE * W2_SCALE)};
#if !(MK_DIS & 256)
#if (MK_DUP & 2048)
            { pg8::EpiNull EN; pg8::gemm_phase<pg8::EpiNull, pg8::StaticOrder, true, true, 0, 1>(F.lds + RING_OFF, g, S, EN); }
#endif
            for (int rep = 0; rep < NREP(256); ++rep) pg8::gemm_phase<pg8::EpiGateBf16<true, true>, pg8::StaticOrder, true, true, 0, 1>(F.lds + RING_OFF, g, S, E);
            GSEAM(pb + 5);
#endif

        }
        if (IN(pb + 6)) { const int nl = (l + 1 < DEPTH) ? l + 1 : l; const float* mtn = modtab + (size_t)nl * BATCH * MODN;

#if !(MK_DIS & 512)
            for (int rep = 0; rep < NREP(512); ++rep) { const bool x_ = rep + 1 < NREP(512); FRESH(); phase_ln(F, args, Yb, args.in[4] + (size_t)(l * 2 + 1) * DM, args.in[5] + (size_t)(l * 2 + 1) * DM, mtn + 0 * DM, mtn + 1 * DM, l + 1 < DEPTH, x_ ? scr_off : 0, x_ ? hscr_off : 0, x_ ? qscr_off : 0, ((l + 1) & 1) == 0); }
#endif
            GSEAM(pb + 6); }
    }
#undef IN
#undef SEAM
#undef GSEAM
#undef ASEAM
#undef CSEAM
}

extern "C" void kernel_launch(void* const* d_in, const int* in_sizes, int n_in, void* d_out, int out_size, void* d_ws, size_t ws_size, hipStream_t stream) {
    static int grid = 0;
    if (grid == 0) {
        if (n_in != 16 || in_sizes[0] != M * DM || out_size != M * DM || ws_size < WS_NEED + (MK_DUP ? 128 * MiB : 0)) { fprintf(stderr, "kernel_launch: unexpected shapes (n_in %d, in0 %d, out %d, ws %zu); nothing launched\n", n_in, n_in > 0 ? in_sizes[0] : -1, out_size, ws_size); grid = -1; return; }
        int dev = 0, cus = 0, per_cu = 0;
        if (hipGetDevice(&dev) != hipSuccess || hipDeviceGetAttribute(&cus, hipDeviceAttributeMultiprocessorCount, dev) != hipSuccess) { fprintf(stderr, "kernel_launch: device query failed\n"); grid = -1; return; }
        if (hipFuncSetAttribute((const void*)mk_fwd, hipFuncAttributeMaxDynamicSharedMemorySize, LDS_BYTES) != hipSuccess) { fprintf(stderr, "kernel_launch: hipFuncSetAttribute failed\n"); grid = -1; return; }
        if (hipOccupancyMaxActiveBlocksPerMultiprocessor(&per_cu, (const void*)mk_fwd, NWAVES * 64, LDS_BYTES) != hipSuccess || per_cu < 1) { fprintf(stderr, "kernel_launch: occupancy query reports %d workgroups per CU\n", per_cu); }
        (void)hipGetLastError();
        grid = cus;
        if (grid > 256) grid = 256;
        if (grid != 256 && grid != 128 && grid != 64) { fprintf(stderr, "kernel_launch: %d CUs: this kernel deals rows in M/grid blocks and needs 64, 128 or 256 workgroups; nothing launched\n", grid); grid = -1; return; }
    }
    if (grid < 0) return;
    if (hipMemsetAsync((char*)d_ws + WS_CTL, 0, CTL_ZERO_BYTES, stream) != hipSuccess) { fprintf(stderr, "kernel_launch: memset failed\n"); return; }
    Args a{};
    for (int i = 0; i < 16; ++i) a.in[i] = (const float*)d_in[i];
    a.out = (float*)d_out; a.ws = (unsigned char*)d_ws;
    a.ph_lo = 0; a.ph_hi = NPHASE;
    hipLaunchKernelGGL(mk_fwd, dim3(grid), dim3(NWAVES * 64), LDS_BYTES, stream, a);
    const hipError_t le = hipPeekAtLastError();
    if (le != hipSuccess) fprintf(stderr, "kernel_launch: launch failed: %s\n", hipGetErrorName(le));
}
```
